# Optimizing an MI355X kernel written in HIP

```python
import jax, jax.numpy as jnp
from jax import lax
import numpy as np

D_MODEL = 1024
BATCH = 4
SEQ = 8192
DEPTH = 2
DEC_BATCH = 8
DEC_SEQ = 64
PAST_LEN = 4096

CHUNK = 64
N_MIXERS = 2
N_CONV_LAYERS = (DEPTH + 1) // 2
N_MLA_LAYERS = DEPTH // 2
CONV_WIDTH = 3
CONV_DIM = D_MODEL
N_HEADS = 16
QK_NOPE_DIM = 64
QK_ROPE_DIM = 32
V_HEAD_DIM = 64
QK_DIM = QK_NOPE_DIM + QK_ROPE_DIM
Q_LORA_RANK = 256
KV_LORA_RANK = 128
MLA_GATE_DIM = N_HEADS * V_HEAD_DIM
MLA_IN_DIM = Q_LORA_RANK + KV_LORA_RANK + QK_ROPE_DIM + MLA_GATE_DIM
ROPE_THETA = 10000.0
Q_BLOCK = 128
EPS = 1e-6
SM_SCALE = QK_DIM ** -0.5
NEG_INF = -1e30

kernel_name = "hybrid_shortconv_mla_stream_step"


def rms_norm(x, g):
    xf = x.astype(jnp.float32)
    y = xf * lax.rsqrt(jnp.mean(xf * xf, axis=-1, keepdims=True) + EPS)
    return (y * g.astype(jnp.float32)).astype(x.dtype)


def rope_cos_sin(pos):
    inv = 1.0 / (ROPE_THETA ** (jnp.arange(0, QK_ROPE_DIM, 2, dtype=jnp.float32) / QK_ROPE_DIM))
    ang = pos.astype(jnp.float32)[:, None] * inv[None, :]
    return jnp.cos(ang), jnp.sin(ang)


def apply_rope(x, cos, sin):
    xf = x.astype(jnp.float32)
    x1, x2 = xf[..., :QK_ROPE_DIM // 2], xf[..., QK_ROPE_DIM // 2:]
    out = jnp.concatenate([x1 * cos - x2 * sin, x2 * cos + x1 * sin], axis=-1)
    return out.astype(x.dtype)


def short_conv_mixer(h, conv_prev, w_in, conv_w, w_out):
    T = h.shape[1]
    b_gate, c_gate, xv, z = jnp.split(h @ w_in, 4, axis=-1)
    u = c_gate * xv
    up = jnp.concatenate([conv_prev.astype(u.dtype), u], axis=1)
    conv = up[:, 0:T] * conv_w[0]
    for k in range(1, CONV_WIDTH):
        conv = conv + up[:, k:k + T] * conv_w[k]
    y = (jax.nn.silu(z) * b_gate * conv) @ w_out
    return y, up[:, -(CONV_WIDTH - 1):]


def mla_project(h, pos, w_in, q_norm_g, w_qb, kv_norm_g):
    B, T, _ = h.shape
    p = h @ w_in
    q_lat = p[..., :Q_LORA_RANK]
    kv_lat = p[..., Q_LORA_RANK:Q_LORA_RANK + KV_LORA_RANK]
    k_rope = p[..., Q_LORA_RANK + KV_LORA_RANK:Q_LORA_RANK + KV_LORA_RANK + QK_ROPE_DIM]
    z = p[..., Q_LORA_RANK + KV_LORA_RANK + QK_ROPE_DIM:]
    q = (rms_norm(q_lat, q_norm_g) @ w_qb).reshape(B, T, N_HEADS, QK_DIM)
    cos, sin = rope_cos_sin(pos)
    q_rope = apply_rope(q[..., QK_NOPE_DIM:], cos[:, None, :], sin[:, None, :])
    q = jnp.concatenate([q[..., :QK_NOPE_DIM], q_rope], axis=-1)
    k_rope = apply_rope(k_rope, cos, sin)
    c_kv = rms_norm(kv_lat, kv_norm_g)
    return q, c_kv, k_rope, z


def mla_expand_kv(c_kv, k_rope, w_kvb):
    B, S, _ = c_kv.shape
    kv = (c_kv @ w_kvb).reshape(B, S, N_HEADS, QK_NOPE_DIM + V_HEAD_DIM)
    k_pe = jnp.broadcast_to(k_rope[:, :, None, :].astype(kv.dtype), (B, S, N_HEADS, QK_ROPE_DIM))
    k = jnp.concatenate([kv[..., :QK_NOPE_DIM], k_pe], axis=-1)
    v = kv[..., QK_NOPE_DIM:]
    return k, v


def attend(q, k, v, mask):
    s = jnp.einsum('bqhd,bkhd->bhqk', q, k).astype(jnp.float32) * SM_SCALE
    if mask is not None:
        s = jnp.where(mask[None, None], s, NEG_INF)
    p = jax.nn.softmax(s, axis=-1).astype(v.dtype)
    return jnp.einsum('bhqk,bkhd->bqhd', p, v)


def mla_prompt_attention(q, k, v):
    B, S = q.shape[0], q.shape[1]
    k_chunk = jnp.arange(S) // CHUNK

    def block(i):
        start = i * Q_BLOCK
        qb = lax.dynamic_slice_in_dim(q, start, Q_BLOCK, axis=1)
        q_chunk = (start + jnp.arange(Q_BLOCK)) // CHUNK
        mask = k_chunk[None, :] <= q_chunk[:, None]
        return attend(qb, k, v, mask)

    o = lax.map(block, jnp.arange(S // Q_BLOCK))
    return jnp.moveaxis(o, 0, 1).reshape(B, S, N_HEADS * V_HEAD_DIM)


def setup_inputs(seed: int = 0) -> dict:
    key = jax.random.key(seed)
    ks = jax.random.split(key, 20)
    f32 = jnp.float32

    def nrm(k, shape, scale):
        return jax.random.normal(k, shape, f32) * scale

    return {
        "x_prompt": nrm(ks[0], (BATCH, SEQ, D_MODEL), 1.0),
        "x_sample": nrm(ks[1], (DEC_BATCH, DEC_SEQ, D_MODEL), 1.0),
        "state_conv": nrm(ks[2], (N_CONV_LAYERS, DEC_BATCH, CONV_WIDTH - 1, CONV_DIM), 1.0),
        "cache_ckv": nrm(ks[3], (N_MLA_LAYERS, DEC_BATCH, PAST_LEN, KV_LORA_RANK), 1.0),
        "cache_krope": nrm(ks[4], (N_MLA_LAYERS, DEC_BATCH, PAST_LEN, QK_ROPE_DIM), 1.0),
        "norm_g": 1.0 + nrm(ks[5], (DEPTH, D_MODEL), 0.05),
        "final_norm_g": 1.0 + nrm(ks[6], (D_MODEL,), 0.05),
        "conv_w_in": nrm(ks[7], (N_CONV_LAYERS, D_MODEL, 4 * CONV_DIM), D_MODEL ** -0.5),
        "conv_w": nrm(ks[8], (N_CONV_LAYERS, CONV_WIDTH, CONV_DIM), CONV_WIDTH ** -0.5),
        "conv_w_out": nrm(ks[9], (N_CONV_LAYERS, CONV_DIM, D_MODEL), CONV_DIM ** -0.5),
        "mla_w_in": nrm(ks[10], (N_MLA_LAYERS, D_MODEL, MLA_IN_DIM), D_MODEL ** -0.5),
        "mla_q_norm_g": 1.0 + nrm(ks[11], (N_MLA_LAYERS, Q_LORA_RANK), 0.05),
        "mla_w_qb": nrm(ks[12], (N_MLA_LAYERS, Q_LORA_RANK, N_HEADS * QK_DIM), Q_LORA_RANK ** -0.5),
        "mla_kv_norm_g": 1.0 + nrm(ks[13], (N_MLA_LAYERS, KV_LORA_RANK), 0.05),
        "mla_w_kvb": nrm(ks[14], (N_MLA_LAYERS, KV_LORA_RANK, N_HEADS * (QK_NOPE_DIM + V_HEAD_DIM)), KV_LORA_RANK ** -0.5),
        "mla_w_out": nrm(ks[15], (N_MLA_LAYERS, MLA_GATE_DIM, D_MODEL), MLA_GATE_DIM ** -0.5),
    }


def reference(x_prompt, x_sample, state_conv, cache_ckv, cache_krope, norm_g, final_norm_g,
              conv_w_in, conv_w, conv_w_out, mla_w_in, mla_q_norm_g, mla_w_qb,
              mla_kv_norm_g, mla_w_kvb, mla_w_out):
    xp, xs = x_prompt, x_sample
    Bp, S, _ = xp.shape
    Bs, T, _ = xs.shape
    pos_p = jnp.arange(S, dtype=jnp.int32)
    pos_s = PAST_LEN + jnp.arange(T, dtype=jnp.int32)
    conv_p_states, conv_s_states = [], []
    ckv_p_rows, krope_p_rows, ckv_s_rows, krope_s_rows = [], [], [], []

    for i in range(DEPTH):
        j = i // N_MIXERS
        hp = rms_norm(xp, norm_g[i])
        hs = rms_norm(xs, norm_g[i])
        if i % N_MIXERS == 0:
            zeros_prev = jnp.zeros((Bp, CONV_WIDTH - 1, CONV_DIM), xp.dtype)
            yp, st_p = short_conv_mixer(hp, zeros_prev, conv_w_in[j], conv_w[j], conv_w_out[j])
            ys, st_s = short_conv_mixer(hs, state_conv[j], conv_w_in[j], conv_w[j], conv_w_out[j])
            conv_p_states.append(st_p)
            conv_s_states.append(st_s)
        else:
            qp, ckv_p, kr_p, zp = mla_project(hp, pos_p, mla_w_in[j], mla_q_norm_g[j], mla_w_qb[j], mla_kv_norm_g[j])
            kp, vp = mla_expand_kv(ckv_p, kr_p, mla_w_kvb[j])
            op = mla_prompt_attention(qp, kp, vp)
            yp = (jax.nn.silu(zp) * op) @ mla_w_out[j]

            qs, ckv_s, kr_s, zs = mla_project(hs, pos_s, mla_w_in[j], mla_q_norm_g[j], mla_w_qb[j], mla_kv_norm_g[j])
            ckv_all = jnp.concatenate([cache_ckv[j].astype(ckv_s.dtype), ckv_s], axis=1)
            kr_all = jnp.concatenate([cache_krope[j].astype(kr_s.dtype), kr_s], axis=1)
            ks_, vs_ = mla_expand_kv(ckv_all, kr_all, mla_w_kvb[j])
            os_ = attend(qs, ks_, vs_, None).reshape(Bs, T, N_HEADS * V_HEAD_DIM)
            ys = (jax.nn.silu(zs) * os_) @ mla_w_out[j]

            ckv_p_rows.append(ckv_p)
            krope_p_rows.append(kr_p)
            ckv_s_rows.append(ckv_s)
            krope_s_rows.append(kr_s)
        xp = xp + yp
        xs = xs + ys

    y_prompt = rms_norm(xp, final_norm_g)
    y_sample = rms_norm(xs, final_norm_g)
    new_conv_prompt = jnp.stack(conv_p_states, axis=0)
    new_ckv_prompt = jnp.stack(ckv_p_rows, axis=0)
    new_krope_prompt = jnp.stack(krope_p_rows, axis=0)
    new_conv_sample = jnp.stack(conv_s_states, axis=0)
    new_ckv_sample = jnp.stack(ckv_s_rows, axis=0)
    new_krope_sample = jnp.stack(krope_s_rows, axis=0)
    return (y_prompt, y_sample, new_conv_prompt, new_ckv_prompt, new_krope_prompt, new_conv_sample, new_ckv_sample, new_krope_sample)
```

```cpp
#include <hip/hip_runtime.h>
#include <hip/hip_bf16.h>
#include <cstdio>
#include <cstdint>
#include <cmath>

#ifndef MK_N_LAUNCHES
#define MK_N_LAUNCHES 1
#endif

constexpr int DM = 1024, SEQ = 8192, NB = 4, MP = NB * SEQ, SB = 8, ST = 64, MS = SB * ST, MT = MP + MS;
constexpr int PAST = 4096, SKV = PAST + ST, SKVP = 4224;
constexpr int NH = 16, DN = 64, DR = 32, DQK = 96, DV = 64, QL = 256, KVL = 128;
constexpr int MKV = MP + SB * PAST + MS;
constexpr int NCHUNK = MT / 64;
constexpr float EPS = 1e-6f;
constexpr float LOG2E = 1.4426950408889634f;
constexpr float C2 = 0.10206207261596577f * 1.4426950408889634f;
constexpr size_t O_YP = 0, O_YS = (size_t)MP * DM, O_CONVP = O_YS + (size_t)MS * DM, O_CKVP = O_CONVP + NB * 2 * DM, O_KRP = O_CKVP + (size_t)MP * KVL,
                 O_CONVS = O_KRP + (size_t)MP * DR, O_CKVS = O_CONVS + SB * 2 * DM, O_KRS = O_CKVS + (size_t)MS * KVL, O_END = O_KRS + (size_t)MS * DR;
static_assert(O_END == 39428096, "output size");

constexpr size_t MiB = 1u << 20;
constexpr size_t al256(size_t x) { return (x + 255) & ~(size_t)255; }
constexpr size_t WS_CTL = 0, CTL_ZERO_BYTES = 1 * MiB;
constexpr size_t WS_W1T = CTL_ZERO_BYTES;
constexpr size_t WS_W2T = WS_W1T + (size_t)4096 * 1024 * 2;
constexpr size_t WS_W3T = WS_W2T + (size_t)1024 * 1024 * 2;
constexpr size_t WS_W4T = WS_W3T + (size_t)1536 * 1024 * 2;
constexpr size_t WS_W5T = WS_W4T + (size_t)1536 * 256 * 2;
constexpr size_t WS_W6T = WS_W5T + (size_t)2048 * 128 * 2;
constexpr size_t WS_ROPE = WS_W6T + (size_t)1024 * 1024 * 2;
constexpr size_t WS_RS0 = WS_ROPE + (size_t)8192 * 32 * 4;
constexpr size_t WS_SSQ1 = al256(WS_RS0 + (size_t)MT * 4);
constexpr size_t WS_SSQ2 = WS_SSQ1 + (size_t)MT * 16 * 4;
constexpr size_t WS_SSQQ = WS_SSQ2 + (size_t)MT * 16 * 4;
constexpr size_t WS_SSQKV = WS_SSQQ + (size_t)MT * 4 * 4;
constexpr size_t WS_WHEAD = WS_SSQKV + (size_t)MT * 4 * 4;
constexpr size_t WS_PCHEAD = WS_WHEAD + (size_t)NCHUNK * 2 * DM * 4;
constexpr size_t WS_UTAIL = WS_PCHEAD + (size_t)NCHUNK * 2 * DM * 4;
constexpr size_t WS_KRP = WS_UTAIL + (size_t)NCHUNK * 2 * DM * 4;
constexpr size_t WS_KRS = WS_KRP + (size_t)MP * DR * 2;
constexpr size_t WS_SMALL_END = WS_KRS + (size_t)SB * SKVP * DR * 2;
constexpr size_t WS_B = 40 * MiB;
constexpr size_t WS_A = WS_B + 65 * MiB;
constexpr size_t QP_ELEMS = (size_t)NB * NH * SEQ * DQK, QS_ELEMS = (size_t)SB * NH * ST * DQK;
static_assert((QP_ELEMS + QS_ELEMS) * 2 <= (size_t)MT * DM * 4, "Q fits in the y region of d_out");
constexpr size_t WS_QLAT = al256(WS_A + (QP_ELEMS + QS_ELEMS) * 2);
constexpr size_t WS_CKVA = WS_QLAT + (size_t)MT * QL * 2;
constexpr size_t KP_ELEMS = (size_t)NB * NH * SEQ * DN, KS_ELEMS = (size_t)SB * NH * SKVP * DN;
constexpr size_t WS_K = al256(WS_CKVA + (size_t)MKV * KVL * 2);
constexpr size_t WS_V = WS_K + (KP_ELEMS + KS_ELEMS) * 2;
constexpr size_t WS_END = WS_V + (KP_ELEMS + KS_ELEMS) * 2;
static_assert(WS_SMALL_END <= WS_B && (size_t)MT * DM * 2 <= 65 * MiB && WS_END <= 512 * MiB, "d_ws map");

namespace pg8 {
#define PG8_LAS __attribute__((address_space(3)))
typedef unsigned short bf16_t;
typedef short bf16x8 __attribute__((ext_vector_type(8)));
typedef float f32x4 __attribute__((ext_vector_type(4)));
typedef unsigned u32x4 __attribute__((ext_vector_type(4)));
constexpr int BM = 256, BK = 64, HALF = 128, HTB = HALF * BK * 2  , STAGE_BYTES = 8 * HTB, NXCD = 8, WGM = 8;

__host__ __device__ __forceinline__ int lds_byte(int r, int c) { const int st = (r >> 4) * 2 + (c >> 5), rr = r & 15, cc = c & 31, ob = rr * 64 + cc * 2; return st * 1024 + (ob ^ (((ob >> 9) & 1) << 5)); }
__host__ __device__ __forceinline__ void stage_rc(int b, int& R, int& C) { const int st = b / 1024, sb = b % 1024, swz = sb ^ (((sb >> 9) & 1) << 5); R = (st >> 1) * 16 + swz / 64; C = (st & 1) * 32 + (swz % 64) / 2; }
__host__ __device__ __forceinline__ int perm32(int rho) { const int n = rho >> 4, i = rho & 15; return 8 * (i >> 2) + 4 * n + (i & 3); }

struct Unit { int pm, pn; };
struct Gemm { const bf16_t* A; const bf16_t* Bt; int M, N, K; int kt = 0; };

struct StaticOrder {
    int nM, nN, nwg, G, c, lim;
    __host__ __device__ __forceinline__ void init(int M, int N, int G_, int c_) { nM = M / BM; nN = N / BM; nwg = nM * nN; G = G_; c = c_; lim = nwg; }
    __host__ __device__ __forceinline__ bool next(int i, Unit& u) const { const long L = (long)i * G + c; if (L >= lim) return false; unit_of((int)L, u); return true; }
    __host__ __device__ __forceinline__ bool unit_of(int L, Unit& u) const {
        int wgid = L; { const int q = nwg / NXCD, r = nwg % NXCD, xcd = wgid % NXCD, off = wgid / NXCD; wgid = (xcd < r ? xcd * (q + 1) : r * (q + 1) + (xcd - r) * q) + off; }
        const int nig = WGM * nN, gid = wgid / nig, fm = gid * WGM, gsz = (nM - fm) < WGM ? (nM - fm) : WGM;
        u.pm = fm + ((wgid % nig) % gsz); u.pn = (wgid % nig) / gsz; return true;
    }
    __device__ __forceinline__ void a_ready(const Unit&) const {}
    __device__ __forceinline__ void done(const Unit&) const {}
};
struct OneUnit {
    int pm, pn, valid;
    __host__ __device__ __forceinline__ bool next(int i, Unit& u) const { if (i > 0 || !valid) return false; u.pm = pm; u.pn = pn; return true; }
    __device__ __forceinline__ void a_ready(const Unit&) const {}
    __device__ __forceinline__ void done(const Unit&) const {}
};
struct CachedOrder {
    int u0, n;
    __host__ __device__ __forceinline__ bool next(int i, Unit& u) const { if (i >= n) return false; const int x = u0 + i; u.pm = 128 + (x >> 3); u.pn = x & 7; return true; }
    __device__ __forceinline__ void a_ready(const Unit&) const {}
    __device__ __forceinline__ void done(const Unit&) const {}
};
struct KvOrder : StaticOrder {
    __host__ __device__ __forceinline__ bool next(int i, Unit& u) const { if (!StaticOrder::next(i, u)) return false; if (u.pm >= 128) u.pm += 128; return true; }
};
struct PanelOrder {
    int c, np;
    __host__ __device__ __forceinline__ bool next(int i, Unit& u) const { const int x = c & 7, s = c >> 3, p = 64 * i + 8 * x + (s >> 2); if (p >= np) return false; u.pm = p; u.pn = s & 3; return true; }
    __device__ __forceinline__ void a_ready(const Unit&) const {}
    __device__ __forceinline__ void done(const Unit&) const {}
};
typedef float f32x2 __attribute__((ext_vector_type(2)));
typedef unsigned u32x2 __attribute__((ext_vector_type(2)));
typedef __bf16 bf16x2_t __attribute__((ext_vector_type(2)));
__device__ __forceinline__ unsigned cvt_pk_bf16(float lo, float hi) { f32x2 v = {lo, hi}; bf16x2_t b = __builtin_convertvector(v, bf16x2_t); return __builtin_bit_cast(unsigned, b); }
__device__ __forceinline__ u32x2 pack4(const f32x4 v) { u32x2 w; w.x = cvt_pk_bf16(v[0], v[1]); w.y = cvt_pk_bf16(v[2], v[3]); return w; }
__device__ __forceinline__ u32x4 pack8(const f32x4 a, const f32x4 b) { u32x4 w; w.x = cvt_pk_bf16(a[0], a[1]); w.y = cvt_pk_bf16(a[2], a[3]); w.z = cvt_pk_bf16(b[0], b[1]); w.w = cvt_pk_bf16(b[2], b[3]); return w; }
__device__ __forceinline__ float dot4(const f32x4 v) { return (v[0] * v[0] + v[1] * v[1]) + (v[2] * v[2] + v[3] * v[3]); }
__device__ __forceinline__ float silu1(float z) { return z * __builtin_amdgcn_rcpf(1.0f + __builtin_amdgcn_exp2f(-z * LOG2E)); }
__device__ __forceinline__ float sum16(const float* p) { const f32x4 a = *(const f32x4*)p, b = *(const f32x4*)(p + 4), c = *(const f32x4*)(p + 8), d = *(const f32x4*)(p + 12);
    return (((a[0] + a[1]) + (a[2] + a[3])) + ((b[0] + b[1]) + (b[2] + b[3]))) + (((c[0] + c[1]) + (c[2] + c[3])) + ((d[0] + d[1]) + (d[2] + d[3]))); }
__device__ __forceinline__ float sum4(const float* p) { const f32x4 a = *(const f32x4*)p; return (a[0] + a[1]) + (a[2] + a[3]); }

struct EpiConvIn {
    static constexpr bool PERM = false, AFTER_DRAIN = false;
    PG8_LAS const float* convw; bf16_t* g; float* whead; float* pchead; float* utail;
    __device__ __forceinline__ void operator()(const f32x4 (&acc)[2][2][4][2], const Unit& u, int wr, int wc, int fr, int fq) const {
        asm volatile("" : "+v"(fr), "+v"(fq));
        const int lane = fq * 16 + fr, ch0 = u.pn * 64 + wc * 16 + fq * 4;
        const f32x4 cw0 = *(PG8_LAS const f32x4*)(convw + ch0), cw1 = *(PG8_LAS const f32x4*)(convw + DM + ch0), cw2 = *(PG8_LAS const f32x4*)(convw + 2 * DM + ch0);
        (void)lane;
#pragma unroll
        for (int ai = 0; ai < 2; ++ai) {
            const int rowc = u.pm * BM + ai * HALF + wr * 64, chunk = rowc >> 6;
            f32x4 r1p = (f32x4){0.f, 0.f, 0.f, 0.f}, r2p = r1p;
#pragma unroll
            for (int m = 0; m < 4; ++m) {
                const int row = rowc + m * 16 + fr;
                const f32x4 bg = acc[ai][0][m][0], cg = acc[ai][0][m][1], xv = acc[ai][1][m][0], z = acc[ai][1][m][1];
                const f32x4 uu = cg * xv; f32x4 w, p1, p2;
                f32x4 r1, r2;
#pragma unroll
                for (int e = 0; e < 4; ++e) { w[e] = silu1(z[e]) * bg[e];
                    r1[e] = __int_as_float(__builtin_amdgcn_update_dpp(0, __float_as_int(uu[e]), 0x121, 0xf, 0xf, false));
                    r2[e] = __int_as_float(__builtin_amdgcn_update_dpp(0, __float_as_int(uu[e]), 0x122, 0xf, 0xf, false));
                    p1[e] = fr >= 1 ? r1[e] : r1p[e]; p2[e] = fr >= 2 ? r2[e] : r2p[e]; }
                const f32x4 conv = cw2 * uu + cw1 * p1 + cw0 * p2;
                if (m == 0 && fr < 2) { *(f32x4*)(whead + (size_t)(chunk * 2 + fr) * DM + ch0) = w; *(f32x4*)(pchead + (size_t)(chunk * 2 + fr) * DM + ch0) = conv; }
                else { *(u32x2*)(g + (size_t)row * DM + ch0) = pack4(w * conv); }
                if (m == 3 && fr >= 14) *(f32x4*)(utail + (size_t)(chunk * 2 + fr - 14) * DM + ch0) = uu;
                r1p = r1; r2p = r2;
            }
        }
    }
};

struct EpiResid {
    static constexpr bool PERM = false, AFTER_DRAIN = false;
    const bf16_t* xin; bf16_t* xo; float* ssq; const float* rinv;
    __device__ __forceinline__ void operator()(const f32x4 (&acc)[2][2][4][2], const Unit& u, int wr, int wc, int fr, int fq, int only = -1) const {
        asm volatile("" : "+v"(fr), "+v"(fq));
        const unsigned col0 = (unsigned)(u.pn * BM + wc * 32 + 8 * fq);
#pragma unroll
        for (int ai = 0; ai < 2; ++ai)
#pragma unroll
            for (int m = 0; m < 4; ++m) { if (only >= 0 && only != ai * 4 + m) continue; const unsigned row = (unsigned)(u.pm * BM + ai * HALF + wr * 64 + m * 16 + fr), off = row * DM + col0; float ss = 0.f; const float ri = rinv ? rinv[row] : 1.f;
#pragma unroll
                for (int bj = 0; bj < 2; ++bj) { const u32x4 xi = __builtin_nontemporal_load((const u32x4*)(xin + (off + bj * HALF))); f32x4 a = acc[ai][bj][m][0], b = acc[ai][bj][m][1];
                    a[0] = fmaf(__uint_as_float(xi.x << 16), ri, a[0]); a[1] = fmaf(__uint_as_float(xi.x & 0xffff0000u), ri, a[1]); a[2] = fmaf(__uint_as_float(xi.y << 16), ri, a[2]); a[3] = fmaf(__uint_as_float(xi.y & 0xffff0000u), ri, a[3]);
                    b[0] = fmaf(__uint_as_float(xi.z << 16), ri, b[0]); b[1] = fmaf(__uint_as_float(xi.z & 0xffff0000u), ri, b[1]); b[2] = fmaf(__uint_as_float(xi.w << 16), ri, b[2]); b[3] = fmaf(__uint_as_float(xi.w & 0xffff0000u), ri, b[3]);
                    ss += dot4(a) + dot4(b); *(u32x4*)(xo + (off + bj * HALF)) = pack8(a, b); }
                ss += __shfl_xor(ss, 16); ss += __shfl_xor(ss, 32);
                if (fq == 0) ssq[row * 16u + u.pn * 4 + wc] = ss;
                if (m & 1) asm volatile("" ::: "memory"); }
    }
};

struct EpiResidNorm {
    static constexpr bool PERM = false, AFTER_DRAIN = false;
    const bf16_t* xin; float* y; const float* gf; float* xs; PG8_LAS float* sc;
    __device__ __forceinline__ void operator()(f32x4 (&acc)[2][2][4][2], const Unit& u, int wr, int wc, int fr, int fq, int only = -1) const {
        asm volatile("" : "+v"(fr), "+v"(fq));
        const unsigned col0 = (unsigned)(u.pn * BM + wc * 32 + 8 * fq);
#pragma unroll
        for (int ai = 0; ai < 2; ++ai)
#pragma unroll
            for (int m = 0; m < 4; ++m) { if (only >= 0 && only != ai * 4 + m) continue; const int rl = ai * HALF + wr * 64 + m * 16 + fr; const unsigned off = (unsigned)(u.pm * BM + rl) * DM + col0; float ss = 0.f;
#pragma unroll
                for (int bj = 0; bj < 2; ++bj) { const u32x4 xi = __builtin_nontemporal_load((const u32x4*)(xin + (off + bj * HALF))); f32x4 a = acc[ai][bj][m][0], b = acc[ai][bj][m][1];
                    a[0] += __uint_as_float(xi.x << 16); a[1] += __uint_as_float(xi.x & 0xffff0000u); a[2] += __uint_as_float(xi.y << 16); a[3] += __uint_as_float(xi.y & 0xffff0000u);
                    b[0] += __uint_as_float(xi.z << 16); b[1] += __uint_as_float(xi.z & 0xffff0000u); b[2] += __uint_as_float(xi.w << 16); b[3] += __uint_as_float(xi.w & 0xffff0000u);
                    ss += dot4(a) + dot4(b); acc[ai][bj][m][0] = a; acc[ai][bj][m][1] = b; }
                ss += __shfl_xor(ss, 16); ss += __shfl_xor(ss, 32);
                if (fq == 0) sc[rl * 4 + wc] = ss; }
        const int t = (wr * 4 + wc) * 64 + fq * 16 + fr;
        asm volatile("s_waitcnt lgkmcnt(0)" ::: "memory"); __builtin_amdgcn_s_barrier();
        if (t < 256 && (only < 0 || only == ((t >> 7) * 4 + ((t >> 4) & 3)))) { const f32x4 q4 = *(const PG8_LAS f32x4*)(sc + t * 4);   const float mine = (q4[0] + q4[1]) + (q4[2] + q4[3]);
            float* sl = xs + ((unsigned)(u.pm * 4) * 256u + t);
            __hip_atomic_store(sl + u.pn * 256, mine, __ATOMIC_RELAXED, __HIP_MEMORY_SCOPE_AGENT);
            float v[4]; unsigned sp = 0; bool ok;
            do { ok = true;
#pragma unroll
                for (int q = 0; q < 4; ++q) v[q] = __hip_atomic_load(sl + q * 256, __ATOMIC_RELAXED, __HIP_MEMORY_SCOPE_AGENT);
#pragma unroll
                for (int q = 0; q < 4; ++q) ok = ok && (q == u.pn || __float_as_uint(v[q]) != 0xFFFFFFFFu);
            } while (!ok && ++sp < (1u << 20));
#pragma unroll
            for (int q = 0; q < 4; ++q) v[q] = (q == u.pn) ? mine : v[q];
            sc[1024 + t] = 1.0f / sqrtf(((v[0] + v[1]) + (v[2] + v[3])) * (1.0f / DM) + EPS); }
        asm volatile("s_waitcnt lgkmcnt(0)" ::: "memory"); __builtin_amdgcn_s_barrier();
#pragma unroll
        for (int ai = 0; ai < 2; ++ai)
#pragma unroll
            for (int m = 0; m < 4; ++m) { if (only >= 0 && only != ai * 4 + m) continue; const int rl = ai * HALF + wr * 64 + m * 16 + fr; const float rs = sc[1024 + rl]; float* yr = y + ((unsigned)(u.pm * BM + rl) * DM + col0);
#pragma unroll
                for (int bj = 0; bj < 2; ++bj) { const f32x4 g0 = *(const f32x4*)(gf + col0 + bj * HALF), g1 = *(const f32x4*)(gf + col0 + bj * HALF + 4);
                    *(f32x4*)(yr + bj * HALF) = acc[ai][bj][m][0] * rs * g0; *(f32x4*)(yr + bj * HALF + 4) = acc[ai][bj][m][1] * rs * g1; } }
        asm volatile("s_waitcnt lgkmcnt(0)" ::: "memory"); __builtin_amdgcn_s_barrier();
    }
};

struct EpiMlaIn {
    static constexpr bool PERM = false, AFTER_DRAIN = false;
    const float* ssq1; const float* gkv; const float* rope; bf16_t* qlat; bf16_t* ckva; bf16_t* krp; bf16_t* krs; bf16_t* sz; float* out; float* ssqkv; PG8_LAS float* sc;
    __device__ __forceinline__ void operator()(const f32x4 (&acc)[2][2][4][2], const Unit& u, int wr, int wc, int fr, int fq, int only = -1) const {
        asm volatile("" : "+v"(fr), "+v"(fq));
        float rsv[2][4];
        { f32x4 q4[2][4];
#pragma unroll
          for (int ai = 0; ai < 2; ++ai)
#pragma unroll
            for (int m = 0; m < 4; ++m) q4[ai][m] = *(const f32x4*)(ssq1 + (size_t)(u.pm * BM + ai * HALF + wr * 64 + m * 16 + fr) * 16 + 4 * fq);
#pragma unroll
          for (int ai = 0; ai < 2; ++ai)
#pragma unroll
            for (int m = 0; m < 4; ++m) rsv[ai][m] = (q4[ai][m][0] + q4[ai][m][1]) + (q4[ai][m][2] + q4[ai][m][3]);
#pragma unroll
          for (int ai = 0; ai < 2; ++ai)
#pragma unroll
            for (int m = 0; m < 4; ++m) rsv[ai][m] += __shfl_xor(rsv[ai][m], 16);
#pragma unroll
          for (int ai = 0; ai < 2; ++ai)
#pragma unroll
            for (int m = 0; m < 4; ++m) { rsv[ai][m] += __shfl_xor(rsv[ai][m], 32); rsv[ai][m] = 1.0f / sqrtf(rsv[ai][m] * (1.0f / DM) + EPS); } }
        if (u.pn < 2) {
            const bool isq = u.pn == 0;
            const f32x4 gk0 = *(const f32x4*)(gkv + wc * 32 + 4 * fq), gk1 = *(const f32x4*)(gkv + wc * 32 + 16 + 4 * fq);
#pragma unroll
            for (int ai = 0; ai < 2; ++ai)
#pragma unroll
                for (int m = 0; m < 4; ++m) { if (only >= 0 && only != ai * 4 + m) continue; const int rl = ai * HALF + wr * 64 + m * 16 + fr; const float rs = rsv[ai][m];
                    const f32x4 a0 = acc[ai][0][m][0] * rs, a1 = acc[ai][0][m][1] * rs; float ss = dot4(a0) + dot4(a1);
                    if (isq) { const f32x4 b0 = acc[ai][1][m][0] * rs, b1 = acc[ai][1][m][1] * rs; ss += dot4(b0) + dot4(b1); }
                    ss += __shfl_xor(ss, 16); ss += __shfl_xor(ss, 32);
                    if (fq == 0) sc[rl * 4 + wc] = ss; }
            asm volatile("s_waitcnt lgkmcnt(0)" ::: "memory"); __builtin_amdgcn_s_barrier();
#pragma unroll
            for (int ai = 0; ai < 2; ++ai)
#pragma unroll
                for (int m = 0; m < 4; ++m) { if (only >= 0 && only != ai * 4 + m) continue; const int rl = ai * HALF + wr * 64 + m * 16 + fr, row = u.pm * BM + rl; const float rs = rsv[ai][m];
                    const f32x4 q = *(const PG8_LAS f32x4*)(sc + rl * 4); const float tot = (q[0] + q[1]) + (q[2] + q[3]);
                    if (isq) { const float f = rs / sqrtf(tot * (1.0f / QL) + EPS);
#pragma unroll
                        for (int bj = 0; bj < 2; ++bj) *(u32x4*)(qlat + (size_t)row * QL + bj * HALF + wc * 32 + 8 * fq) = pack8(acc[ai][bj][m][0] * f, acc[ai][bj][m][1] * f);
                    } else { const float r2 = 1.0f / sqrtf(tot * (1.0f / KVL) + EPS), f = rs * r2;
                        if (fq == 0) ssqkv[(size_t)row * 4 + wc] = q[wc] * (r2 * r2);
                        float* co = out + (row < MP ? O_CKVP + (size_t)row * KVL : O_CKVS + (size_t)(row - MP) * KVL); bf16_t* cb = ckva + (size_t)(row < MP ? row : row + SB * PAST) * KVL;
#pragma unroll
                        for (int n = 0; n < 2; ++n) { const int c = wc * 32 + n * 16 + 4 * fq; const f32x4 v = acc[ai][0][m][n] * f * (n == 0 ? gk0 : gk1); *(f32x4*)(co + c) = v; *(u32x2*)(cb + c) = pack4(v); }
                        if (wc == 0) {
                            const int pos = row < MP ? (row & (SEQ - 1)) : PAST + ((row - MP) & (ST - 1));
                            const f32x4 cs = *(const f32x4*)(rope + (size_t)pos * 32 + 4 * fq), sn = *(const f32x4*)(rope + (size_t)pos * 32 + 16 + 4 * fq);
                            const f32x4 x1 = acc[ai][1][m][0] * rs, x2 = acc[ai][1][m][1] * rs, o1 = x1 * cs - x2 * sn, o2 = x2 * cs + x1 * sn;
                            float* ko = out + (row < MP ? O_KRP + (size_t)row * DR : O_KRS + (size_t)(row - MP) * DR);
                            *(f32x4*)(ko + 4 * fq) = o1; *(f32x4*)(ko + 16 + 4 * fq) = o2;
                            bf16_t* kb = row < MP ? krp + (((unsigned)row >> 6) * 2048u + ((unsigned)row & 63) * 8u) : krs + ((((unsigned)(row - MP) >> 6) * (SKVP / 64) + PAST / 64) * 2048u + ((unsigned)(row - MP) & 63) * 8u);
                            *(u32x2*)(kb + (fq >> 1) * 512 + 4 * (fq & 1)) = pack4(o1); *(u32x2*)(kb + (2 + (fq >> 1)) * 512 + 4 * (fq & 1)) = pack4(o2); } }
                    asm volatile("" ::: "memory"); }
        } else {
#pragma unroll
            for (int ai = 0; ai < 2; ++ai)
#pragma unroll
                for (int m = 0; m < 4; ++m) { if (only >= 0 && only != ai * 4 + m) continue; const int row = u.pm * BM + ai * HALF + wr * 64 + m * 16 + fr; const float rs = rsv[ai][m];
#pragma unroll
                    for (int bj = 0; bj < 2; ++bj) { f32x4 a = acc[ai][bj][m][0] * rs, b = acc[ai][bj][m][1] * rs;
#pragma unroll
                        for (int e = 0; e < 4; ++e) { a[e] = silu1(a[e]); b[e] = silu1(b[e]); }
                        *(u32x4*)(sz + (size_t)row * DM + (u.pn - 2) * BM + bj * HALF + wc * 32 + 8 * fq) = pack8(a, b); }
                    asm volatile("" ::: "memory"); }
        }
    }
};


template <class Inner> struct EpiSplit {
    static constexpr bool PERM = Inner::PERM, AFTER_DRAIN = false;
    Inner in; float* scr; unsigned* cnt; int tu, slice;
    __device__ __forceinline__ void operator()(f32x4 (&acc)[2][2][4][2], const Unit& u, int wr, int wc, int fr, int fq) const {
        int lane_ = fq * 16 + fr; asm volatile("" : "+v"(lane_));
        const unsigned tid = (unsigned)((wr * 4 + wc) * 64 + lane_);
        f32x4* mine = (f32x4*)scr + ((size_t)(tu * 8 + slice) * 32u) * 512u + tid;
#pragma unroll
        for (int ai = 0; ai < 2; ++ai)
#pragma unroll
            for (int bj = 0; bj < 2; ++bj)
#pragma unroll
                for (int m = 0; m < 4; ++m)
#pragma unroll
                    for (int n = 0; n < 2; ++n) mine[(unsigned)(((ai * 2 + bj) * 4 + m) * 2 + n) * 512u] = acc[ai][bj][m][n];
        asm volatile("s_waitcnt vmcnt(0)" ::: "memory"); __builtin_amdgcn_s_barrier();
        if (tid == 0) { unsigned* c = cnt + tu * 16;
            __builtin_amdgcn_fence(__ATOMIC_RELEASE, "agent"); asm volatile("s_waitcnt vmcnt(0)" ::: "memory");
            (void)__hip_atomic_fetch_add(c, 1u, __ATOMIC_RELAXED, __HIP_MEMORY_SCOPE_AGENT);
            unsigned sp = 0; while (__hip_atomic_load(c, __ATOMIC_RELAXED, __HIP_MEMORY_SCOPE_AGENT) < 8u && ++sp < (1u << 22)) __builtin_amdgcn_s_sleep(1);
            __builtin_amdgcn_fence(__ATOMIC_ACQUIRE, "agent"); asm volatile("s_waitcnt vmcnt(0)" ::: "memory"); }
        __builtin_amdgcn_s_barrier();
        const f32x4* all = (const f32x4*)scr + ((size_t)(tu * 8) * 32u) * 512u + tid;
#pragma unroll
        for (int ai = 0; ai < 2; ++ai)
#pragma unroll
            for (int m = 0; m < 4; ++m) { if (slice != ai * 4 + m) continue;
#pragma unroll
                for (int bj = 0; bj < 2; ++bj)
#pragma unroll
                    for (int n = 0; n < 2; ++n) { const unsigned f = (unsigned)(((ai * 2 + bj) * 4 + m) * 2 + n) * 512u; f32x4 t = all[f];
#pragma unroll
                        for (int s = 1; s < 8; ++s) t += all[(unsigned)s * (32u * 512u) + f];
                        acc[ai][bj][m][n] = t; } }
        in(acc, u, wr, wc, fr, fq, slice);
    }
};

struct EpiQ {
    static constexpr bool PERM = false, AFTER_DRAIN = false;
    const float* ssqq; const float* rope; bf16_t* Qp; bf16_t* Qs;
    __device__ __forceinline__ void operator()(const f32x4 (&acc)[2][2][4][2], const Unit& u, int wr, int wc, int fr, int fq) const {
        asm volatile("" : "+v"(fr), "+v"(fq));
        const bool smp = u.pm * BM >= MP;
        bf16_t* Qb = smp ? Qs : Qp; const unsigned hs = smp ? (unsigned)(ST * DQK) : (unsigned)(SEQ * DQK);
#pragma unroll
        for (int ai = 0; ai < 2; ++ai) {
            f32x4 csv[4], snv[4];
            if (u.pn >= 4) {
#pragma unroll
                for (int m = 0; m < 4; ++m) { const int row = u.pm * BM + ai * HALF + wr * 64 + m * 16 + fr; const int pos = smp ? PAST + ((row - MP) & 63) : (row & (SEQ - 1));
                    csv[m] = *(const f32x4*)(rope + (unsigned)(pos * 32 + 4 * fq)); snv[m] = *(const f32x4*)(rope + (unsigned)(pos * 32 + 16 + 4 * fq)); }
            }
#pragma unroll
            for (int m = 0; m < 4; ++m) { const int row = u.pm * BM + ai * HALF + wr * 64 + m * 16 + fr;
                const float rq = 1.f;
                unsigned qo; int pos;
                if (!smp) { const unsigned b = (unsigned)row >> 13, s = (unsigned)row & (SEQ - 1); qo = (b * (NH * SEQ) + s) * DQK; pos = (int)s; }
                else { const unsigned r2 = (unsigned)(row - MP), b = r2 >> 6, s = r2 & 63; qo = (b * (NH * ST) + s) * DQK; pos = PAST + (int)s; }
                if (u.pn < 4) {
#pragma unroll
                    for (int bj = 0; bj < 2; ++bj) { const unsigned L = (unsigned)(u.pn * BM + bj * HALF + wc * 32 + 8 * fq), head = L >> 6, d = L & 63;
                        *(u32x4*)(Qb + (qo + head * hs + d)) = pack8(acc[ai][bj][m][0] * rq, acc[ai][bj][m][1] * rq); }
                } else {
                    const f32x4 cs = csv[m], sn = snv[m];
#pragma unroll
                    for (int bj = 0; bj < 2; ++bj) { const unsigned head = (unsigned)((u.pn - 4) * 8 + bj * 4 + wc);
                        const f32x4 x1 = acc[ai][bj][m][0] * rq, x2 = acc[ai][bj][m][1] * rq, o1 = x1 * cs - x2 * sn, o2 = x2 * cs + x1 * sn;
                        *(u32x2*)(Qb + (qo + head * hs + DN + 4 * fq)) = pack4(o1); *(u32x2*)(Qb + (qo + head * hs + DN + 16 + 4 * fq)) = pack4(o2); }
                }
                asm volatile("" ::: "memory");
            } }
    }
};

struct EpiKV {
    static constexpr bool PERM = false, AFTER_DRAIN = false;
    const float* ssqkv; bf16_t* K; bf16_t* V; float* out; int fix;
    __device__ __forceinline__ void operator()(const f32x4 (&acc)[2][2][4][2], const Unit& u, int wr, int wc, int fr, int fq) const {
        asm volatile("" : "+v"(fr), "+v"(fq));
        const bool isK = u.pn < 4; bf16_t* T = isK ? K : V; const int pn4 = u.pn & 3;
        const int cat = u.pm * BM < MP ? 0 : (u.pm * BM < MP + SB * PAST ? 1 : 2);
        const unsigned hs = cat == 0 ? (unsigned)(SEQ * DN) : (unsigned)(SKVP * DN);
        const int rbase = cat == 0 ? u.pm * BM : (cat == 2 ? u.pm * BM - SB * PAST : -1);
        float rkv[2][4];
        { f32x4 sq[2][4];
          if (rbase >= 0) {
#pragma unroll
            for (int ai = 0; ai < 2; ++ai)
#pragma unroll
                for (int m = 0; m < 4; ++m) sq[ai][m] = *(const f32x4*)(ssqkv + (unsigned)(rbase + ai * HALF + wr * 64 + m * 16 + fr) * 4u);
          }
#pragma unroll
          for (int ai = 0; ai < 2; ++ai)
#pragma unroll
            for (int m = 0; m < 4; ++m) rkv[ai][m] = rbase >= 0 ? 1.0f / sqrtf(((sq[ai][m][0] + sq[ai][m][1]) + (sq[ai][m][2] + sq[ai][m][3])) * (1.0f / KVL) + EPS) : 1.f; }
#pragma unroll
        for (int ai = 0; ai < 2; ++ai)
#pragma unroll
            for (int m = 0; m < 4; ++m) { const unsigned R = (unsigned)(u.pm * BM + ai * HALF + wr * 64 + m * 16 + fr);
                unsigned sb, s; float rk = 1.f; int r = -1;
                if (cat == 0) { const unsigned b = R >> 13; s = R & (SEQ - 1); sb = b * (NH * SEQ * DN); r = (int)R; }
                else if (cat == 1) { const unsigned r2 = R - MP, b = r2 >> 12; s = r2 & (PAST - 1); sb = (unsigned)KP_ELEMS + b * (NH * SKVP * DN); }
                else { const unsigned r2 = R - MP - SB * PAST, b = r2 >> 6; s = PAST + (r2 & 63); sb = (unsigned)KP_ELEMS + b * (NH * SKVP * DN); r = MP + (int)r2; }
                rk = rkv[ai][m];
                const unsigned key = s & 63, kk = key, tb = sb + (s >> 6) * 4096u;
#pragma unroll
                for (int bj = 0; bj < 2; ++bj) { const unsigned L = (unsigned)(pn4 * BM + bj * HALF + wc * 32 + 8 * fq), head = L >> 6, c = (L & 63) >> 3;
                    const unsigned off = isK ? c * 512u + key * 8u : ((kk >> 3) * 2 + (c >> 2)) * 256u + (kk & 7) * 32u + (c & 3) * 8u;
                    *(u32x4*)(T + (tb + head * hs + off)) = pack8(acc[ai][bj][m][0] * rk, acc[ai][bj][m][1] * rk); }
                if (fix && u.pn == 0 && r >= 0) { float* co = out + ((unsigned)(r < MP ? O_CKVP : O_CKVS - (size_t)MP * KVL) + (unsigned)r * KVL + wc * 32 + 8 * fq);
                    const f32x4 a = *(const f32x4*)co, b = *(const f32x4*)(co + 4); *(f32x4*)co = a * rk; *(f32x4*)(co + 4) = b * rk; }
                asm volatile("" ::: "memory");
            }
    }
};

template <class Epi, class Sched, bool ALIGN_EPI = false, bool SP2 = false>
__device__ __forceinline__ void gemm_phase(PG8_LAS unsigned char* lds, const Gemm g, const Sched& S, const Epi& E) {
    int tid_ = threadIdx.x; asm volatile("" : "+v"(tid_));
    const int tid = tid_, wid = __builtin_amdgcn_readfirstlane(tid >> 6), lane = tid & 63, wr = wid >> 2, wc = wid & 3, fr = lane & 15, fq = lane >> 4;
    const int K = g.K, nt = g.kt > 0 ? g.kt : K / BK;
    unsigned voffA[2], voffB[2];
#pragma unroll
    for (int i = 0; i < 2; ++i) { int R, C; stage_rc(tid * 16 + i * 8192, R, C); const int Rb = Epi::PERM ? ((R & ~31) + perm32(R & 31)) : R;
        voffA[i] = (unsigned)(R * K + C) * 2u; voffB[i] = (unsigned)(Rb * K + C) * 2u; }
    const size_t kstep = (size_t)(BK * 2);
    const size_t hstep = (size_t)HALF * K * 2;
    const size_t tstep = 2 * hstep;
    const unsigned ldsw = (unsigned)wid * 1024u;
    const int aoff = lds_byte(wr * 64 + fr, fq * 8), boff = lds_byte(wc * 32 + fr, fq * 8);
#define PG8_SA(b, h) (((b) * 2 + (h)) * HTB)
#define PG8_SB(b, h) ((4 + (b) * 2 + (h)) * HTB)
#define PG8_STAGE(bufoff, gbase, voff) do { _Pragma("unroll") for (int _i = 0; _i < 2; ++_i) \
        __builtin_amdgcn_global_load_lds((const unsigned*)((const char*)(gbase) + (voff)[_i]), (PG8_LAS unsigned*)(lds + (bufoff) + ldsw + _i * 8192), 16, 0, 0); } while (0)
#define PG8_LDA(dst, b, h) do { _Pragma("unroll") for (int m = 0; m < 4; ++m) _Pragma("unroll") for (int k = 0; k < 2; ++k) dst[m][k] = *(const PG8_LAS bf16x8*)(lds + PG8_SA(b, h) + aoff + m * 2048 + k * 1024); } while (0)
#define PG8_LDB(dst, b, h) do { _Pragma("unroll") for (int n = 0; n < 2; ++n) _Pragma("unroll") for (int k = 0; k < 2; ++k) dst[n][k] = *(const PG8_LAS bf16x8*)(lds + PG8_SB(b, h) + boff + n * 2048 + k * 1024); } while (0)
#define PG8_MMA(ai, bj, At, Bt) do { __builtin_amdgcn_s_setprio(1); _Pragma("unroll") for (int m = 0; m < 4; ++m) _Pragma("unroll") for (int n = 0; n < 2; ++n) _Pragma("unroll") for (int k = 0; k < 2; ++k) \
        acc[ai][bj][m][n] = __builtin_amdgcn_mfma_f32_16x16x32_bf16(Bt[n][k], At[m][k], acc[ai][bj][m][n], 0, 0, 0); __builtin_amdgcn_s_setprio(0); } while (0)
#define PG8_WAIT_V(n) asm volatile("s_waitcnt vmcnt(" #n ")" ::: "memory")
#define PG8_WAIT_L(n) asm volatile("s_waitcnt lgkmcnt(" #n ")" ::: "memory")
#define PG8_BAR __builtin_amdgcn_s_barrier()
#define PG8_SCHED __builtin_amdgcn_sched_barrier(0)
    Unit cur, nxt; int ui = 0;
    if (!S.next(0, cur)) return;
    f32x4 acc[2][2][4][2];
#pragma unroll
    for (int a = 0; a < 2; ++a)
#pragma unroll
        for (int b = 0; b < 2; ++b)
#pragma unroll
            for (int m = 0; m < 4; ++m)
#pragma unroll
                for (int n = 0; n < 2; ++n) acc[a][b][m][n] = (f32x4){0.f, 0.f, 0.f, 0.f};
    bf16x8 At[4][2], B0[2][2], B1[2][2];
    const char* cA = (const char*)g.A + (size_t)cur.pm * tstep; const char* cB = (const char*)g.Bt + (size_t)cur.pn * tstep;
    S.a_ready(cur);
    if constexpr (SP2) {
        PG8_STAGE(PG8_SB(0, 0), cB, voffB); PG8_STAGE(PG8_SB(0, 1), cB + hstep, voffB); PG8_STAGE(PG8_SA(0, 0), cA, voffA); PG8_STAGE(PG8_SA(0, 1), cA + hstep, voffA);
        if (wr == 1) PG8_BAR;
        PG8_WAIT_V(2); PG8_BAR;
        PG8_STAGE(PG8_SB(1, 0), cB + kstep, voffB); PG8_STAGE(PG8_SA(1, 0), cA + kstep, voffA); PG8_STAGE(PG8_SB(1, 1), cB + hstep + kstep, voffB);
        PG8_WAIT_V(6); PG8_BAR;
    } else {
        PG8_STAGE(PG8_SB(0, 0), cB, voffB); PG8_STAGE(PG8_SA(0, 0), cA, voffA); PG8_STAGE(PG8_SB(0, 1), cB + hstep, voffB); PG8_STAGE(PG8_SA(0, 1), cA + hstep, voffA);
        if (wr == 1) PG8_BAR;
        PG8_WAIT_V(4); PG8_BAR;
        PG8_STAGE(PG8_SB(1, 0), cB + kstep, voffB); PG8_STAGE(PG8_SA(1, 0), cA + kstep, voffA); PG8_STAGE(PG8_SB(1, 1), cB + hstep + kstep, voffB);
        PG8_WAIT_V(6); PG8_BAR;
    }
    for (;;) {
        const bool has_next = S.next(ui + 1, nxt);
        const char* nA = has_next ? (const char*)g.A + (size_t)nxt.pm * tstep : cA; const char* nB = has_next ? (const char*)g.Bt + (size_t)nxt.pn * tstep : cB;
#pragma unroll 1
        for (int t = 0; t < nt; t += 2) {
            const bool last = (t == nt - 2);
            const char* a1 = cA + (size_t)(t + 1) * kstep;
            const char* a2 = last ? nA : cA + (size_t)(t + 2) * kstep; const char* b2 = last ? nB : cB + (size_t)(t + 2) * kstep;
            const char* a3 = a2 + kstep; const char* b3 = b2 + kstep;
            if (last && has_next) S.a_ready(nxt);
            if constexpr (SP2) {
            PG8_LDB(B0, 0, 0); PG8_LDB(B1, 0, 1); PG8_SCHED; PG8_LDA(At, 0, 0); PG8_STAGE(PG8_SA(1, 1), a1 + hstep, voffA);
            PG8_WAIT_V(8); PG8_WAIT_L(0); PG8_BAR; PG8_MMA(0, 0, At, B0); PG8_MMA(0, 1, At, B1); PG8_BAR; PG8_SCHED;
            PG8_LDA(At, 0, 1); PG8_STAGE(PG8_SB(0, 0), b2, voffB); PG8_STAGE(PG8_SB(0, 1), b2 + hstep, voffB); PG8_STAGE(PG8_SA(0, 0), a2, voffA);
            PG8_WAIT_V(8); PG8_WAIT_L(0); PG8_BAR; PG8_MMA(1, 0, At, B0); PG8_MMA(1, 1, At, B1); PG8_BAR; PG8_SCHED;
            PG8_LDB(B0, 1, 0); PG8_LDB(B1, 1, 1); PG8_SCHED; PG8_LDA(At, 1, 0); PG8_STAGE(PG8_SA(0, 1), a2 + hstep, voffA);
            PG8_WAIT_V(8); PG8_WAIT_L(0); PG8_BAR; PG8_MMA(0, 0, At, B0); PG8_MMA(0, 1, At, B1); PG8_BAR; PG8_SCHED;
            PG8_LDA(At, 1, 1); PG8_STAGE(PG8_SB(1, 0), b3, voffB); PG8_STAGE(PG8_SB(1, 1), b3 + hstep, voffB); PG8_STAGE(PG8_SA(1, 0), a3, voffA);
            PG8_WAIT_V(8); PG8_WAIT_L(0); PG8_BAR; PG8_MMA(1, 0, At, B0); PG8_MMA(1, 1, At, B1); PG8_BAR; PG8_SCHED;
            } else {
            PG8_LDB(B0, 0, 0); PG8_SCHED; PG8_LDA(At, 0, 0); PG8_STAGE(PG8_SA(1, 1), a1 + hstep, voffA);
            PG8_WAIT_L(8); PG8_BAR; PG8_WAIT_L(0); PG8_MMA(0, 0, At, B0); PG8_BAR; PG8_SCHED;
            PG8_LDB(B1, 0, 1); PG8_STAGE(PG8_SB(0, 0), b2, voffB);
            PG8_BAR; PG8_WAIT_L(0); PG8_MMA(0, 1, At, B1); PG8_BAR;
            PG8_LDA(At, 0, 1); PG8_STAGE(PG8_SA(0, 0), a2, voffA);
            PG8_BAR; PG8_WAIT_L(0); PG8_MMA(1, 0, At, B0); PG8_BAR; PG8_SCHED;
            PG8_STAGE(PG8_SB(0, 1), b2 + hstep, voffB);
            PG8_WAIT_V(6); PG8_BAR; PG8_MMA(1, 1, At, B1); PG8_BAR;
            PG8_LDB(B0, 1, 0); PG8_SCHED; PG8_LDA(At, 1, 0); PG8_STAGE(PG8_SA(0, 1), a2 + hstep, voffA);
            PG8_WAIT_L(8); PG8_BAR; PG8_WAIT_L(0); PG8_MMA(0, 0, At, B0); PG8_BAR; PG8_SCHED;
            PG8_LDB(B1, 1, 1); PG8_STAGE(PG8_SB(1, 0), b3, voffB);
            PG8_BAR; PG8_WAIT_L(0); PG8_MMA(0, 1, At, B1); PG8_BAR;
            PG8_LDA(At, 1, 1); PG8_STAGE(PG8_SA(1, 0), a3, voffA);
            PG8_BAR; PG8_WAIT_L(0); PG8_MMA(1, 0, At, B0); PG8_BAR; PG8_SCHED;
            PG8_STAGE(PG8_SB(1, 1), b3 + hstep, voffB);
            PG8_WAIT_V(6); PG8_BAR; PG8_MMA(1, 1, At, B1); PG8_BAR;
            }
        }
        if constexpr (ALIGN_EPI) { if (wr == 0) PG8_BAR; }
        if constexpr (!Epi::AFTER_DRAIN) { E(acc, cur, wr, wc, fr, fq); S.done(cur); }
        if (!has_next) break;
#pragma unroll
        for (int a = 0; a < 2; ++a)
#pragma unroll
            for (int b = 0; b < 2; ++b)
#pragma unroll
                for (int m = 0; m < 4; ++m)
#pragma unroll
                    for (int n = 0; n < 2; ++n) acc[a][b][m][n] = (f32x4){0.f, 0.f, 0.f, 0.f};
        cur = nxt; cA = nA; cB = nB; ++ui;
        if constexpr (ALIGN_EPI) { if (wr == 1) PG8_BAR; }
    }
    PG8_WAIT_V(0);
    if constexpr (!ALIGN_EPI) { if (wr == 0) PG8_BAR; }
    PG8_BAR;
    if constexpr (Epi::AFTER_DRAIN) { E.fused(acc, cur, wr, wc, fr, fq, lds, wid, lane); S.done(cur); }
#undef PG8_SA
#undef PG8_SB
#undef PG8_STAGE
#undef PG8_LDA
#undef PG8_LDB
#undef PG8_MMA
#undef PG8_WAIT_V
#undef PG8_WAIT_L
#undef PG8_BAR
#undef PG8_SCHED
}
}
namespace att {
using bf16x8 = __attribute__((ext_vector_type(8))) short;
using s16x4  = __attribute__((ext_vector_type(4))) short;
using f32x16 = __attribute__((ext_vector_type(16))) float;
using f32x4  = __attribute__((ext_vector_type(4))) float;
using u32x4  = __attribute__((ext_vector_type(4))) unsigned;
using u32x2  = __attribute__((ext_vector_type(2))) unsigned;
typedef unsigned short bf16_t;
constexpr int NW = 8, QBLK = 32, KVBLK = 64;
constexpr int KSLOT = 12288, VSLOT = 8192, OSTP = 68, NSLOT = 4;
constexpr int L_K = 0, L_V = NSLOT * KSLOT, L_WS = L_V + NSLOT * VSLOT, L_OST = L_WS + NW * 256, L_END = L_OST + NW * 32 * OSTP * 4;
constexpr float THR = 8.f;
#define SBAR() __builtin_amdgcn_sched_barrier(0)
__device__ __forceinline__ int crow(int r, int hi) { return (r & 3) + 8 * (r >> 2) + 4 * hi; }
__device__ __forceinline__ void glds16(const void* gbase, unsigned voff, unsigned lds_dst) { unsigned keep;
  asm volatile("s_mov_b32 %0, m0\n\ts_mov_b32 m0, %3\n\ts_nop 0\n\tglobal_load_lds_dwordx4 %1, %2\n\ts_mov_b32 m0, %0" : "=&s"(keep) : "v"(voff), "s"(gbase), "s"(lds_dst) : "memory"); }
#define WAIT_BAR(N) asm volatile("s_waitcnt vmcnt(" #N ") lgkmcnt(0)\n\ts_barrier" ::: "memory")
typedef float f32x2_t __attribute__((ext_vector_type(2))); typedef __bf16 bf16x2_t __attribute__((ext_vector_type(2)));
__device__ __forceinline__ unsigned cvtpk(float lo, float hi) { f32x2_t v = {lo, hi}; bf16x2_t b = __builtin_convertvector(v, bf16x2_t); return __builtin_bit_cast(unsigned, b); }

template <bool FIRST>
__device__ __forceinline__ bool rowmax_dec(f32x16& p0, f32x16& p1, float& mhat, f32x16& negm, float& alpha) {
  float pmax = p0[0];
#pragma unroll
  for (int r = 1; r < 16; ++r) pmax = fmaxf(pmax, p0[r]);
#pragma unroll
  for (int r = 0; r < 16; ++r) pmax = fmaxf(pmax, p1[r]);
  { auto rr = __builtin_amdgcn_permlane32_swap(__float_as_uint(pmax), __float_as_uint(pmax), false, false);
    pmax = fmaxf(__uint_as_float(rr[0]), __uint_as_float(rr[1])); }
  alpha = 1.f;
  if (FIRST || __builtin_expect(__any(pmax > THR), 0)) {
    const float dl = FIRST ? pmax : fmaxf(pmax, 0.f); mhat += dl;
#pragma unroll
    for (int r = 0; r < 16; ++r) { p0[r] -= dl; p1[r] -= dl; }
#pragma unroll
    for (int r = 0; r < 16; ++r) negm[r] = -mhat;
    alpha = __builtin_amdgcn_exp2f(-dl);
    return true;
  }
  return false;
}
__device__ __forceinline__ void finishSM(f32x16& p0, f32x16& p1, float alpha, float& l_reg, bf16x8& pa0, bf16x8& pa1, bf16x8& pa2, bf16x8& pa3) {
#pragma unroll
  for (int r = 0; r < 16; ++r) p0[r] = __builtin_amdgcn_exp2f(p0[r]);
#pragma unroll
  for (int r = 0; r < 16; ++r) p1[r] = __builtin_amdgcn_exp2f(p1[r]);
  float ps = 0;
#pragma unroll
  for (int r = 0; r < 16; ++r) ps += p0[r];
#pragma unroll
  for (int r = 0; r < 16; ++r) ps += p1[r];
  { auto rr = __builtin_amdgcn_permlane32_swap(__float_as_uint(ps), __float_as_uint(ps), false, false);
    ps = __uint_as_float(rr[0]) + __uint_as_float(rr[1]); }
  l_reg = l_reg * alpha + ps;
#define PK4(P, BASE, OUT) do { u32x4 w = {cvtpk(P[BASE + 0], P[BASE + 1]), cvtpk(P[BASE + 2], P[BASE + 3]), cvtpk(P[BASE + 4], P[BASE + 5]), cvtpk(P[BASE + 6], P[BASE + 7])}; OUT = *reinterpret_cast<bf16x8*>(&w); } while (0)
  PK4(p0, 0, pa0); PK4(p0, 8, pa1); PK4(p1, 0, pa2); PK4(p1, 8, pa3);
#undef PK4
}
template <int D0A, int D0B> __device__ __forceinline__ void kload(bf16x8* kf, const char* Ks, int r32, int hi) {
  const char* kb = Ks + hi * 1024 + r32 * 16;
#pragma unroll
  for (int d0 = D0A; d0 < D0B; ++d0) { kf[2 * d0] = *reinterpret_cast<const bf16x8*>(kb + d0 * 2048); kf[2 * d0 + 1] = *reinterpret_cast<const bf16x8*>(kb + d0 * 2048 + 512); }
}
constexpr int KPRE = 0;
__device__ __forceinline__ void qkt(f32x16& p0, f32x16& p1, const bf16x8* kf, const bf16x8* qr, const f32x16& negm) {
#pragma unroll
  for (int d0 = 0; d0 < 6; ++d0) {
    if (d0 == 0) { p0 = __builtin_amdgcn_mfma_f32_32x32x16_bf16(kf[0], qr[0], negm, 0, 0, 0); p1 = __builtin_amdgcn_mfma_f32_32x32x16_bf16(kf[1], qr[0], negm, 0, 0, 0); }
    else { p0 = __builtin_amdgcn_mfma_f32_32x32x16_bf16(kf[2 * d0], qr[d0], p0, 0, 0, 0); p1 = __builtin_amdgcn_mfma_f32_32x32x16_bf16(kf[2 * d0 + 1], qr[d0], p1, 0, 0, 0); } }
}
__device__ __forceinline__ int v_rd_base(int lane) { return ((lane & 3) << 3) | (((lane >> 2) & 3) << 6) | (((lane >> 4) & 1) << 5) | (((lane >> 5) & 1) << 8); }
constexpr int v_rd_off(int d0, int ks, int half) { return d0 * 512 + ks * 2048 + half * 1024; }
template <int OFF> __device__ __forceinline__ s16x4 tr_read(int vb) {
  s16x4 r; asm volatile("ds_read_b64_tr_b16 %0, %1 offset:%2" : "=&v"(r) : "v"(vb), "i"(OFF) : "memory"); return r;
}
template <int D0> __device__ __forceinline__ void pv_one(f32x16& od, int vb, bf16x8 pa0, bf16x8 pa1, bf16x8 pa2, bf16x8 pa3) {
  const s16x4 l0 = tr_read<v_rd_off(D0, 0, 0)>(vb), h0 = tr_read<v_rd_off(D0, 0, 1)>(vb), l1 = tr_read<v_rd_off(D0, 1, 0)>(vb), h1 = tr_read<v_rd_off(D0, 1, 1)>(vb);
  const s16x4 l2 = tr_read<v_rd_off(D0, 2, 0)>(vb), h2 = tr_read<v_rd_off(D0, 2, 1)>(vb), l3 = tr_read<v_rd_off(D0, 3, 0)>(vb), h3 = tr_read<v_rd_off(D0, 3, 1)>(vb);
  asm volatile("s_waitcnt lgkmcnt(0)" ::: "memory"); SBAR();
#define PK(L, H) (bf16x8){L[0], L[1], L[2], L[3], H[0], H[1], H[2], H[3]}
  od = __builtin_amdgcn_mfma_f32_32x32x16_bf16(pa0, PK(l0, h0), od, 0, 0, 0);
  od = __builtin_amdgcn_mfma_f32_32x32x16_bf16(pa1, PK(l1, h1), od, 0, 0, 0);
  od = __builtin_amdgcn_mfma_f32_32x32x16_bf16(pa2, PK(l2, h2), od, 0, 0, 0);
  od = __builtin_amdgcn_mfma_f32_32x32x16_bf16(pa3, PK(l3, h3), od, 0, 0, 0);
#undef PK
}
struct VFrag8 { s16x4 l0, h0, l1, h1, l2, h2, l3, h3; };
__device__ __forceinline__ void pv_read0(VFrag8& f, int vb) {
  f.l0 = tr_read<v_rd_off(0, 0, 0)>(vb); f.h0 = tr_read<v_rd_off(0, 0, 1)>(vb); f.l1 = tr_read<v_rd_off(0, 1, 0)>(vb); f.h1 = tr_read<v_rd_off(0, 1, 1)>(vb);
  f.l2 = tr_read<v_rd_off(0, 2, 0)>(vb); f.h2 = tr_read<v_rd_off(0, 2, 1)>(vb); f.l3 = tr_read<v_rd_off(0, 3, 0)>(vb); f.h3 = tr_read<v_rd_off(0, 3, 1)>(vb);
}
__device__ __forceinline__ void pv_mma0(f32x16& od, const VFrag8& f, bf16x8 pa0, bf16x8 pa1, bf16x8 pa2, bf16x8 pa3) {
  asm volatile("s_waitcnt lgkmcnt(0)" ::: "memory"); SBAR();
#define PK(L, H) (bf16x8){L[0], L[1], L[2], L[3], H[0], H[1], H[2], H[3]}
  od = __builtin_amdgcn_mfma_f32_32x32x16_bf16(pa0, PK(f.l0, f.h0), od, 0, 0, 0);
  od = __builtin_amdgcn_mfma_f32_32x32x16_bf16(pa1, PK(f.l1, f.h1), od, 0, 0, 0);
  od = __builtin_amdgcn_mfma_f32_32x32x16_bf16(pa2, PK(f.l2, f.h2), od, 0, 0, 0);
  od = __builtin_amdgcn_mfma_f32_32x32x16_bf16(pa3, PK(f.l3, f.h3), od, 0, 0, 0);
#undef PK
}
__device__ __forceinline__ void pv_all(f32x16* o, int vb, bf16x8 pa0, bf16x8 pa1, bf16x8 pa2, bf16x8 pa3) {
  pv_one<0>(o[0], vb, pa0, pa1, pa2, pa3); pv_one<1>(o[1], vb, pa0, pa1, pa2, pa3);
}

__device__ __forceinline__ void attn_unit(const bool SAMPLE, const bool DRY, const bool PRE, const bf16_t* __restrict__ Qb, const bf16_t* __restrict__ Kh, const bf16_t* __restrict__ Vh, const bf16_t* __restrict__ KRh,
                                          const bf16_t* KhN, const bf16_t* VhN, const bf16_t* KRhN, const bf16_t* QbN, const bool SAMPLE_N, bf16_t* G, int NT, int visb, char* lds) {
  int tid_ = threadIdx.x; asm volatile("" : "+v"(tid_));
  const int tid = tid_, wid = __builtin_amdgcn_readfirstlane(tid >> 6), lane = tid & 63, r32 = lane & 31, hi = lane >> 5;
  char* V_lds = lds + L_V; char* K_lds = lds + L_K;
  float* ws = (float*)(lds + L_WS) + wid * 64; float* li_l = ws; float* al_l = ws + 32;
  float* ost = (float*)(lds + L_OST) + wid * 32 * OSTP;
  const unsigned lds0 = (unsigned)(uintptr_t)lds;
  const int wq = SAMPLE ? (wid & 1) : wid, vis = SAMPLE ? visb : visb + (wid >> 1);
  const unsigned lo = (unsigned)(wid * 1024 + lane * 16), lor = (unsigned)(wid * 512 + (lane & 31) * 16);
  const unsigned kdst = lds0 + L_K + wid * 1024, rdst = lds0 + L_K + 8 * 1024 + wid * 512, vdst = lds0 + L_V + wid * 1024;
#define DMA_K(t, slot) do { const unsigned t_ = (unsigned)(t); glds16((const char*)Kh + (size_t)t_ * 8192u, lo, (unsigned)__builtin_amdgcn_readfirstlane(kdst + (slot))); \
    if (lane < 32) glds16((const char*)KRh + (size_t)t_ * 4096u, lor, (unsigned)__builtin_amdgcn_readfirstlane(rdst + (slot))); } while (0)
#define DMA_V(t, slot) glds16((const char*)Vh + (size_t)(unsigned)(t) * 8192u, lo, (unsigned)__builtin_amdgcn_readfirstlane(vdst + (slot) / 3 * 2))
#define SLOTK(t) ((((unsigned)(t)) & (NSLOT - 1)) * KSLOT)
#define ISSUE_PAIR(j_, FULL) do { if ((FULL) || (j_) + 2 < NT) DMA_K((j_) + 2, SLOTK((j_) + 2)); if ((FULL) || (j_) + 3 < NT) DMA_K((j_) + 3, SLOTK((j_) + 3)); \
    if ((FULL) || (j_) + 1 < NT) DMA_V((j_) + 1, SLOTK((j_) + 1)); if ((FULL) || (j_) + 2 < NT) DMA_V((j_) + 2, SLOTK((j_) + 2)); } while (0)
  if (!PRE) { DMA_K(0, 0); DMA_V(0, 0); DMA_K(1, KSLOT); DMA_K(2, 2 * KSLOT); }
  if (SAMPLE && wid >= 2) {
    asm volatile("s_waitcnt vmcnt(0)" ::: "memory"); WAIT_BAR(0);
    DMA_V(1, SLOTK(1)); WAIT_BAR(0);
    for (int j = 1; j + 1 < NT; j += 2) { ISSUE_PAIR(j, false); WAIT_BAR(0); }
    WAIT_BAR(0);
    if (KhN) { const unsigned t0_ = 0u; (void)t0_;
      glds16((const char*)KhN, lo, (unsigned)__builtin_amdgcn_readfirstlane(kdst)); if (lane < 32) glds16((const char*)KRhN, lor, (unsigned)__builtin_amdgcn_readfirstlane(rdst));
      glds16((const char*)VhN, lo, (unsigned)__builtin_amdgcn_readfirstlane(vdst));
      glds16((const char*)KhN + 8192, lo, (unsigned)__builtin_amdgcn_readfirstlane(kdst + KSLOT)); if (lane < 32) glds16((const char*)KRhN + 4096, lor, (unsigned)__builtin_amdgcn_readfirstlane(rdst + KSLOT));
      glds16((const char*)KhN + 16384, lo, (unsigned)__builtin_amdgcn_readfirstlane(kdst + 2 * KSLOT)); if (lane < 32) glds16((const char*)KRhN + 8192, lor, (unsigned)__builtin_amdgcn_readfirstlane(rdst + 2 * KSLOT)); }
    asm volatile("s_waitcnt lgkmcnt(0)\n\ts_barrier" ::: "memory");
    return;
  }
  float mhat = 0.f, l_reg = 0; f32x16 o[2] = {}; f32x16 negm = {}; bf16x8 kf[12], qr[6];
  { const unsigned qof = (unsigned)((wq * QBLK + r32) * DQK + hi * 8);
#pragma unroll
    for (int d0 = 0; d0 < 6; ++d0) qr[d0] = *reinterpret_cast<const bf16x8*>(Qb + (qof + d0 * 16)); }
  const int vb0 = (int)(uintptr_t)V_lds + v_rd_base(lane);
#define RESC(a) do { if (hi == 0) al_l[r32] = (a); asm volatile("s_waitcnt lgkmcnt(0)" ::: "memory"); \
    _Pragma("unroll") for (int d = 0; d < 2; ++d) _Pragma("unroll") for (int r = 0; r < 16; ++r) o[d][r] *= al_l[crow(r, hi)]; } while (0)
#define MASK(P0, P1, t) do { if ((t) > vis) { _Pragma("unroll") for (int r = 0; r < 16; ++r) { P0[r] = -INFINITY; P1[r] = -INFINITY; } } } while (0)
  f32x16 pA0, pA1, pB0, pB1; float alA, alB; bf16x8 pa0, pa1, pa2, pa3;
#define VOFF(s) ((s) / 3 * 2)
  asm volatile("s_waitcnt vmcnt(0)" ::: "memory");
  WAIT_BAR(0);
  kload<0, 6>(kf, K_lds, r32, hi);
  qkt(pA0, pA1, kf, qr, negm); rowmax_dec<true>(pA0, pA1, mhat, negm, alA); alA = 0.f;
  DMA_V(1, SLOTK(1));
  WAIT_BAR(0);
#define QK_SGB() do { __builtin_amdgcn_sched_group_barrier(0x100, 12, 0); __builtin_amdgcn_sched_group_barrier(0x400, 4, 0); __builtin_amdgcn_sched_group_barrier(0x002, 4, 0); _Pragma("unroll") for (int i_ = 0; i_ < 12; ++i_) { __builtin_amdgcn_sched_group_barrier(0x008, 1, 0); \
      __builtin_amdgcn_sched_group_barrier(0x400, 3, 0); __builtin_amdgcn_sched_group_barrier(0x002, 5, 0); } } while (0)
#define STEP(C0, C1, P0, P1, alC, alP, t, MSK, DMA_) do { \
    const bool vc_ = !(MSK) || (t) <= vis, vp_ = !(MSK) || (t) - 1 <= vis; \
    SBAR(); if (vc_) { kload<0, 6>(kf, K_lds + SLOTK(t), r32, hi); qkt(C0, C1, kf, qr, negm); } \
    if (vp_) finishSM(P0, P1, alP, l_reg, pa0, pa1, pa2, pa3); if (!(MSK)) QK_SGB(); SBAR(); \
    VFrag8 vf_; if (vp_) pv_read0(vf_, vb0 + VOFF(SLOTK((t) - 1))); SBAR(); \
    DMA_; SBAR(); \
    if (vp_) { pv_mma0(o[0], vf_, pa0, pa1, pa2, pa3); pv_one<1>(o[1], vb0 + VOFF(SLOTK((t) - 1)), pa0, pa1, pa2, pa3); } \
    if (vc_) { if (rowmax_dec<false>(C0, C1, mhat, negm, alC)) RESC(alC); } else alC = 1.f; } while (0)
  int j = 1; const int jm = visb < NT - 4 ? visb : NT - 4;
  for (; j + 1 <= jm; j += 2) { STEP(pB0, pB1, pA0, pA1, alB, alA, j, false, ISSUE_PAIR(j, true)); STEP(pA0, pA1, pB0, pB1, alA, alB, j + 1, false, (void)0); WAIT_BAR(0); }
  for (; j + 1 < NT; j += 2) { STEP(pB0, pB1, pA0, pA1, alB, alA, j, true, ISSUE_PAIR(j, false)); STEP(pA0, pA1, pB0, pB1, alA, alB, j + 1, true, (void)0); WAIT_BAR(0); }
  STEP(pB0, pB1, pA0, pA1, alB, alA, NT - 1, true, (void)0); WAIT_BAR(0);
  const unsigned sl_prev = SLOTK(NT - 1);
  if (KhN) {
#define DMA_KN(t, slot) do { const unsigned t_ = (unsigned)(t); glds16((const char*)KhN + (size_t)t_ * 8192u, lo, (unsigned)__builtin_amdgcn_readfirstlane(kdst + (slot))); \
    if (lane < 32) glds16((const char*)KRhN + (size_t)t_ * 4096u, lor, (unsigned)__builtin_amdgcn_readfirstlane(rdst + (slot))); } while (0)
    DMA_KN(0, 0); glds16((const char*)VhN, lo, (unsigned)__builtin_amdgcn_readfirstlane(vdst)); DMA_KN(1, KSLOT); DMA_KN(2, 2 * KSLOT);
#undef DMA_KN
  }
  u32x4 zz[4];
  if ((!SAMPLE || wid < 2) && !DRY) {
#pragma unroll
    for (int i = 0; i < 4; ++i) zz[i] = __builtin_nontemporal_load((const u32x4*)(G + (unsigned)((wq * QBLK + i * 8 + (lane >> 3)) * DM + (lane & 7) * 8))); }
  if (NT - 1 <= vis) { finishSM(pB0, pB1, alB, l_reg, pa0, pa1, pa2, pa3); SBAR();
    pv_all(o, vb0 + VOFF(sl_prev), pa0, pa1, pa2, pa3); }
  if (hi == 0) li_l[r32] = l_reg; asm volatile("s_waitcnt lgkmcnt(0)" ::: "memory");
#pragma unroll
  for (int r = 0; r < 16; ++r) { const int orow = crow(r, hi); const float rl = __builtin_amdgcn_rcpf(li_l[orow]);
    ost[orow * OSTP + r32] = o[0][r] * rl; ost[orow * OSTP + 32 + r32] = o[1][r] * rl; }
  asm volatile("s_waitcnt lgkmcnt(0)" ::: "memory");
  if ((!SAMPLE || wid < 2) && !DRY) {
#pragma unroll
    for (int i = 0; i < 4; ++i) { const int row = i * 8 + (lane >> 3), ch = lane & 7;
      const f32x4 a = *(const f32x4*)(ost + row * OSTP + ch * 8), b = *(const f32x4*)(ost + row * OSTP + ch * 8 + 4);
      bf16_t* gp = G + (unsigned)((wq * QBLK + row) * DM + ch * 8); const u32x4 z_ = zz[i]; u32x4 w;
      w.x = cvtpk(a[0] * __uint_as_float(z_.x << 16), a[1] * __uint_as_float(z_.x & 0xffff0000u));
      w.y = cvtpk(a[2] * __uint_as_float(z_.y << 16), a[3] * __uint_as_float(z_.y & 0xffff0000u));
      w.z = cvtpk(b[0] * __uint_as_float(z_.z << 16), b[1] * __uint_as_float(z_.z & 0xffff0000u));
      w.w = cvtpk(b[2] * __uint_as_float(z_.w << 16), b[3] * __uint_as_float(z_.w & 0xffff0000u));
      *(u32x4*)gp = w; }
  }
  asm volatile("s_waitcnt lgkmcnt(0)\n\ts_barrier" ::: "memory");
#undef DMA_K
#undef DMA_V
#undef RESC
#undef MASK
#undef ROT
#undef VOFF
#undef SLOTK
#undef ISSUE_PAIR
#undef ENDW
#undef QK_SGB
#undef STEP
}
#undef WAIT_BAR
#undef SBAR
}

constexpr int NWAVES = 8;
constexpr int RING_OFF = 0, RING_BYTES = 153600;
constexpr int LDSCTL_OFF = RING_BYTES, MISC_OFF = LDSCTL_OFF + 320;
constexpr int LDS_BYTES = 155648;
static_assert(att::L_END <= RING_BYTES && MISC_OFF + 128 <= LDS_BYTES, "LDS map");

#define GAS __attribute__((address_space(1)))
#define LAS __attribute__((address_space(3)))
typedef unsigned short bf16;
typedef unsigned v4u __attribute__((ext_vector_type(4)));
typedef unsigned v2u __attribute__((ext_vector_type(2)));
typedef float f32x4 __attribute__((ext_vector_type(4)));
typedef GAS unsigned gu32;
#define RLX_AGENT __ATOMIC_RELAXED, __HIP_MEMORY_SCOPE_AGENT
#define LDS_WAIT() asm volatile("s_waitcnt lgkmcnt(0)" ::: "memory")
#define VM_WAIT() asm volatile("s_waitcnt vmcnt(0)" ::: "memory")
typedef float f32x2_ __attribute__((ext_vector_type(2))); typedef __bf16 bf16x2_ __attribute__((ext_vector_type(2)));
__device__ __forceinline__ unsigned pk2(float lo, float hi) { f32x2_ v = {lo, hi}; bf16x2_ b = __builtin_convertvector(v, bf16x2_); return __builtin_bit_cast(unsigned, b); }

#define XB_TMO      128
#define XB_XCNT(j)  (256  + 64 * (j))
#define XB_XSUB(j)  (1280 + 64 * (j))
#define XB_XGEN(j)  (2304 + 64 * (j))
#define XB_TOP      3328
#define XB_TOPGEN   3392
#define XCD_BAR_WORDS 3456
#define XB_SPIN_CAP (1u << 18)

__device__ __forceinline__ unsigned xb_ld(unsigned* p)              { return __hip_atomic_load(p, __ATOMIC_RELAXED, __HIP_MEMORY_SCOPE_AGENT); }
__device__ __forceinline__ unsigned xb_add(unsigned* p, unsigned v) { return __hip_atomic_fetch_add(p, v, __ATOMIC_RELAXED, __HIP_MEMORY_SCOPE_AGENT); }
__device__ __forceinline__ unsigned xb_xcc_id() { return (unsigned)__builtin_amdgcn_s_getreg((3 << 11) | 20) & 0xFu; }
#define XB_SPIN(cond, bar) do { unsigned _sp = 0; while (cond) { __builtin_amdgcn_s_sleep(1); \
    if ((++_sp & 255u) == 0u) { if (xb_ld(&(bar)[XB_TMO])) break; if (_sp > XB_SPIN_CAP) { atomicAdd(&(bar)[XB_TMO], 1u); break; } } } } while (0)

struct XcdBarrier {
    unsigned* bar; unsigned x;
    volatile LAS unsigned* st;
};

__device__ __forceinline__ XcdBarrier xcd_barrier_post(unsigned* bar, volatile LAS unsigned* st) {
    XcdBarrier b; b.bar = bar; b.x = xb_xcc_id(); b.st = st;
    if (threadIdx.x == 0) (void)xb_add(&bar[XB_XCNT(b.x)], 1u);
    return b;
}
__device__ __forceinline__ void xcd_barrier_complete(unsigned* bar, unsigned x, unsigned& nloc, unsigned& nx) {
    const unsigned G = gridDim.x * gridDim.y * gridDim.z;
    unsigned sum, cnt, mine, sp = 0u;
    for (;;) {
        sum = 0u; cnt = 0u; mine = 0u;
#pragma unroll
        for (unsigned j = 0; j < 16; ++j) { const unsigned c = xb_ld(&bar[XB_XCNT(j)]); sum += c; cnt += (c > 0u) ? 1u : 0u; mine = (j == x) ? c : mine; }
        if (sum == G) break;
        __builtin_amdgcn_s_sleep(1);
        if ((++sp & 255u) == 0u) { if (xb_ld(&bar[XB_TMO])) break; if (sp > XB_SPIN_CAP) { atomicAdd(&bar[XB_TMO], 1u); break; } }
    }
    nloc = mine > 0u ? mine : 1u; nx = cnt > 0u ? cnt : 1u;
}

__device__ __forceinline__ void xcd_barrier(const XcdBarrier& b) {
    asm volatile("s_waitcnt vmcnt(0)" ::: "memory");
    __syncthreads();
    if (threadIdx.x == 0) {
        unsigned* bar = b.bar;
        __builtin_amdgcn_s_waitcnt(0);
        unsigned nloc = b.st[0], nx = b.st[1];
        if (nloc == 0u) { xcd_barrier_complete(bar, b.x, nloc, nx); b.st[0] = nloc; b.st[1] = nx; }
        const unsigned round = b.st[2];
        const unsigned old = xb_add(&bar[XB_XSUB(b.x)], 1u);
        if (old + 1u == (round + 1u) * nloc) {
            __builtin_amdgcn_fence(__ATOMIC_RELEASE, "agent");
            asm volatile("s_waitcnt vmcnt(0)" ::: "memory");
            const unsigned og = xb_add(&bar[XB_TOP], 1u);
            if (og + 1u == (round + 1u) * nx) xb_add(&bar[XB_TOPGEN], 1u);
            else XB_SPIN(xb_ld(&bar[XB_TOPGEN]) == round, bar);
        } else {
            XB_SPIN(xb_ld(&bar[XB_TOPGEN]) == round, bar);
        }
        __builtin_amdgcn_fence(__ATOMIC_ACQUIRE, "agent");
        asm volatile("s_waitcnt vmcnt(0)" ::: "memory");
        b.st[2] = round + 1u;
    }
    __syncthreads();
}


struct Args { const float* in[16]; float* out; unsigned char* ws; int ph_lo, ph_hi, li, pad; };
struct Frame {
    LAS unsigned char* lds; volatile LAS unsigned* MISC; gu32* ctl;
    int tid, lane, wave, vcu, G;
};
__device__ __forceinline__ float wave_sum(float v) {
#pragma unroll
    for (int o = 1; o < 64; o <<= 1) v += __shfl_xor(v, o);
    return v;
}
__device__ __forceinline__ int p8map(int cl) { return (cl & ~31) | (((cl >> 2) & 3) << 3) | (((cl >> 4) & 1) << 2) | (cl & 3); }
__device__ __forceinline__ int wcol(int g, int j) {
    const int pn = j >> 8, cl = j & 255;
    if (g == 0) return ((cl >> 7) * 2 + ((cl >> 4) & 1)) * 1024 + pn * 64 + ((cl >> 5) & 3) * 16 + (cl & 15);
    if (g == 2) { if (pn == 0) return p8map(cl); if (pn == 1) return cl < 160 ? 256 + cl : -1; return 416 + (pn - 2) * 256 + p8map(cl); }
    if (g == 3) { if (pn < 4) { const int L = pn * 256 + p8map(cl); return (L >> 6) * 96 + (L & 63); } const int L = (pn - 4) * 256 + cl; return (L >> 5) * 96 + 64 + (L & 31); }
    if (g == 4) { const int L = (pn & 3) * 256 + p8map(cl); return (L >> 6) * 128 + (pn >= 4 ? 64 : 0) + (L & 63); }
    return (j & ~255) | p8map(j & 255);
}
__device__ __forceinline__ void p0_wt_item(const float* W, int K, int Nsrc, const float* rscale, float cscale, int g, bf16* WT, LAS float* scr, int item, int nblk, int lane) {
    const int kb = item / nblk, nb = item % nblk, k0 = 64 * kb, j0 = 32 * nb;
    const int col = wcol(g, j0 + (lane & 31));
    float wv[32];
#pragma unroll
    for (int i = 0; i < 32; ++i) { const int kk = 2 * i + (lane >> 5); wv[i] = col >= 0 ? __builtin_nontemporal_load(W + (size_t)(k0 + kk) * Nsrc + col) : 0.f; }
#pragma unroll
    for (int i = 0; i < 32; ++i) { const int kk = 2 * i + (lane >> 5); float v = wv[i] * cscale; if (rscale) v *= rscale[k0 + kk];
        scr[kk * 33 + (lane & 31)] = v; }
    LDS_WAIT(); asm volatile("" ::: "memory");
    const int c = lane & 7;
#pragma unroll
    for (int jq = 0; jq < 4; ++jq) { const int n = (lane >> 3) + 8 * jq; const LAS float* s = scr + (8 * c) * 33 + n;
        v4u o; o.x = pk2(s[0 * 33], s[1 * 33]); o.y = pk2(s[2 * 33], s[3 * 33]); o.z = pk2(s[4 * 33], s[5 * 33]); o.w = pk2(s[6 * 33], s[7 * 33]);
        *(GAS v4u*)(WT + (size_t)(j0 + n) * K + k0 + 8 * c) = o; }
    LDS_WAIT(); asm volatile("" ::: "memory");
}
__device__ __forceinline__ void sincos_tab(float ang, float& s, float& c) {
    const double x = (double)ang, q = rint(x * 0.63661977236758134308), r = x - q * 1.57079632679489661923, r2 = r * r;
    const double sp = r * (1.0 + r2 * (-1.0 / 6 + r2 * (1.0 / 120 + r2 * (-1.0 / 5040 + r2 * (1.0 / 362880 - r2 * (1.0 / 39916800))))));
    const double cp = 1.0 + r2 * (-0.5 + r2 * (1.0 / 24 + r2 * (-1.0 / 720 + r2 * (1.0 / 40320 + r2 * (-1.0 / 3628800 + r2 * (1.0 / 479001600))))));
    const int k = ((int)q) & 3;
    s = (float)(k == 0 ? sp : k == 1 ? cp : k == 2 ? -sp : -cp); c = (float)(k == 0 ? cp : k == 1 ? -sp : k == 2 ? -cp : sp);
}
__device__ __forceinline__ void p0_prologue(Frame& F, const Args& a) {
    unsigned char* ws = a.ws;
    LAS float* scr = (LAS float*)(F.lds + RING_OFF + F.wave * 16384);
    const int gw = F.vcu * NWAVES + F.wave, NGW = F.G * NWAVES;
    constexpr int I0 = 16 * 128, I1 = 16 * 32, I2 = 16 * 48, I3 = 4 * 48, I4 = 2 * 64, I5 = 16 * 32, NITEMS = I0 + I1 + I2 + I3 + I4 + I5;
    for (int it = gw; it < NITEMS; it += NGW) {
        int r = it;
        if (r < I0) { p0_wt_item(a.in[7], 1024, 4096, a.in[5], 1.f, 0, (bf16*)(ws + WS_W1T), scr, r, 128, F.lane); continue; } r -= I0;
        if (r < I1) { p0_wt_item(a.in[9], 1024, 1024, nullptr, 1.f, 1, (bf16*)(ws + WS_W2T), scr, r, 32, F.lane); continue; } r -= I1;
        if (r < I2) { p0_wt_item(a.in[10], 1024, 1440, a.in[5] + 1024, 1.f, 2, (bf16*)(ws + WS_W3T), scr, r, 48, F.lane); continue; } r -= I2;
        if (r < I3) { p0_wt_item(a.in[12], 256, 1536, a.in[11], C2, 3, (bf16*)(ws + WS_W4T), scr, r, 48, F.lane); continue; } r -= I3;
        if (r < I4) { p0_wt_item(a.in[14], 128, 2048, nullptr, 1.f, 4, (bf16*)(ws + WS_W5T), scr, r, 64, F.lane); continue; } r -= I4;
        p0_wt_item(a.in[15], 1024, 1024, nullptr, 1.f, 5, (bf16*)(ws + WS_W6T), scr, r, 32, F.lane);
    }
    { bf16* xb = (bf16*)(ws + WS_A); float* rs0 = (float*)(ws + WS_RS0);
      for (int m = gw; m < MT; m += NGW) {
        const float* xrow = m < MP ? a.in[0] + (size_t)m * DM : a.in[1] + (size_t)(m - MP) * DM;
        const GAS f32x4* xr = (const GAS f32x4*)xrow + F.lane; f32x4 v[4]; float s = 0.f;
#pragma unroll
        for (int j = 0; j < 4; ++j) { v[j] = __builtin_nontemporal_load(xr + 64 * j); s += (v[j].x * v[j].x + v[j].y * v[j].y) + (v[j].z * v[j].z + v[j].w * v[j].w); }
        s = wave_sum(s);
        const float rms = sqrtf(s * (1.0f / DM) + EPS), rn = 1.0f / rms;
        if (F.lane == 0) rs0[m] = rms;
        GAS v2u* o8 = (GAS v2u*)(xb + (size_t)m * DM) + F.lane;
#pragma unroll
        for (int j = 0; j < 4; ++j) { v2u w; w.x = pk2(v[j].x * rn, v[j].y * rn); w.y = pk2(v[j].z * rn, v[j].w * rn); o8[64 * j] = w; }
      } }
    { const long gt = (long)F.vcu * (NWAVES * 64) + F.tid, NT_ = (long)F.G * NWAVES * 64;
      { unsigned* xs = (unsigned*)(ws + WS_SSQ2); for (long i = gt; i < 130 * 4 * 256; i += NT_) xs[i] = 0xFFFFFFFFu; }
      bf16* ckva = (bf16*)(ws + WS_CKVA) + (size_t)MP * KVL; const float* cc = a.in[3];
      bf16* krs = (bf16*)(ws + WS_KRS); const float* ck = a.in[4];
      constexpr long NCC = (long)SB * PAST * KVL / 8, NCK = (long)SB * PAST * DR / 8;
      bool first = true;
      for (long base = gt; base < NCC; base += 4 * NT_) {
          f32x4 cv[4][2], kv[2]; const bool dok = first && gt < NCK;
#pragma unroll
          for (int k = 0; k < 4; ++k) { const long i = base + k * NT_; if (i < NCC) { cv[k][0] = __builtin_nontemporal_load((const f32x4*)(cc + i * 8)); cv[k][1] = __builtin_nontemporal_load((const f32x4*)(cc + i * 8 + 4)); } }
          if (dok) { kv[0] = __builtin_nontemporal_load((const f32x4*)(ck + gt * 8)); kv[1] = __builtin_nontemporal_load((const f32x4*)(ck + gt * 8 + 4)); }
          if (first) { float* tab = (float*)(ws + WS_ROPE);
              for (long i = gt; i < 8192L * 16; i += NT_) { const int pos = (int)(i >> 4), k = (int)(i & 15);
                  const float inv = 1.0f / powf(10000.0f, (float)(2 * k) * (1.0f / 32.0f)); const float ang = (float)pos * inv; float s, c; sincos_tab(ang, s, c);
                  tab[pos * 32 + k] = c; tab[pos * 32 + 16 + k] = s; } }
#pragma unroll
          for (int k = 0; k < 4; ++k) { const long i = base + k * NT_; if (i < NCC) { const f32x4 x0 = cv[k][0], x1 = cv[k][1];
              v4u w; w.x = pk2(x0.x, x0.y); w.y = pk2(x0.z, x0.w); w.z = pk2(x1.x, x1.y); w.w = pk2(x1.z, x1.w); *(v4u*)(ckva + i * 8) = w; } }
          if (dok) { const long i = gt, row = i >> 2; const int c8 = (int)(i & 3); const long b = row >> 12, s = row & (PAST - 1); const f32x4 x0 = kv[0], x1 = kv[1];
              v4u w; w.x = pk2(x0.x, x0.y); w.y = pk2(x0.z, x0.w); w.z = pk2(x1.x, x1.y); w.w = pk2(x1.z, x1.w); *(v4u*)(krs + ((b * (SKVP / 64) + (s >> 6)) * 4 + c8) * 512 + (s & 63) * 8) = w; }
          first = false;
      }
      for (long i = gt + NT_; i < NCK; i += NT_) { const long row = i >> 2; const int c8 = (int)(i & 3); const long b = row >> 12, s = row & (PAST - 1);
          const f32x4 x0 = __builtin_nontemporal_load((const f32x4*)(ck + i * 8)), x1 = __builtin_nontemporal_load((const f32x4*)(ck + i * 8 + 4));
          v4u w; w.x = pk2(x0.x, x0.y); w.y = pk2(x0.z, x0.w); w.z = pk2(x1.x, x1.y); w.w = pk2(x1.z, x1.w); *(v4u*)(krs + ((b * (SKVP / 64) + (s >> 6)) * 4 + c8) * 512 + (s & 63) * 8) = w; }
      bf16* Ks = (bf16*)(ws + WS_K) + KP_ELEMS; bf16* Vs = (bf16*)(ws + WS_V) + KP_ELEMS; const v4u z4 = {0u, 0u, 0u, 0u};
      for (long i = gt; i < (long)SB * NH * 512; i += NT_) { const long bh = i >> 9, r = i & 511;
          *(v4u*)(Ks + (bh * (SKVP / 64) + 65) * 4096 + r * 8) = z4; *(v4u*)(Vs + (bh * (SKVP / 64) + 65) * 4096 + r * 8) = z4; }
      for (long i = gt; i < (long)SB * 256; i += NT_) { const long b = i >> 8, r = i & 255; *(v4u*)(krs + (b * (SKVP / 64) + 65) * 2048 + r * 8) = z4; }
    }
}
__device__ __forceinline__ void p2_fixup(Frame& F, const Args& a) {
    unsigned char* ws = a.ws;
    const float* whead = (const float*)(ws + WS_WHEAD); const float* pchead = (const float*)(ws + WS_PCHEAD); const float* utail = (const float*)(ws + WS_UTAIL);
    const float* cw = a.in[8]; const float* st = a.in[2]; bf16* g = (bf16*)(ws + WS_B);
    const long gt = (long)F.vcu * (NWAVES * 64) + F.tid, NT_ = (long)F.G * NWAVES * 64;
    for (long i = gt; i < (long)NCHUNK * 256; i += NT_) { const int c = (int)(i >> 8), ch = (int)(i & 255) * 4;
        f32x4 p1, p2;
        if (c < MP / 64) { if ((c & 127) == 0) { p1 = (f32x4){0.f, 0.f, 0.f, 0.f}; p2 = p1; } else { p1 = *(const f32x4*)(utail + (size_t)((c - 1) * 2 + 1) * DM + ch); p2 = *(const f32x4*)(utail + (size_t)((c - 1) * 2) * DM + ch); } }
        else { const int b = c - MP / 64; p1 = *(const f32x4*)(st + (size_t)(b * 2 + 1) * DM + ch); p2 = *(const f32x4*)(st + (size_t)(b * 2) * DM + ch); }
        const f32x4 cw0 = *(const f32x4*)(cw + ch), cw1 = *(const f32x4*)(cw + DM + ch);
        const f32x4 w0 = *(const f32x4*)(whead + (size_t)(c * 2) * DM + ch), w1 = *(const f32x4*)(whead + (size_t)(c * 2 + 1) * DM + ch);
        const f32x4 q0 = *(const f32x4*)(pchead + (size_t)(c * 2) * DM + ch), q1 = *(const f32x4*)(pchead + (size_t)(c * 2 + 1) * DM + ch);
        const f32x4 g0 = w0 * (q0 + cw1 * p1 + cw0 * p2), g1 = w1 * (q1 + cw0 * p1);
        v2u o0, o1; o0.x = pk2(g0.x, g0.y); o0.y = pk2(g0.z, g0.w); o1.x = pk2(g1.x, g1.y); o1.y = pk2(g1.z, g1.w);
        *(v2u*)(g + (size_t)(c * 64) * DM + ch) = o0; *(v2u*)(g + (size_t)(c * 64 + 1) * DM + ch) = o1;
    }
    for (long i = gt; i < (long)(NB + SB) * 2 * 256; i += NT_) { const int sidx = (int)(i >> 9), j = (int)(i >> 8) & 1, ch = (int)(i & 255) * 4;
        const int c = sidx < NB ? 128 * (sidx + 1) - 1 : MP / 64 + (sidx - NB);
        const f32x4 v = *(const f32x4*)(utail + (size_t)(c * 2 + j) * DM + ch);
        float* o = a.out + (sidx < NB ? O_CONVP + (size_t)(sidx * 2 + j) * DM : O_CONVS + (size_t)((sidx - NB) * 2 + j) * DM) + ch;
        *(f32x4*)o = v; }
}
__device__ __forceinline__ void p8_final(Frame& F, const Args& a) {
    const float* ssq2 = (const float*)(a.ws + WS_SSQ2); const float* gf = a.in[6]; const bf16* x2 = (const bf16*)(a.ws + WS_K);
    const int gw = F.vcu * NWAVES + F.wave, NGW = F.G * NWAVES;
    int ln = threadIdx.x; asm volatile("" : "+v"(ln)); ln &= 63;
    f32x4 gv[4];
#pragma unroll
    for (int j = 0; j < 2; ++j) { gv[2 * j] = *(const f32x4*)(gf + 512 * j + 8 * ln); gv[2 * j + 1] = *(const f32x4*)(gf + 512 * j + 8 * ln + 4); }
    for (int m = gw; m < MT; m += NGW) {
        const float rs = 1.0f / sqrtf(pg8::sum16(ssq2 + (size_t)m * 16) * (1.0f / DM) + EPS);
        const v4u x0 = __builtin_nontemporal_load((const v4u*)(x2 + (size_t)m * DM + 8 * ln)), x1 = __builtin_nontemporal_load((const v4u*)(x2 + (size_t)m * DM + 512 + 8 * ln));
        float* yr = a.out + (size_t)m * DM + 8 * ln;
        f32x4 v;
        v = (f32x4){__uint_as_float(x0.x << 16), __uint_as_float(x0.x & 0xffff0000u), __uint_as_float(x0.y << 16), __uint_as_float(x0.y & 0xffff0000u)}; *(f32x4*)yr = v * rs * gv[0];
        v = (f32x4){__uint_as_float(x0.z << 16), __uint_as_float(x0.z & 0xffff0000u), __uint_as_float(x0.w << 16), __uint_as_float(x0.w & 0xffff0000u)}; *(f32x4*)(yr + 4) = v * rs * gv[1];
        v = (f32x4){__uint_as_float(x1.x << 16), __uint_as_float(x1.x & 0xffff0000u), __uint_as_float(x1.y << 16), __uint_as_float(x1.y & 0xffff0000u)}; *(f32x4*)(yr + 512) = v * rs * gv[2];
        v = (f32x4){__uint_as_float(x1.z << 16), __uint_as_float(x1.z & 0xffff0000u), __uint_as_float(x1.w << 16), __uint_as_float(x1.w & 0xffff0000u)}; *(f32x4*)(yr + 516) = v * rs * gv[3];
    }
}
__device__ __forceinline__ void p6_attention(Frame& F, const Args& a, char* lds, const bool dry) {
    unsigned char* ws = a.ws;
    const bf16* Qp = (const bf16*)a.out; const bf16* Qs = Qp + QP_ELEMS; const bf16* Kp = (const bf16*)(ws + WS_K); const bf16* Ks = Kp + KP_ELEMS;
    const bf16* Vp = (const bf16*)(ws + WS_V); const bf16* Vs = Vp + KP_ELEMS; const bf16* krp = (const bf16*)(ws + WS_KRP); const bf16* krs = (const bf16*)(ws + WS_KRS);
    bf16* sz = (bf16*)(ws + WS_B);
    int nun, typeA = 0, grp = 0, s = 0; unsigned long long tab = 0;
    if (F.G == 256) { grp = F.vcu >> 3; const int j = F.vcu & 7; s = j & 3; typeA = j < 4; nun = typeA ? 9 : 8;
        tab = j == 0 ? 0x00720d41561eull : j == 1 ? 0x827a2dc35e3eull : j == 2 ? 0x08528c45465cull : j == 3 ? 0x8a5aacc74e7cull : j == 4 ? 0x04624f49769full : j == 5 ? 0x866a6fcb7ebfull : j == 6 ? 0x0c42ce4d66ddull : 0x8e4aeecf6efdull; }
    else nun = (64 * 32 + 128 - F.vcu + F.G - 1) / F.G;
#define UDESC(i, smp, idx, qb) do { \
        if (F.G == 256) { smp = typeA && (i) == 8; const unsigned e_ = (unsigned)(tab >> (6 * ((i) & 7))) & 63u; qb = (int)(e_ & 31u); idx = smp ? grp * 4 + s : 2 * grp + (int)(e_ >> 5); \
        } else { const int u_ = F.vcu + (i) * F.G; smp = u_ >= 2048; idx = smp ? u_ - 2048 : (u_ >> 5); qb = 31 - (u_ & 31); } } while (0)
#define UPTRS(smp, idx, K_, V_, R_) do { const int b__ = (idx) >> 4; K_ = smp ? Ks + (size_t)(idx) * SKVP * DN : Kp + (size_t)(idx) * SEQ * DN; V_ = smp ? Vs + (size_t)(idx) * SKVP * DV : Vp + (size_t)(idx) * SEQ * DV; \
        R_ = smp ? krs + (size_t)b__ * SKVP * DR : krp + (size_t)b__ * SEQ * DR; } while (0)
    for (int i = 0; i < nun; ++i) {
        bool smp; int idx, qb = 0; UDESC(i, smp, idx, qb);
        const int b_ = idx >> 4, h_ = idx & 15;
        const bf16* Qb = smp ? Qs + (size_t)idx * ST * DQK : Qp + ((size_t)idx * SEQ + 256 * qb) * DQK;
        const bf16 *Kh, *Vh, *KRh, *KhN = nullptr, *VhN = nullptr, *KRhN = nullptr, *QbN = nullptr; bool smpn = false; UPTRS(smp, idx, Kh, Vh, KRh);
        if (i + 1 < nun) { int idxn, qbn = 0; UDESC(i + 1, smpn, idxn, qbn); UPTRS(smpn, idxn, KhN, VhN, KRhN); QbN = smpn ? Qs + (size_t)idxn * ST * DQK : Qp + ((size_t)idxn * SEQ + 256 * qbn) * DQK; }
        bf16* Gp = sz + (smp ? ((size_t)MP + b_ * ST) * DM : ((size_t)b_ * SEQ + 256 * qb) * DM) + h_ * 64;
        att::attn_unit(smp, dry, i > 0, Qb, Kh, Vh, KRh, KhN, VhN, KRhN, QbN, smpn, Gp, smp ? 66 : 4 * qb + 4, smp ? 64 : 4 * qb, lds);
    }
#undef UDESC
#undef UPTRS
}

constexpr int PER_PHASE = 9;
constexpr int N_LAUNCHES = MK_N_LAUNCHES;
static_assert(N_LAUNCHES == 1 || N_LAUNCHES == PER_PHASE, "MK_N_LAUNCHES is 1 or 9");
constexpr int CW_BAR = 4096, CW_SPLIT = 8192;
#ifndef PROBE_DUP
#define PROBE_DUP 0
#endif
#define DUP(k) (((PROBE_DUP) >> (k)) & 1)

__global__ void __launch_bounds__(NWAVES * 64, 2) mk_fwd(Args args) {
    extern __shared__ __attribute__((aligned(16))) unsigned char lds[];
    Frame F;
    F.lds = (LAS unsigned char*)lds;
    F.MISC = (volatile LAS unsigned*)(F.lds + MISC_OFF);
    F.tid = threadIdx.x; F.lane = F.tid & 63; F.wave = __builtin_amdgcn_readfirstlane(F.tid >> 6);
    F.G = gridDim.x; { const int bx = blockIdx.x; F.vcu = (F.G % 8 == 0) ? (bx % 8) * (F.G / 8) + bx / 8 : bx; }
    unsigned char* ws = args.ws;
    F.ctl = (gu32*)(ws + WS_CTL);
    for (int u = F.tid; u < (LDS_BYTES - LDSCTL_OFF) / 4; u += NWAVES * 64) ((LAS unsigned*)(F.lds + LDSCTL_OFF))[u] = 0u;
    __syncthreads();
    XcdBarrier bar; bar.bar = (unsigned*)(F.ctl + CW_BAR); bar.x = 0; bar.st = nullptr;
    if (N_LAUNCHES == 1) bar = xcd_barrier_post((unsigned*)(F.ctl + CW_BAR), F.MISC + 8);
#define GRID_BAR() do { if (N_LAUNCHES == 1) xcd_barrier(bar); } while (0)
#define KV_CACHED(U0, N) do { pg8::Gemm g{(const pg8::bf16_t*)(ws + WS_CKVA), (const pg8::bf16_t*)(ws + WS_W5T), MKV, 2048, 128}; pg8::CachedOrder S{(U0), (N)}; \
        pg8::EpiKV E{(const float*)(ws + WS_SSQKV), (pg8::bf16_t*)(ws + WS_K), (pg8::bf16_t*)(ws + WS_V), args.out, 0}; \
        pg8::gemm_phase<pg8::EpiKV, pg8::CachedOrder, true, true>(F.lds + RING_OFF, g, S, E); } while (0)
    const bool tails = (F.G == 256);
    const bool split = tails && N_LAUNCHES == 1;
#define SPLIT_TAIL(EPI, E_, A_, B_, N_, PM_, PN_, TU_, SL_, SCR_, K_) do { \
        pg8::Gemm gs{(const pg8::bf16_t*)(A_) + (SL_) * 128, (const pg8::bf16_t*)(B_) + (SL_) * 128, MT, (N_), 1024, 2}; pg8::OneUnit O1{(PM_), (PN_), 1}; \
        pg8::EpiSplit<EPI> ES{E_, (float*)(SCR_), (unsigned*)(F.ctl + CW_SPLIT + 256 * (K_)), (TU_), (SL_)}; \
        pg8::gemm_phase<pg8::EpiSplit<EPI>, pg8::OneUnit, true, true>(F.lds + RING_OFF, gs, O1, ES); } while (0)
    const int lo = args.ph_lo, hi = args.ph_hi;
#define IN(k) (lo <= (k) && (k) < hi)
#define BOTH(k) (IN(k) && IN((k) + 1))
    const int bx = (int)blockIdx.x;

    if (IN(0)) { for (int rep = 0; rep <= DUP(0); ++rep) { p0_prologue(F, args); if (BOTH(0)) GRID_BAR(); } }
    if (IN(1)) for (int rep = 0; rep <= DUP(1); ++rep) {
        pg8::Gemm g{(const pg8::bf16_t*)(ws + WS_A), (const pg8::bf16_t*)(ws + WS_W1T), MT, 4096, 1024}; pg8::StaticOrder S; S.init(MT, 4096, F.G, bx);
        { LAS f32x4* cwl = (LAS f32x4*)(F.lds + RING_OFF + pg8::STAGE_BYTES); const f32x4* cwg = (const f32x4*)args.in[8];
          for (int i = F.tid; i < 3 * DM / 4; i += NWAVES * 64) cwl[i] = cwg[i]; __syncthreads(); }
        pg8::EpiConvIn E{(PG8_LAS const float*)(F.lds + RING_OFF + pg8::STAGE_BYTES), (pg8::bf16_t*)(ws + WS_B), (float*)(ws + WS_WHEAD), (float*)(ws + WS_PCHEAD), (float*)(ws + WS_UTAIL)};
        pg8::gemm_phase<pg8::EpiConvIn, pg8::StaticOrder, true, true>(F.lds + RING_OFF, g, S, E);
        if (tails && rep == 0 && bx >= 32) { if (!split) KV_CACHED(bx - 32, 1); else if (bx < 128) KV_CACHED(2 * (bx - 32), 2); else KV_CACHED(192 + (bx - 128), 1); }
        if (BOTH(1)) GRID_BAR();
    }
    if (IN(2)) { for (int rep = 0; rep <= DUP(2); ++rep) { p2_fixup(F, args); if (BOTH(2)) GRID_BAR(); } }
    if (IN(3)) for (int rep = 0; rep <= DUP(3); ++rep) {
        pg8::Gemm g{(const pg8::bf16_t*)(ws + WS_B), (const pg8::bf16_t*)(ws + WS_W2T), MT, 1024, 1024}; pg8::StaticOrder S; S.init(MT, 1024, F.G, bx);
        pg8::EpiResid E{(const pg8::bf16_t*)(ws + WS_A), (pg8::bf16_t*)(ws + WS_A), (float*)(ws + WS_SSQ1), (const float*)(ws + WS_RS0)};
        if (split) S.lim = 512;
        pg8::gemm_phase<pg8::EpiResid, pg8::StaticOrder, true, true>(F.lds + RING_OFF, g, S, E);
        if (split) { if (bx < 64) { pg8::Unit tv; S.unit_of(512 + (bx >> 3), tv); SPLIT_TAIL(pg8::EpiResid, E, ws + WS_B, ws + WS_W2T, 1024, tv.pm, tv.pn, bx >> 3, bx & 7, args.out, 0); }
                     else if (rep == 0) KV_CACHED(320 + 2 * (bx - 64), 2); }
        else if (tails && rep == 0 && bx >= 8) KV_CACHED(224 + 2 * (bx - 8), 2);
        if (BOTH(3)) GRID_BAR();
    }
    if (IN(4)) for (int rep = 0; rep <= DUP(4); ++rep) {
        pg8::Gemm g{(const pg8::bf16_t*)(ws + WS_A), (const pg8::bf16_t*)(ws + WS_W3T), MT, 1536, 1024}; pg8::StaticOrder S; S.init(MT, 1536, F.G, bx);
        pg8::EpiMlaIn E{(const float*)(ws + WS_SSQ1), args.in[13], (const float*)(ws + WS_ROPE), (pg8::bf16_t*)(ws + WS_QLAT), (pg8::bf16_t*)(ws + WS_CKVA), (pg8::bf16_t*)(ws + WS_KRP),
                        (pg8::bf16_t*)(ws + WS_KRS), (pg8::bf16_t*)(ws + WS_B), args.out, (float*)(ws + WS_SSQKV), (PG8_LAS float*)(F.lds + RING_OFF + pg8::STAGE_BYTES)};
        if (split) S.lim = 768;
        pg8::gemm_phase<pg8::EpiMlaIn, pg8::StaticOrder, true, true>(F.lds + RING_OFF, g, S, E);
        if (split) { if (bx < 96) { pg8::Unit tv; S.unit_of(768 + (bx >> 3), tv); SPLIT_TAIL(pg8::EpiMlaIn, E, ws + WS_A, ws + WS_W3T, 1536, tv.pm, tv.pn, bx >> 3, bx & 7, args.out + (size_t)4 * 1024 * 1024, 1); }
                     else if (rep == 0) KV_CACHED(704 + 2 * (bx - 96), 2); }
        else if (tails && rep == 0 && bx >= 12) { if (bx < 72) KV_CACHED(720 + 2 * (bx - 12), 2); else KV_CACHED(840 + (bx - 72), 1); }
        if (BOTH(4)) GRID_BAR();
    }
#define P5A() { pg8::Gemm g{(const pg8::bf16_t*)(ws + WS_QLAT), (const pg8::bf16_t*)(ws + WS_W4T), MT, 1536, 256}; pg8::StaticOrder S; S.init(MT, 1536, F.G, bx); \
          pg8::EpiQ E{(const float*)(ws + WS_SSQQ), (const float*)(ws + WS_ROPE), (pg8::bf16_t*)args.out, (pg8::bf16_t*)args.out + QP_ELEMS}; \
          pg8::gemm_phase<pg8::EpiQ, pg8::StaticOrder, true, true>(F.lds + RING_OFF, g, S, E); }
#define P5B(FIX) { pg8::Gemm g{(const pg8::bf16_t*)(ws + WS_CKVA), (const pg8::bf16_t*)(ws + WS_W5T), MKV, 2048, 128}; \
          pg8::EpiKV E{(const float*)(ws + WS_SSQKV), (pg8::bf16_t*)(ws + WS_K), (pg8::bf16_t*)(ws + WS_V), args.out, FIX}; \
          if (tails) { pg8::KvOrder S; S.init(130 * 256, 2048, F.G, bx); pg8::gemm_phase<pg8::EpiKV, pg8::KvOrder, true, true>(F.lds + RING_OFF, g, S, E); } \
          else { pg8::StaticOrder S; S.init(MKV, 2048, F.G, bx); pg8::gemm_phase<pg8::EpiKV, pg8::StaticOrder, true, true>(F.lds + RING_OFF, g, S, E); } }
    if (IN(5)) {
#if (PROBE_DUP) & 32
        P5A(); GRID_BAR();
#endif
#if (PROBE_DUP) & 512
        P5B(0); GRID_BAR();
#endif
        P5A(); P5B(0);
        if (BOTH(5)) GRID_BAR();
    }
    if (IN(6)) { for (int rep = 0; rep <= DUP(6); ++rep) { p6_attention(F, args, (char*)lds + RING_OFF, rep < DUP(6)); if (BOTH(6)) GRID_BAR(); } }
    const bool fuse78 = tails && N_LAUNCHES == 1 && IN(7) && IN(8);
    if (fuse78) {
        pg8::Gemm g{(const pg8::bf16_t*)(ws + WS_B), (const pg8::bf16_t*)(ws + WS_W6T), MT, 1024, 1024}; pg8::PanelOrder S{bx, split ? 128 : 130};
        pg8::EpiResidNorm E{(const pg8::bf16_t*)(ws + WS_A), args.out, args.in[6], (float*)(ws + WS_SSQ2), (PG8_LAS float*)(F.lds + RING_OFF + pg8::STAGE_BYTES)};
        pg8::gemm_phase<pg8::EpiResidNorm, pg8::PanelOrder, true, true>(F.lds + RING_OFF, g, S, E);
        if (split && bx < 64) SPLIT_TAIL(pg8::EpiResidNorm, E, ws + WS_B, ws + WS_W6T, 1024, 128 + (bx >> 5), (bx >> 3) & 3, bx >> 3, bx & 7, ws + WS_K, 2);
    }
    if (IN(7) && !fuse78) for (int rep = 0; rep <= DUP(7); ++rep) {
        pg8::Gemm g{(const pg8::bf16_t*)(ws + WS_B), (const pg8::bf16_t*)(ws + WS_W6T), MT, 1024, 1024}; pg8::StaticOrder S; S.init(MT, 1024, F.G, bx);
        pg8::EpiResid E{(const pg8::bf16_t*)(ws + WS_A), (pg8::bf16_t*)(ws + WS_K), (float*)(ws + WS_SSQ2), nullptr};
        pg8::gemm_phase<pg8::EpiResid, pg8::StaticOrder, true, true>(F.lds + RING_OFF, g, S, E);
        if (BOTH(7)) GRID_BAR();
    }
    if (IN(8) && !fuse78) { p8_final(F, args); }
#undef IN
#undef BOTH
#undef GRID_BAR
}

extern "C" void kernel_launch(void* const* d_in, const int* in_sizes, int n_in, void* d_out, int out_size, void* d_ws, size_t ws_size, hipStream_t stream) {
    static int grid = 0;
    if (grid == 0) {
        if (n_in != 16 || in_sizes[0] != MP * DM || in_sizes[1] != MS * DM || (size_t)out_size != O_END || ws_size < WS_END) {
            fprintf(stderr, "kernel_launch: shape mismatch: n_in %d in0 %d in1 %d out %d ws %zu (need >= %zu)\n", n_in, n_in > 0 ? in_sizes[0] : -1, n_in > 1 ? in_sizes[1] : -1, out_size, ws_size, (size_t)WS_END); grid = -1; return; }
        int dev = 0, cus = 0, per_cu = 0;
        if (hipGetDevice(&dev) != hipSuccess || hipDeviceGetAttribute(&cus, hipDeviceAttributeMultiprocessorCount, dev) != hipSuccess) { fprintf(stderr, "kernel_launch: device query failed\n"); grid = -1; return; }
        if (hipFuncSetAttribute((const void*)mk_fwd, hipFuncAttributeMaxDynamicSharedMemorySize, LDS_BYTES) != hipSuccess) { fprintf(stderr, "kernel_launch: hipFuncSetAttribute failed\n"); grid = -1; return; }
        if (hipOccupancyMaxActiveBlocksPerMultiprocessor(&per_cu, (const void*)mk_fwd, NWAVES * 64, LDS_BYTES) != hipSuccess || per_cu < 1) { fprintf(stderr, "kernel_launch: occupancy query says %d blocks per CU\n", per_cu); per_cu = 1; }
        (void)hipGetLastError();
        grid = cus;
        fprintf(stderr, "kernel_launch: grid %d (occupancy %d per CU)\n", grid, per_cu);
    }
    if (grid < 0) return;
    if (hipMemsetAsync((char*)d_ws + WS_CTL, 0, CTL_ZERO_BYTES, stream) != hipSuccess) { fprintf(stderr, "kernel_launch: memset failed\n"); return; }
    Args a{};
    for (int i = 0; i < 16; ++i) a.in[i] = (const float*)d_in[i];
    a.out = (float*)d_out; a.ws = (unsigned char*)d_ws;
    if (N_LAUNCHES == 1) {
        a.ph_lo = 0; a.ph_hi = PER_PHASE; a.li = 0;
        void* kargs[] = {&a};
        const hipError_t le = hipLaunchCooperativeKernel((const void*)mk_fwd, dim3(grid), dim3(NWAVES * 64), kargs, LDS_BYTES, stream);
        if (le != hipSuccess) fprintf(stderr, "kernel_launch: cooperative launch failed: %s (grid %d)\n", hipGetErrorName(le), grid);
    } else {
        for (int li = 0; li < PER_PHASE; ++li) {
            a.ph_lo = li; a.ph_hi = li + 1; a.li = li;
            hipLaunchKernelGGL(mk_fwd, dim3(grid), dim3(NWAVES * 64), LDS_BYTES, stream, a);
            const hipError_t le = hipPeekAtLastError();
            if (le != hipSuccess) { fprintf(stderr, "kernel_launch: launch %d failed: %s\n", li, hipGetErrorName(le)); break; }
        }
    }
}
```

```cpp
#include <hip/hip_runtime.h>
#include <hip/hip_bf16.h>
#include <cstdio>
#include <cstdint>
#include <cmath>

#ifndef MK_N_LAUNCHES
#define MK_N_LAUNCHES 1
#endif

constexpr int DM = 1024, SEQ = 8192, NB = 4, MP = NB * SEQ, SB = 8, ST = 64, MS = SB * ST, MT = MP + MS;
constexpr int PAST = 4096, SKV = PAST + ST, SKVP = 4224;
constexpr int NH = 16, DN = 64, DR = 32, DQK = 96, DV = 64, QL = 256, KVL = 128;
constexpr int MKV = MP + SB * PAST + MS;
constexpr int NCHUNK = MT / 64;
constexpr float EPS = 1e-6f;
constexpr float LOG2E = 1.4426950408889634f;
constexpr float C2 = 0.10206207261596577f * 1.4426950408889634f;
constexpr size_t O_YP = 0, O_YS = (size_t)MP * DM, O_CONVP = O_YS + (size_t)MS * DM, O_CKVP = O_CONVP + NB * 2 * DM, O_KRP = O_CKVP + (size_t)MP * KVL,
                 O_CONVS = O_KRP + (size_t)MP * DR, O_CKVS = O_CONVS + SB * 2 * DM, O_KRS = O_CKVS + (size_t)MS * KVL, O_END = O_KRS + (size_t)MS * DR;
static_assert(O_END == 39428096, "output size");

constexpr size_t MiB = 1u << 20;
constexpr size_t al256(size_t x) { return (x + 255) & ~(size_t)255; }
constexpr size_t WS_CTL = 0, CTL_ZERO_BYTES = 1 * MiB;
constexpr size_t WS_W1T = CTL_ZERO_BYTES;
constexpr size_t WS_W2T = WS_W1T + (size_t)4096 * 1024 * 2;
constexpr size_t WS_W3T = WS_W2T + (size_t)1024 * 1024 * 2;
constexpr size_t WS_W4T = WS_W3T + (size_t)1536 * 1024 * 2;
constexpr size_t WS_W5T = WS_W4T + (size_t)1536 * 256 * 2;
constexpr size_t WS_W6T = WS_W5T + (size_t)2048 * 128 * 2;
constexpr size_t WS_ROPE = WS_W6T + (size_t)1024 * 1024 * 2;
constexpr size_t WS_RS0 = WS_ROPE + (size_t)8192 * 32 * 4;
constexpr size_t WS_SSQ1 = al256(WS_RS0 + (size_t)MT * 4);
constexpr size_t WS_SSQ2 = WS_SSQ1 + (size_t)MT * 16 * 4;
constexpr size_t WS_SSQQ = WS_SSQ2 + (size_t)MT * 16 * 4;
constexpr size_t WS_SSQKV = WS_SSQQ + (size_t)MT * 4 * 4;
constexpr size_t WS_WHEAD = WS_SSQKV + (size_t)MT * 4 * 4;
constexpr size_t WS_PCHEAD = WS_WHEAD + (size_t)NCHUNK * 2 * DM * 4;
constexpr size_t WS_UTAIL = WS_PCHEAD + (size_t)NCHUNK * 2 * DM * 4;
constexpr size_t WS_KRP = WS_UTAIL + (size_t)NCHUNK * 2 * DM * 4;
constexpr size_t WS_KRS = WS_KRP + (size_t)MP * DR * 2;
constexpr size_t WS_SMALL_END = WS_KRS + (size_t)SB * SKVP * DR * 2;
constexpr size_t WS_B = 40 * MiB;
constexpr size_t WS_A = WS_B + 65 * MiB;
constexpr size_t QP_ELEMS = (size_t)NB * NH * SEQ * DQK, QS_ELEMS = (size_t)SB * NH * ST * DQK;
static_assert((QP_ELEMS + QS_ELEMS) * 2 <= (size_t)MT * DM * 4, "Q fits in the y region of d_out");
constexpr size_t WS_QLAT = al256(WS_A + (QP_ELEMS + QS_ELEMS) * 2);
constexpr size_t WS_CKVA = WS_QLAT + (size_t)MT * QL * 2;
constexpr size_t KP_ELEMS = (size_t)NB * NH * SEQ * DN, KS_ELEMS = (size_t)SB * NH * SKVP * DN;
constexpr size_t WS_K = al256(WS_CKVA + (size_t)MKV * KVL * 2);
constexpr size_t WS_V = WS_K + (KP_ELEMS + KS_ELEMS) * 2;
constexpr size_t WS_END = WS_V + (KP_ELEMS + KS_ELEMS) * 2;
static_assert(WS_SMALL_END <= WS_B && (size_t)MT * DM * 2 <= 65 * MiB && WS_END <= 512 * MiB, "d_ws map");

namespace pg8 {
#define PG8_LAS __attribute__((address_space(3)))
typedef unsigned short bf16_t;
typedef short bf16x8 __attribute__((ext_vector_type(8)));
typedef float f32x4 __attribute__((ext_vector_type(4)));
typedef unsigned u32x4 __attribute__((ext_vector_type(4)));
constexpr int BM = 256, BK = 64, HALF = 128, HTB = HALF * BK * 2  , STAGE_BYTES = 8 * HTB, NXCD = 8, WGM = 8;

__host__ __device__ __forceinline__ int lds_byte(int r, int c) { const int st = (r >> 4) * 2 + (c >> 5), rr = r & 15, cc = c & 31, ob = rr * 64 + cc * 2; return st * 1024 + (ob ^ (((ob >> 9) & 1) << 5)); }
__host__ __device__ __forceinline__ void stage_rc(int b, int& R, int& C) { const int st = b / 1024, sb = b % 1024, swz = sb ^ (((sb >> 9) & 1) << 5); R = (st >> 1) * 16 + swz / 64; C = (st & 1) * 32 + (swz % 64) / 2; }
__host__ __device__ __forceinline__ int perm32(int rho) { const int n = rho >> 4, i = rho & 15; return 8 * (i >> 2) + 4 * n + (i & 3); }

struct Unit { int pm, pn; };
struct Gemm { const bf16_t* A; const bf16_t* Bt; int M, N, K; int kt = 0; };

struct StaticOrder {
    int nM, nN, nwg, G, c, lim;
    __host__ __device__ __forceinline__ void init(int M, int N, int G_, int c_) { nM = M / BM; nN = N / BM; nwg = nM * nN; G = G_; c = c_; lim = nwg; }
    __host__ __device__ __forceinline__ bool next(int i, Unit& u) const { const long L = (long)i * G + c; if (L >= lim) return false; unit_of((int)L, u); return true; }
    __host__ __device__ __forceinline__ bool unit_of(int L, Unit& u) const {
        int wgid = L; { const int q = nwg / NXCD, r = nwg % NXCD, xcd = wgid % NXCD, off = wgid / NXCD; wgid = (xcd < r ? xcd * (q + 1) : r * (q + 1) + (xcd - r) * q) + off; }
        const int nig = WGM * nN, gid = wgid / nig, fm = gid * WGM, gsz = (nM - fm) < WGM ? (nM - fm) : WGM;
        u.pm = fm + ((wgid % nig) % gsz); u.pn = (wgid % nig) / gsz; return true;
    }
    __device__ __forceinline__ void a_ready(const Unit&) const {}
    __device__ __forceinline__ void done(const Unit&) const {}
};
struct OneUnit {
    int pm, pn, valid;
    __host__ __device__ __forceinline__ bool next(int i, Unit& u) const { if (i > 0 || !valid) return false; u.pm = pm; u.pn = pn; return true; }
    __device__ __forceinline__ void a_ready(const Unit&) const {}
    __device__ __forceinline__ void done(const Unit&) const {}
};
struct CachedOrder {
    int u0, n;
    __host__ __device__ __forceinline__ bool next(int i, Unit& u) const { if (i >= n) return false; const int x = u0 + i; u.pm = 128 + (x >> 3); u.pn = x & 7; return true; }
    __device__ __forceinline__ void a_ready(const Unit&) const {}
    __device__ __forceinline__ void done(const Unit&) const {}
};
struct KvOrder : StaticOrder {
    __host__ __device__ __forceinline__ bool next(int i, Unit& u) const { if (!StaticOrder::next(i, u)) return false; if (u.pm >= 128) u.pm += 128; return true; }
};
struct PanelOrder {
    int c, np;
    __host__ __device__ __forceinline__ bool next(int i, Unit& u) const { const int x = c & 7, s = c >> 3, p = 64 * i + 8 * x + (s >> 2); if (p >= np) return false; u.pm = p; u.pn = s & 3; return true; }
    __device__ __forceinline__ void a_ready(const Unit&) const {}
    __device__ __forceinline__ void done(const Unit&) const {}
};
typedef float f32x2 __attribute__((ext_vector_type(2)));
typedef unsigned u32x2 __attribute__((ext_vector_type(2)));
typedef __bf16 bf16x2_t __attribute__((ext_vector_type(2)));
__device__ __forceinline__ unsigned cvt_pk_bf16(float lo, float hi) { f32x2 v = {lo, hi}; bf16x2_t b = __builtin_convertvector(v, bf16x2_t); return __builtin_bit_cast(unsigned, b); }
__device__ __forceinline__ u32x2 pack4(const f32x4 v) { u32x2 w; w.x = cvt_pk_bf16(v[0], v[1]); w.y = cvt_pk_bf16(v[2], v[3]); return w; }
__device__ __forceinline__ u32x4 pack8(const f32x4 a, const f32x4 b) { u32x4 w; w.x = cvt_pk_bf16(a[0], a[1]); w.y = cvt_pk_bf16(a[2], a[3]); w.z = cvt_pk_bf16(b[0], b[1]); w.w = cvt_pk_bf16(b[2], b[3]); return w; }
__device__ __forceinline__ float dot4(const f32x4 v) { return (v[0] * v[0] + v[1] * v[1]) + (v[2] * v[2] + v[3] * v[3]); }
__device__ __forceinline__ float silu1(float z) { return z * __builtin_amdgcn_rcpf(1.0f + __builtin_amdgcn_exp2f(-z * LOG2E)); }
__device__ __forceinline__ float sum16(const float* p) { const f32x4 a = *(const f32x4*)p, b = *(const f32x4*)(p + 4), c = *(const f32x4*)(p + 8), d = *(const f32x4*)(p + 12);
    return (((a[0] + a[1]) + (a[2] + a[3])) + ((b[0] + b[1]) + (b[2] + b[3]))) + (((c[0] + c[1]) + (c[2] + c[3])) + ((d[0] + d[1]) + (d[2] + d[3]))); }
__device__ __forceinline__ float sum4(const float* p) { const f32x4 a = *(const f32x4*)p; return (a[0] + a[1]) + (a[2] + a[3]); }

struct EpiConvIn {
    static constexpr bool PERM = false, AFTER_DRAIN = false;
    PG8_LAS const float* convw; bf16_t* g; float* whead; float* pchead; float* utail;
    __device__ __forceinline__ void operator()(const f32x4 (&acc)[2][2][4][2], const Unit& u, int wr, int wc, int fr, int fq) const {
        asm volatile("" : "+v"(fr), "+v"(fq));
        const int lane = fq * 16 + fr, ch0 = u.pn * 64 + wc * 16 + fq * 4;
        const f32x4 cw0 = *(PG8_LAS const f32x4*)(convw + ch0), cw1 = *(PG8_LAS const f32x4*)(convw + DM + ch0), cw2 = *(PG8_LAS const f32x4*)(convw + 2 * DM + ch0);
        (void)lane;
#pragma unroll
        for (int ai = 0; ai < 2; ++ai) {
            const int rowc = u.pm * BM + ai * HALF + wr * 64, chunk = rowc >> 6;
            f32x4 r1p = (f32x4){0.f, 0.f, 0.f, 0.f}, r2p = r1p;
#pragma unroll
            for (int m = 0; m < 4; ++m) {
                const int row = rowc + m * 16 + fr;
                const f32x4 bg = acc[ai][0][m][0], cg = acc[ai][0][m][1], xv = acc[ai][1][m][0], z = acc[ai][1][m][1];
                const f32x4 uu = cg * xv; f32x4 w, p1, p2;
                f32x4 r1, r2;
#pragma unroll
                for (int e = 0; e < 4; ++e) { w[e] = silu1(z[e]) * bg[e];
                    r1[e] = __int_as_float(__builtin_amdgcn_update_dpp(0, __float_as_int(uu[e]), 0x121, 0xf, 0xf, false));
                    r2[e] = __int_as_float(__builtin_amdgcn_update_dpp(0, __float_as_int(uu[e]), 0x122, 0xf, 0xf, false));
                    p1[e] = fr >= 1 ? r1[e] : r1p[e]; p2[e] = fr >= 2 ? r2[e] : r2p[e]; }
                const f32x4 conv = cw2 * uu + cw1 * p1 + cw0 * p2;
                if (m == 0 && fr < 2) { *(f32x4*)(whead + (size_t)(chunk * 2 + fr) * DM + ch0) = w; *(f32x4*)(pchead + (size_t)(chunk * 2 + fr) * DM + ch0) = conv; }
                else { *(u32x2*)(g + (size_t)row * DM + ch0) = pack4(w * conv); }
                if (m == 3 && fr >= 14) *(f32x4*)(utail + (size_t)(chunk * 2 + fr - 14) * DM + ch0) = uu;
                r1p = r1; r2p = r2;
            }
        }
    }
};

struct EpiResid {
    static constexpr bool PERM = false, AFTER_DRAIN = false;
    const bf16_t* xin; bf16_t* xo; float* ssq; const float* rinv;
    __device__ __forceinline__ void operator()(const f32x4 (&acc)[2][2][4][2], const Unit& u, int wr, int wc, int fr, int fq, int only = -1) const {
        asm volatile("" : "+v"(fr), "+v"(fq));
        const unsigned col0 = (unsigned)(u.pn * BM + wc * 32 + 8 * fq), off0 = (unsigned)(u.pm * BM + wr * 64 + fr) * DM + col0;
#pragma unroll
        for (int ai = 0; ai < 2; ++ai) {
            u32x4 xi[4][2]; float riv[4];
#pragma unroll
            for (int m = 0; m < 4; ++m) { if (only >= 0 && only != ai * 4 + m) continue;
                riv[m] = rinv ? rinv[u.pm * BM + ai * HALF + wr * 64 + m * 16 + fr] : 1.f;
#pragma unroll
                for (int bj = 0; bj < 2; ++bj) xi[m][bj] = __builtin_nontemporal_load((const u32x4*)(xin + (off0 + (unsigned)((ai * HALF + m * 16) * DM + bj * HALF)))); }
#pragma unroll
            for (int m = 0; m < 4; ++m) { if (only >= 0 && only != ai * 4 + m) continue; const unsigned row = (unsigned)(u.pm * BM + ai * HALF + wr * 64 + m * 16 + fr), off = off0 + (unsigned)((ai * HALF + m * 16) * DM); float ss = 0.f; const float ri = riv[m];
#pragma unroll
                for (int bj = 0; bj < 2; ++bj) { const u32x4 x = xi[m][bj]; f32x4 a = acc[ai][bj][m][0], b = acc[ai][bj][m][1];
                    a[0] = fmaf(__uint_as_float(x.x << 16), ri, a[0]); a[1] = fmaf(__uint_as_float(x.x & 0xffff0000u), ri, a[1]); a[2] = fmaf(__uint_as_float(x.y << 16), ri, a[2]); a[3] = fmaf(__uint_as_float(x.y & 0xffff0000u), ri, a[3]);
                    b[0] = fmaf(__uint_as_float(x.z << 16), ri, b[0]); b[1] = fmaf(__uint_as_float(x.z & 0xffff0000u), ri, b[1]); b[2] = fmaf(__uint_as_float(x.w << 16), ri, b[2]); b[3] = fmaf(__uint_as_float(x.w & 0xffff0000u), ri, b[3]);
                    ss += dot4(a) + dot4(b); *(u32x4*)(xo + (off + bj * HALF)) = pack8(a, b); }
                ss += __shfl_xor(ss, 16); ss += __shfl_xor(ss, 32);
                if (fq == 0) ssq[row * 16u + u.pn * 4 + wc] = ss; }
        }
    }
};

struct EpiResidNorm {
    static constexpr bool PERM = false, AFTER_DRAIN = false;
    const bf16_t* xin; float* y; const float* gf; float* xs; PG8_LAS float* sc;
    __device__ __forceinline__ void operator()(f32x4 (&acc)[2][2][4][2], const Unit& u, int wr, int wc, int fr, int fq, int only = -1) const {
        asm volatile("" : "+v"(fr), "+v"(fq));
        const unsigned col0 = (unsigned)(u.pn * BM + wc * 32 + 8 * fq);
#pragma unroll
        for (int ai = 0; ai < 2; ++ai)
#pragma unroll
            for (int m = 0; m < 4; ++m) { if (only >= 0 && only != ai * 4 + m) continue; const int rl = ai * HALF + wr * 64 + m * 16 + fr; const unsigned off = (unsigned)(u.pm * BM + rl) * DM + col0; float ss = 0.f;
#pragma unroll
                for (int bj = 0; bj < 2; ++bj) { const u32x4 xi = __builtin_nontemporal_load((const u32x4*)(xin + (off + bj * HALF))); f32x4 a = acc[ai][bj][m][0], b = acc[ai][bj][m][1];
                    a[0] += __uint_as_float(xi.x << 16); a[1] += __uint_as_float(xi.x & 0xffff0000u); a[2] += __uint_as_float(xi.y << 16); a[3] += __uint_as_float(xi.y & 0xffff0000u);
                    b[0] += __uint_as_float(xi.z << 16); b[1] += __uint_as_float(xi.z & 0xffff0000u); b[2] += __uint_as_float(xi.w << 16); b[3] += __uint_as_float(xi.w & 0xffff0000u);
                    ss += dot4(a) + dot4(b); acc[ai][bj][m][0] = a; acc[ai][bj][m][1] = b; }
                ss += __shfl_xor(ss, 16); ss += __shfl_xor(ss, 32);
                if (fq == 0) sc[rl * 4 + wc] = ss; }
        const int t = (wr * 4 + wc) * 64 + fq * 16 + fr;
        asm volatile("s_waitcnt lgkmcnt(0)" ::: "memory"); __builtin_amdgcn_s_barrier();
        if (t < 256 && (only < 0 || only == ((t >> 7) * 4 + ((t >> 4) & 3)))) { const f32x4 q4 = *(const PG8_LAS f32x4*)(sc + t * 4);   const float mine = (q4[0] + q4[1]) + (q4[2] + q4[3]);
            float* sl = xs + ((unsigned)(u.pm * 4) * 256u + t);
            __hip_atomic_store(sl + u.pn * 256, mine, __ATOMIC_RELAXED, __HIP_MEMORY_SCOPE_AGENT);
            float v[4]; unsigned sp = 0; bool ok;
            do { ok = true;
#pragma unroll
                for (int q = 0; q < 4; ++q) v[q] = __hip_atomic_load(sl + q * 256, __ATOMIC_RELAXED, __HIP_MEMORY_SCOPE_AGENT);
#pragma unroll
                for (int q = 0; q < 4; ++q) ok = ok && (q == u.pn || __float_as_uint(v[q]) != 0xFFFFFFFFu);
            } while (!ok && ++sp < (1u << 20));
#pragma unroll
            for (int q = 0; q < 4; ++q) v[q] = (q == u.pn) ? mine : v[q];
            sc[1024 + t] = 1.0f / sqrtf(((v[0] + v[1]) + (v[2] + v[3])) * (1.0f / DM) + EPS); }
        asm volatile("s_waitcnt lgkmcnt(0)" ::: "memory"); __builtin_amdgcn_s_barrier();
#pragma unroll
        for (int ai = 0; ai < 2; ++ai)
#pragma unroll
            for (int m = 0; m < 4; ++m) { if (only >= 0 && only != ai * 4 + m) continue; const int rl = ai * HALF + wr * 64 + m * 16 + fr; const float rs = sc[1024 + rl]; float* yr = y + ((unsigned)(u.pm * BM + rl) * DM + col0);
#pragma unroll
                for (int bj = 0; bj < 2; ++bj) { const f32x4 g0 = *(const f32x4*)(gf + col0 + bj * HALF), g1 = *(const f32x4*)(gf + col0 + bj * HALF + 4);
                    *(f32x4*)(yr + bj * HALF) = acc[ai][bj][m][0] * rs * g0; *(f32x4*)(yr + bj * HALF + 4) = acc[ai][bj][m][1] * rs * g1; } }
        asm volatile("s_waitcnt lgkmcnt(0)" ::: "memory"); __builtin_amdgcn_s_barrier();
    }
};

struct EpiMlaIn {
    static constexpr bool PERM = false, AFTER_DRAIN = false;
    const float* ssq1; const float* gkv; const float* rope; bf16_t* qlat; bf16_t* ckva; bf16_t* krp; bf16_t* krs; bf16_t* sz; float* out; float* ssqkv; PG8_LAS float* sc;
    __device__ __forceinline__ void operator()(const f32x4 (&acc)[2][2][4][2], const Unit& u, int wr, int wc, int fr, int fq, int only = -1) const {
        asm volatile("" : "+v"(fr), "+v"(fq));
        float rsv[2][4];
        { f32x4 q4[2][4];
#pragma unroll
          for (int ai = 0; ai < 2; ++ai)
#pragma unroll
            for (int m = 0; m < 4; ++m) q4[ai][m] = *(const f32x4*)(ssq1 + (size_t)(u.pm * BM + ai * HALF + wr * 64 + m * 16 + fr) * 16 + 4 * fq);
#pragma unroll
          for (int ai = 0; ai < 2; ++ai)
#pragma unroll
            for (int m = 0; m < 4; ++m) rsv[ai][m] = (q4[ai][m][0] + q4[ai][m][1]) + (q4[ai][m][2] + q4[ai][m][3]);
#pragma unroll
          for (int ai = 0; ai < 2; ++ai)
#pragma unroll
            for (int m = 0; m < 4; ++m) rsv[ai][m] += __shfl_xor(rsv[ai][m], 16);
#pragma unroll
          for (int ai = 0; ai < 2; ++ai)
#pragma unroll
            for (int m = 0; m < 4; ++m) { rsv[ai][m] += __shfl_xor(rsv[ai][m], 32); rsv[ai][m] = 1.0f / sqrtf(rsv[ai][m] * (1.0f / DM) + EPS); } }
        if (u.pn < 2) {
            const bool isq = u.pn == 0;
            const f32x4 gk0 = *(const f32x4*)(gkv + wc * 32 + 4 * fq), gk1 = *(const f32x4*)(gkv + wc * 32 + 16 + 4 * fq);
#pragma unroll
            for (int ai = 0; ai < 2; ++ai)
#pragma unroll
                for (int m = 0; m < 4; ++m) { if (only >= 0 && only != ai * 4 + m) continue; const int rl = ai * HALF + wr * 64 + m * 16 + fr; const float rs = rsv[ai][m];
                    const f32x4 a0 = acc[ai][0][m][0] * rs, a1 = acc[ai][0][m][1] * rs; float ss = dot4(a0) + dot4(a1);
                    if (isq) { const f32x4 b0 = acc[ai][1][m][0] * rs, b1 = acc[ai][1][m][1] * rs; ss += dot4(b0) + dot4(b1); }
                    ss += __shfl_xor(ss, 16); ss += __shfl_xor(ss, 32);
                    if (fq == 0) sc[rl * 4 + wc] = ss; }
            asm volatile("s_waitcnt lgkmcnt(0)" ::: "memory"); __builtin_amdgcn_s_barrier();
#pragma unroll
            for (int ai = 0; ai < 2; ++ai)
#pragma unroll
                for (int m = 0; m < 4; ++m) { if (only >= 0 && only != ai * 4 + m) continue; const int rl = ai * HALF + wr * 64 + m * 16 + fr, row = u.pm * BM + rl; const float rs = rsv[ai][m];
                    const f32x4 q = *(const PG8_LAS f32x4*)(sc + rl * 4); const float tot = (q[0] + q[1]) + (q[2] + q[3]);
                    if (isq) { const float f = rs / sqrtf(tot * (1.0f / QL) + EPS);
#pragma unroll
                        for (int bj = 0; bj < 2; ++bj) *(u32x4*)(qlat + (size_t)row * QL + bj * HALF + wc * 32 + 8 * fq) = pack8(acc[ai][bj][m][0] * f, acc[ai][bj][m][1] * f);
                    } else { const float r2 = 1.0f / sqrtf(tot * (1.0f / KVL) + EPS), f = rs * r2;
                        if (fq == 0) ssqkv[(size_t)row * 4 + wc] = q[wc] * (r2 * r2);
                        float* co = out + (row < MP ? O_CKVP + (size_t)row * KVL : O_CKVS + (size_t)(row - MP) * KVL); bf16_t* cb = ckva + (size_t)(row < MP ? row : row + SB * PAST) * KVL;
#pragma unroll
                        for (int n = 0; n < 2; ++n) { const int c = wc * 32 + n * 16 + 4 * fq; const f32x4 v = acc[ai][0][m][n] * f * (n == 0 ? gk0 : gk1); *(f32x4*)(co + c) = v; *(u32x2*)(cb + c) = pack4(v); }
                        if (wc == 0) {
                            const int pos = row < MP ? (row & (SEQ - 1)) : PAST + ((row - MP) & (ST - 1));
                            const f32x4 cs = *(const f32x4*)(rope + (size_t)pos * 32 + 4 * fq), sn = *(const f32x4*)(rope + (size_t)pos * 32 + 16 + 4 * fq);
                            const f32x4 x1 = acc[ai][1][m][0] * rs, x2 = acc[ai][1][m][1] * rs, o1 = x1 * cs - x2 * sn, o2 = x2 * cs + x1 * sn;
                            float* ko = out + (row < MP ? O_KRP + (size_t)row * DR : O_KRS + (size_t)(row - MP) * DR);
                            *(f32x4*)(ko + 4 * fq) = o1; *(f32x4*)(ko + 16 + 4 * fq) = o2;
                            bf16_t* kb = row < MP ? krp + (((unsigned)row >> 6) * 2048u + ((unsigned)row & 63) * 8u) : krs + ((((unsigned)(row - MP) >> 6) * (SKVP / 64) + PAST / 64) * 2048u + ((unsigned)(row - MP) & 63) * 8u);
                            *(u32x2*)(kb + (fq >> 1) * 512 + 4 * (fq & 1)) = pack4(o1); *(u32x2*)(kb + (2 + (fq >> 1)) * 512 + 4 * (fq & 1)) = pack4(o2); } }
                    asm volatile("" ::: "memory"); }
        } else {
#pragma unroll
            for (int ai = 0; ai < 2; ++ai)
#pragma unroll
                for (int m = 0; m < 4; ++m) { if (only >= 0 && only != ai * 4 + m) continue; const int row = u.pm * BM + ai * HALF + wr * 64 + m * 16 + fr; const float rs = rsv[ai][m];
#pragma unroll
                    for (int bj = 0; bj < 2; ++bj) { f32x4 a = acc[ai][bj][m][0] * rs, b = acc[ai][bj][m][1] * rs;
#pragma unroll
                        for (int e = 0; e < 4; ++e) { a[e] = silu1(a[e]); b[e] = silu1(b[e]); }
                        *(u32x4*)(sz + (size_t)row * DM + (u.pn - 2) * BM + bj * HALF + wc * 32 + 8 * fq) = pack8(a, b); }
                    asm volatile("" ::: "memory"); }
        }
    }
};


template <class Inner> struct EpiSplit {
    static constexpr bool PERM = Inner::PERM, AFTER_DRAIN = false;
    Inner in; float* scr; unsigned* cnt; int tu, slice;
    __device__ __forceinline__ void operator()(f32x4 (&acc)[2][2][4][2], const Unit& u, int wr, int wc, int fr, int fq) const {
        int lane_ = fq * 16 + fr; asm volatile("" : "+v"(lane_));
        const unsigned tid = (unsigned)((wr * 4 + wc) * 64 + lane_);
        f32x4* mine = (f32x4*)scr + ((size_t)(tu * 8 + slice) * 32u) * 512u + tid;
#pragma unroll
        for (int ai = 0; ai < 2; ++ai)
#pragma unroll
            for (int bj = 0; bj < 2; ++bj)
#pragma unroll
                for (int m = 0; m < 4; ++m)
#pragma unroll
                    for (int n = 0; n < 2; ++n) mine[(unsigned)(((ai * 2 + bj) * 4 + m) * 2 + n) * 512u] = acc[ai][bj][m][n];
        asm volatile("s_waitcnt vmcnt(0)" ::: "memory"); __builtin_amdgcn_s_barrier();
        if (tid == 0) { unsigned* c = cnt + tu * 16;
            __builtin_amdgcn_fence(__ATOMIC_RELEASE, "agent"); asm volatile("s_waitcnt vmcnt(0)" ::: "memory");
            (void)__hip_atomic_fetch_add(c, 1u, __ATOMIC_RELAXED, __HIP_MEMORY_SCOPE_AGENT);
            unsigned sp = 0; while (__hip_atomic_load(c, __ATOMIC_RELAXED, __HIP_MEMORY_SCOPE_AGENT) < 8u && ++sp < (1u << 22)) __builtin_amdgcn_s_sleep(1);
            __builtin_amdgcn_fence(__ATOMIC_ACQUIRE, "agent"); asm volatile("s_waitcnt vmcnt(0)" ::: "memory"); }
        __builtin_amdgcn_s_barrier();
        const f32x4* all = (const f32x4*)scr + ((size_t)(tu * 8) * 32u) * 512u + tid;
#pragma unroll
        for (int ai = 0; ai < 2; ++ai)
#pragma unroll
            for (int m = 0; m < 4; ++m) { if (slice != ai * 4 + m) continue;
#pragma unroll
                for (int bj = 0; bj < 2; ++bj)
#pragma unroll
                    for (int n = 0; n < 2; ++n) { const unsigned f = (unsigned)(((ai * 2 + bj) * 4 + m) * 2 + n) * 512u; f32x4 t = all[f];
#pragma unroll
                        for (int s = 1; s < 8; ++s) t += all[(unsigned)s * (32u * 512u) + f];
                        acc[ai][bj][m][n] = t; } }
        in(acc, u, wr, wc, fr, fq, slice);
    }
};

struct EpiQ {
    static constexpr bool PERM = false, AFTER_DRAIN = false;
    const float* ssqq; const float* rope; bf16_t* Qp; bf16_t* Qs;
    __device__ __forceinline__ void operator()(const f32x4 (&acc)[2][2][4][2], const Unit& u, int wr, int wc, int fr, int fq) const {
        asm volatile("" : "+v"(fr), "+v"(fq));
        const bool smp = u.pm * BM >= MP;
        bf16_t* Qb = smp ? Qs : Qp; const unsigned hs = smp ? (unsigned)(ST * DQK) : (unsigned)(SEQ * DQK);
#pragma unroll
        for (int ai = 0; ai < 2; ++ai) {
            f32x4 csv[4], snv[4];
            if (u.pn >= 4) {
#pragma unroll
                for (int m = 0; m < 4; ++m) { const int row = u.pm * BM + ai * HALF + wr * 64 + m * 16 + fr; const int pos = smp ? PAST + ((row - MP) & 63) : (row & (SEQ - 1));
                    csv[m] = *(const f32x4*)(rope + (unsigned)(pos * 32 + 4 * fq)); snv[m] = *(const f32x4*)(rope + (unsigned)(pos * 32 + 16 + 4 * fq)); }
            }
#pragma unroll
            for (int m = 0; m < 4; ++m) { const int row = u.pm * BM + ai * HALF + wr * 64 + m * 16 + fr;
                const float rq = 1.f;
                unsigned qo; int pos;
                if (!smp) { const unsigned b = (unsigned)row >> 13, s = (unsigned)row & (SEQ - 1); qo = (b * (NH * SEQ) + s) * DQK; pos = (int)s; }
                else { const unsigned r2 = (unsigned)(row - MP), b = r2 >> 6, s = r2 & 63; qo = (b * (NH * ST) + s) * DQK; pos = PAST + (int)s; }
                if (u.pn < 4) {
#pragma unroll
                    for (int bj = 0; bj < 2; ++bj) { const unsigned L = (unsigned)(u.pn * BM + bj * HALF + wc * 32 + 8 * fq), head = L >> 6, d = L & 63;
                        *(u32x4*)(Qb + (qo + head * hs + d)) = pack8(acc[ai][bj][m][0] * rq, acc[ai][bj][m][1] * rq); }
                } else {
                    const f32x4 cs = csv[m], sn = snv[m];
#pragma unroll
                    for (int bj = 0; bj < 2; ++bj) { const unsigned head = (unsigned)((u.pn - 4) * 8 + bj * 4 + wc);
                        const f32x4 x1 = acc[ai][bj][m][0] * rq, x2 = acc[ai][bj][m][1] * rq, o1 = x1 * cs - x2 * sn, o2 = x2 * cs + x1 * sn;
                        *(u32x2*)(Qb + (qo + head * hs + DN + 4 * fq)) = pack4(o1); *(u32x2*)(Qb + (qo + head * hs + DN + 16 + 4 * fq)) = pack4(o2); }
                }
                asm volatile("" ::: "memory");
            } }
    }
};

struct EpiKV {
    static constexpr bool PERM = false, AFTER_DRAIN = false;
    const float* ssqkv; bf16_t* K; bf16_t* V; float* out; int fix;
    __device__ __forceinline__ void operator()(const f32x4 (&acc)[2][2][4][2], const Unit& u, int wr, int wc, int fr, int fq) const {
        asm volatile("" : "+v"(fr), "+v"(fq));
        const bool isK = u.pn < 4; bf16_t* T = isK ? K : V; const int pn4 = u.pn & 3;
        const int cat = u.pm * BM < MP ? 0 : (u.pm * BM < MP + SB * PAST ? 1 : 2);
        const unsigned hs = cat == 0 ? (unsigned)(SEQ * DN) : (unsigned)(SKVP * DN);
        const int rbase = cat == 0 ? u.pm * BM : (cat == 2 ? u.pm * BM - SB * PAST : -1);
        float rkv[2][4];
        { f32x4 sq[2][4];
          if (rbase >= 0) {
#pragma unroll
            for (int ai = 0; ai < 2; ++ai)
#pragma unroll
                for (int m = 0; m < 4; ++m) sq[ai][m] = *(const f32x4*)(ssqkv + (unsigned)(rbase + ai * HALF + wr * 64 + m * 16 + fr) * 4u);
          }
#pragma unroll
          for (int ai = 0; ai < 2; ++ai)
#pragma unroll
            for (int m = 0; m < 4; ++m) rkv[ai][m] = rbase >= 0 ? 1.0f / sqrtf(((sq[ai][m][0] + sq[ai][m][1]) + (sq[ai][m][2] + sq[ai][m][3])) * (1.0f / KVL) + EPS) : 1.f; }
#pragma unroll
        for (int ai = 0; ai < 2; ++ai)
#pragma unroll
            for (int m = 0; m < 4; ++m) { const unsigned R = (unsigned)(u.pm * BM + ai * HALF + wr * 64 + m * 16 + fr);
                unsigned sb, s; float rk = 1.f; int r = -1;
                if (cat == 0) { const unsigned b = R >> 13; s = R & (SEQ - 1); sb = b * (NH * SEQ * DN); r = (int)R; }
                else if (cat == 1) { const unsigned r2 = R - MP, b = r2 >> 12; s = r2 & (PAST - 1); sb = (unsigned)KP_ELEMS + b * (NH * SKVP * DN); }
                else { const unsigned r2 = R - MP - SB * PAST, b = r2 >> 6; s = PAST + (r2 & 63); sb = (unsigned)KP_ELEMS + b * (NH * SKVP * DN); r = MP + (int)r2; }
                rk = rkv[ai][m];
                const unsigned key = s & 63, kk = key, tb = sb + (s >> 6) * 4096u;
#pragma unroll
                for (int bj = 0; bj < 2; ++bj) { const unsigned L = (unsigned)(pn4 * BM + bj * HALF + wc * 32 + 8 * fq), head = L >> 6, c = (L & 63) >> 3;
                    const unsigned off = isK ? c * 512u + key * 8u : ((kk >> 3) * 2 + (c >> 2)) * 256u + (kk & 7) * 32u + (c & 3) * 8u;
                    *(u32x4*)(T + (tb + head * hs + off)) = pack8(acc[ai][bj][m][0] * rk, acc[ai][bj][m][1] * rk); }
                if (fix && u.pn == 0 && r >= 0) { float* co = out + ((unsigned)(r < MP ? O_CKVP : O_CKVS - (size_t)MP * KVL) + (unsigned)r * KVL + wc * 32 + 8 * fq);
                    const f32x4 a = *(const f32x4*)co, b = *(const f32x4*)(co + 4); *(f32x4*)co = a * rk; *(f32x4*)(co + 4) = b * rk; }
                asm volatile("" ::: "memory");
            }
    }
};

template <class Epi, class Sched, bool ALIGN_EPI = false, bool SP2 = false>
__device__ __forceinline__ void gemm_phase(PG8_LAS unsigned char* lds, const Gemm g, const Sched& S, const Epi& E) {
    int tid_ = threadIdx.x; asm volatile("" : "+v"(tid_));
    const int tid = tid_, wid = __builtin_amdgcn_readfirstlane(tid >> 6), lane = tid & 63, wr = wid >> 2, wc = wid & 3, fr = lane & 15, fq = lane >> 4;
    const int K = g.K, nt = g.kt > 0 ? g.kt : K / BK;
    unsigned voffA[2], voffB[2];
#pragma unroll
    for (int i = 0; i < 2; ++i) { int R, C; stage_rc(tid * 16 + i * 8192, R, C); const int Rb = Epi::PERM ? ((R & ~31) + perm32(R & 31)) : R;
        voffA[i] = (unsigned)(R * K + C) * 2u; voffB[i] = (unsigned)(Rb * K + C) * 2u; }
    const size_t kstep = (size_t)(BK * 2);
    const size_t hstep = (size_t)HALF * K * 2;
    const size_t tstep = 2 * hstep;
    const unsigned ldsw = (unsigned)wid * 1024u;
    const int aoff = lds_byte(wr * 64 + fr, fq * 8), boff = lds_byte(wc * 32 + fr, fq * 8);
#define PG8_SA(b, h) (((b) * 2 + (h)) * HTB)
#define PG8_SB(b, h) ((4 + (b) * 2 + (h)) * HTB)
#define PG8_STAGE(bufoff, gbase, voff) do { _Pragma("unroll") for (int _i = 0; _i < 2; ++_i) \
        __builtin_amdgcn_global_load_lds((const unsigned*)((const char*)(gbase) + (voff)[_i]), (PG8_LAS unsigned*)(lds + (bufoff) + ldsw + _i * 8192), 16, 0, 0); } while (0)
#define PG8_LDA(dst, b, h) do { _Pragma("unroll") for (int m = 0; m < 4; ++m) _Pragma("unroll") for (int k = 0; k < 2; ++k) dst[m][k] = *(const PG8_LAS bf16x8*)(lds + PG8_SA(b, h) + aoff + m * 2048 + k * 1024); } while (0)
#define PG8_LDB(dst, b, h) do { _Pragma("unroll") for (int n = 0; n < 2; ++n) _Pragma("unroll") for (int k = 0; k < 2; ++k) dst[n][k] = *(const PG8_LAS bf16x8*)(lds + PG8_SB(b, h) + boff + n * 2048 + k * 1024); } while (0)
#define PG8_MMA(ai, bj, At, Bt) do { __builtin_amdgcn_s_setprio(1); _Pragma("unroll") for (int m = 0; m < 4; ++m) _Pragma("unroll") for (int n = 0; n < 2; ++n) _Pragma("unroll") for (int k = 0; k < 2; ++k) \
        acc[ai][bj][m][n] = __builtin_amdgcn_mfma_f32_16x16x32_bf16(Bt[n][k], At[m][k], acc[ai][bj][m][n], 0, 0, 0); __builtin_amdgcn_s_setprio(0); } while (0)
#define PG8_WAIT_V(n) asm volatile("s_waitcnt vmcnt(" #n ")" ::: "memory")
#define PG8_WAIT_L(n) asm volatile("s_waitcnt lgkmcnt(" #n ")" ::: "memory")
#define PG8_BAR __builtin_amdgcn_s_barrier()
#define PG8_SCHED __builtin_amdgcn_sched_barrier(0)
    Unit cur, nxt; int ui = 0;
    if (!S.next(0, cur)) return;
    f32x4 acc[2][2][4][2];
#pragma unroll
    for (int a = 0; a < 2; ++a)
#pragma unroll
        for (int b = 0; b < 2; ++b)
#pragma unroll
            for (int m = 0; m < 4; ++m)
#pragma unroll
                for (int n = 0; n < 2; ++n) acc[a][b][m][n] = (f32x4){0.f, 0.f, 0.f, 0.f};
    bf16x8 At[4][2], B0[2][2], B1[2][2];
    const char* cA = (const char*)g.A + (size_t)cur.pm * tstep; const char* cB = (const char*)g.Bt + (size_t)cur.pn * tstep;
    S.a_ready(cur);
    if constexpr (SP2) {
        PG8_STAGE(PG8_SB(0, 0), cB, voffB); PG8_STAGE(PG8_SB(0, 1), cB + hstep, voffB); PG8_STAGE(PG8_SA(0, 0), cA, voffA); PG8_STAGE(PG8_SA(0, 1), cA + hstep, voffA);
        if (wr == 1) PG8_BAR;
        PG8_WAIT_V(2); PG8_BAR;
        PG8_STAGE(PG8_SB(1, 0), cB + kstep, voffB); PG8_STAGE(PG8_SA(1, 0), cA + kstep, voffA); PG8_STAGE(PG8_SB(1, 1), cB + hstep + kstep, voffB);
        PG8_WAIT_V(6); PG8_BAR;
    } else {
        PG8_STAGE(PG8_SB(0, 0), cB, voffB); PG8_STAGE(PG8_SA(0, 0), cA, voffA); PG8_STAGE(PG8_SB(0, 1), cB + hstep, voffB); PG8_STAGE(PG8_SA(0, 1), cA + hstep, voffA);
        if (wr == 1) PG8_BAR;
        PG8_WAIT_V(4); PG8_BAR;
        PG8_STAGE(PG8_SB(1, 0), cB + kstep, voffB); PG8_STAGE(PG8_SA(1, 0), cA + kstep, voffA); PG8_STAGE(PG8_SB(1, 1), cB + hstep + kstep, voffB);
        PG8_WAIT_V(6); PG8_BAR;
    }
    for (;;) {
        const bool has_next = S.next(ui + 1, nxt);
        const char* nA = has_next ? (const char*)g.A + (size_t)nxt.pm * tstep : cA; const char* nB = has_next ? (const char*)g.Bt + (size_t)nxt.pn * tstep : cB;
#pragma unroll 1
        for (int t = 0; t < nt; t += 2) {
            const bool last = (t == nt - 2);
            const char* a1 = cA + (size_t)(t + 1) * kstep;
            const char* a2 = last ? nA : cA + (size_t)(t + 2) * kstep; const char* b2 = last ? nB : cB + (size_t)(t + 2) * kstep;
            const char* a3 = a2 + kstep; const char* b3 = b2 + kstep;
            if (last && has_next) S.a_ready(nxt);
            if constexpr (SP2) {
            PG8_LDB(B0, 0, 0); PG8_LDB(B1, 0, 1); PG8_SCHED; PG8_LDA(At, 0, 0); PG8_STAGE(PG8_SA(1, 1), a1 + hstep, voffA);
            PG8_WAIT_V(8); PG8_WAIT_L(0); PG8_BAR; PG8_MMA(0, 0, At, B0); PG8_MMA(0, 1, At, B1); PG8_BAR; PG8_SCHED;
            PG8_LDA(At, 0, 1); PG8_STAGE(PG8_SB(0, 0), b2, voffB); PG8_STAGE(PG8_SB(0, 1), b2 + hstep, voffB); PG8_STAGE(PG8_SA(0, 0), a2, voffA);
            PG8_WAIT_V(8); PG8_WAIT_L(0); PG8_BAR; PG8_MMA(1, 0, At, B0); PG8_MMA(1, 1, At, B1); PG8_BAR; PG8_SCHED;
            PG8_LDB(B0, 1, 0); PG8_LDB(B1, 1, 1); PG8_SCHED; PG8_LDA(At, 1, 0); PG8_STAGE(PG8_SA(0, 1), a2 + hstep, voffA);
            PG8_WAIT_V(8); PG8_WAIT_L(0); PG8_BAR; PG8_MMA(0, 0, At, B0); PG8_MMA(0, 1, At, B1); PG8_BAR; PG8_SCHED;
            PG8_LDA(At, 1, 1); PG8_STAGE(PG8_SB(1, 0), b3, voffB); PG8_STAGE(PG8_SB(1, 1), b3 + hstep, voffB); PG8_STAGE(PG8_SA(1, 0), a3, voffA);
            PG8_WAIT_V(8); PG8_WAIT_L(0); PG8_BAR; PG8_MMA(1, 0, At, B0); PG8_MMA(1, 1, At, B1); PG8_BAR; PG8_SCHED;
            } else {
            PG8_LDB(B0, 0, 0); PG8_SCHED; PG8_LDA(At, 0, 0); PG8_STAGE(PG8_SA(1, 1), a1 + hstep, voffA);
            PG8_WAIT_L(8); PG8_BAR; PG8_WAIT_L(0); PG8_MMA(0, 0, At, B0); PG8_BAR; PG8_SCHED;
            PG8_LDB(B1, 0, 1); PG8_STAGE(PG8_SB(0, 0), b2, voffB);
            PG8_BAR; PG8_WAIT_L(0); PG8_MMA(0, 1, At, B1); PG8_BAR;
            PG8_LDA(At, 0, 1); PG8_STAGE(PG8_SA(0, 0), a2, voffA);
            PG8_BAR; PG8_WAIT_L(0); PG8_MMA(1, 0, At, B0); PG8_BAR; PG8_SCHED;
            PG8_STAGE(PG8_SB(0, 1), b2 + hstep, voffB);
            PG8_WAIT_V(6); PG8_BAR; PG8_MMA(1, 1, At, B1); PG8_BAR;
            PG8_LDB(B0, 1, 0); PG8_SCHED; PG8_LDA(At, 1, 0); PG8_STAGE(PG8_SA(0, 1), a2 + hstep, voffA);
            PG8_WAIT_L(8); PG8_BAR; PG8_WAIT_L(0); PG8_MMA(0, 0, At, B0); PG8_BAR; PG8_SCHED;
            PG8_LDB(B1, 1, 1); PG8_STAGE(PG8_SB(1, 0), b3, voffB);
            PG8_BAR; PG8_WAIT_L(0); PG8_MMA(0, 1, At, B1); PG8_BAR;
            PG8_LDA(At, 1, 1); PG8_STAGE(PG8_SA(1, 0), a3, voffA);
            PG8_BAR; PG8_WAIT_L(0); PG8_MMA(1, 0, At, B0); PG8_BAR; PG8_SCHED;
            PG8_STAGE(PG8_SB(1, 1), b3 + hstep, voffB);
            PG8_WAIT_V(6); PG8_BAR; PG8_MMA(1, 1, At, B1); PG8_BAR;
            }
        }
        if constexpr (ALIGN_EPI) { if (wr == 0) PG8_BAR; }
        if constexpr (!Epi::AFTER_DRAIN) { E(acc, cur, wr, wc, fr, fq); S.done(cur); }
        if (!has_next) break;
#pragma unroll
        for (int a = 0; a < 2; ++a)
#pragma unroll
            for (int b = 0; b < 2; ++b)
#pragma unroll
                for (int m = 0; m < 4; ++m)
#pragma unroll
                    for (int n = 0; n < 2; ++n) acc[a][b][m][n] = (f32x4){0.f, 0.f, 0.f, 0.f};
        cur = nxt; cA = nA; cB = nB; ++ui;
        if constexpr (ALIGN_EPI) { if (wr == 1) PG8_BAR; }
    }
    PG8_WAIT_V(0);
    if constexpr (!ALIGN_EPI) { if (wr == 0) PG8_BAR; }
    PG8_BAR;
    if constexpr (Epi::AFTER_DRAIN) { E.fused(acc, cur, wr, wc, fr, fq, lds, wid, lane); S.done(cur); }
#undef PG8_SA
#undef PG8_SB
#undef PG8_STAGE
#undef PG8_LDA
#undef PG8_LDB
#undef PG8_MMA
#undef PG8_WAIT_V
#undef PG8_WAIT_L
#undef PG8_BAR
#undef PG8_SCHED
}
}
namespace att {
using bf16x8 = __attribute__((ext_vector_type(8))) short;
using s16x4  = __attribute__((ext_vector_type(4))) short;
using f32x16 = __attribute__((ext_vector_type(16))) float;
using f32x4  = __attribute__((ext_vector_type(4))) float;
using u32x4  = __attribute__((ext_vector_type(4))) unsigned;
using u32x2  = __attribute__((ext_vector_type(2))) unsigned;
typedef unsigned short bf16_t;
constexpr int NW = 8, QBLK = 32, KVBLK = 64;
constexpr int KSLOT = 12288, VSLOT = 8192, OSTP = 68, NSLOT = 4;
constexpr int L_K = 0, L_V = NSLOT * KSLOT, L_WS = L_V + NSLOT * VSLOT, L_OST = L_WS + NW * 256, L_END = L_OST + NW * 32 * OSTP * 4;
constexpr float THR = 8.f;
#define SBAR() __builtin_amdgcn_sched_barrier(0)
__device__ __forceinline__ int crow(int r, int hi) { return (r & 3) + 8 * (r >> 2) + 4 * hi; }
__device__ __forceinline__ void glds16(const void* gbase, unsigned voff, unsigned lds_dst) { unsigned keep;
  asm volatile("s_mov_b32 %0, m0\n\ts_mov_b32 m0, %3\n\ts_nop 0\n\tglobal_load_lds_dwordx4 %1, %2\n\ts_mov_b32 m0, %0" : "=&s"(keep) : "v"(voff), "s"(gbase), "s"(lds_dst) : "memory"); }
#define WAIT_BAR(N) asm volatile("s_waitcnt vmcnt(" #N ") lgkmcnt(0)\n\ts_barrier" ::: "memory")
typedef float f32x2_t __attribute__((ext_vector_type(2))); typedef __bf16 bf16x2_t __attribute__((ext_vector_type(2)));
__device__ __forceinline__ unsigned cvtpk(float lo, float hi) { f32x2_t v = {lo, hi}; bf16x2_t b = __builtin_convertvector(v, bf16x2_t); return __builtin_bit_cast(unsigned, b); }

template <bool FIRST>
__device__ __forceinline__ bool rowmax_dec(f32x16& p0, f32x16& p1, float& mhat, f32x16& negm, float& alpha) {
  float pmax = p0[0];
#pragma unroll
  for (int r = 1; r < 16; ++r) pmax = fmaxf(pmax, p0[r]);
#pragma unroll
  for (int r = 0; r < 16; ++r) pmax = fmaxf(pmax, p1[r]);
  { auto rr = __builtin_amdgcn_permlane32_swap(__float_as_uint(pmax), __float_as_uint(pmax), false, false);
    pmax = fmaxf(__uint_as_float(rr[0]), __uint_as_float(rr[1])); }
  alpha = 1.f;
  if (FIRST || __builtin_expect(__any(pmax > THR), 0)) {
    const float dl = FIRST ? pmax : fmaxf(pmax, 0.f); mhat += dl;
#pragma unroll
    for (int r = 0; r < 16; ++r) { p0[r] -= dl; p1[r] -= dl; }
#pragma unroll
    for (int r = 0; r < 16; ++r) negm[r] = -mhat;
    alpha = __builtin_amdgcn_exp2f(-dl);
    return true;
  }
  return false;
}
__device__ __forceinline__ void finishSM(f32x16& p0, f32x16& p1, float alpha, float& l_reg, bf16x8& pa0, bf16x8& pa1, bf16x8& pa2, bf16x8& pa3) {
#pragma unroll
  for (int r = 0; r < 16; ++r) p0[r] = __builtin_amdgcn_exp2f(p0[r]);
#pragma unroll
  for (int r = 0; r < 16; ++r) p1[r] = __builtin_amdgcn_exp2f(p1[r]);
  float ps = 0;
#pragma unroll
  for (int r = 0; r < 16; ++r) ps += p0[r];
#pragma unroll
  for (int r = 0; r < 16; ++r) ps += p1[r];
  { auto rr = __builtin_amdgcn_permlane32_swap(__float_as_uint(ps), __float_as_uint(ps), false, false);
    ps = __uint_as_float(rr[0]) + __uint_as_float(rr[1]); }
  l_reg = l_reg * alpha + ps;
#define PK4(P, BASE, OUT) do { u32x4 w = {cvtpk(P[BASE + 0], P[BASE + 1]), cvtpk(P[BASE + 2], P[BASE + 3]), cvtpk(P[BASE + 4], P[BASE + 5]), cvtpk(P[BASE + 6], P[BASE + 7])}; OUT = *reinterpret_cast<bf16x8*>(&w); } while (0)
  PK4(p0, 0, pa0); PK4(p0, 8, pa1); PK4(p1, 0, pa2); PK4(p1, 8, pa3);
#undef PK4
}
template <int D0A, int D0B> __device__ __forceinline__ void kload(bf16x8* kf, const char* Ks, int r32, int hi) {
  const char* kb = Ks + hi * 1024 + r32 * 16;
#pragma unroll
  for (int d0 = D0A; d0 < D0B; ++d0) { kf[2 * d0] = *reinterpret_cast<const bf16x8*>(kb + d0 * 2048); kf[2 * d0 + 1] = *reinterpret_cast<const bf16x8*>(kb + d0 * 2048 + 512); }
}
constexpr int KPRE = 0;
__device__ __forceinline__ void qkt(f32x16& p0, f32x16& p1, const bf16x8* kf, const bf16x8* qr, const f32x16& negm) {
#pragma unroll
  for (int d0 = 0; d0 < 6; ++d0) {
    if (d0 == 0) { p0 = __builtin_amdgcn_mfma_f32_32x32x16_bf16(kf[0], qr[0], negm, 0, 0, 0); p1 = __builtin_amdgcn_mfma_f32_32x32x16_bf16(kf[1], qr[0], negm, 0, 0, 0); }
    else { p0 = __builtin_amdgcn_mfma_f32_32x32x16_bf16(kf[2 * d0], qr[d0], p0, 0, 0, 0); p1 = __builtin_amdgcn_mfma_f32_32x32x16_bf16(kf[2 * d0 + 1], qr[d0], p1, 0, 0, 0); } }
}
__device__ __forceinline__ int v_rd_base(int lane) { return ((lane & 3) << 3) | (((lane >> 2) & 3) << 6) | (((lane >> 4) & 1) << 5) | (((lane >> 5) & 1) << 8); }
constexpr int v_rd_off(int d0, int ks, int half) { return d0 * 512 + ks * 2048 + half * 1024; }
template <int OFF> __device__ __forceinline__ s16x4 tr_read(int vb) {
  s16x4 r; asm volatile("ds_read_b64_tr_b16 %0, %1 offset:%2" : "=&v"(r) : "v"(vb), "i"(OFF) : "memory"); return r;
}
template <int D0> __device__ __forceinline__ void pv_one(f32x16& od, int vb, bf16x8 pa0, bf16x8 pa1, bf16x8 pa2, bf16x8 pa3) {
  const s16x4 l0 = tr_read<v_rd_off(D0, 0, 0)>(vb), h0 = tr_read<v_rd_off(D0, 0, 1)>(vb), l1 = tr_read<v_rd_off(D0, 1, 0)>(vb), h1 = tr_read<v_rd_off(D0, 1, 1)>(vb);
  const s16x4 l2 = tr_read<v_rd_off(D0, 2, 0)>(vb), h2 = tr_read<v_rd_off(D0, 2, 1)>(vb), l3 = tr_read<v_rd_off(D0, 3, 0)>(vb), h3 = tr_read<v_rd_off(D0, 3, 1)>(vb);
  asm volatile("s_waitcnt lgkmcnt(0)" ::: "memory"); SBAR();
#define PK(L, H) (bf16x8){L[0], L[1], L[2], L[3], H[0], H[1], H[2], H[3]}
  od = __builtin_amdgcn_mfma_f32_32x32x16_bf16(pa0, PK(l0, h0), od, 0, 0, 0);
  od = __builtin_amdgcn_mfma_f32_32x32x16_bf16(pa1, PK(l1, h1), od, 0, 0, 0);
  od = __builtin_amdgcn_mfma_f32_32x32x16_bf16(pa2, PK(l2, h2), od, 0, 0, 0);
  od = __builtin_amdgcn_mfma_f32_32x32x16_bf16(pa3, PK(l3, h3), od, 0, 0, 0);
#undef PK
}
struct VFrag8 { s16x4 l0, h0, l1, h1, l2, h2, l3, h3; };
__device__ __forceinline__ void pv_read0(VFrag8& f, int vb) {
  f.l0 = tr_read<v_rd_off(0, 0, 0)>(vb); f.h0 = tr_read<v_rd_off(0, 0, 1)>(vb); f.l1 = tr_read<v_rd_off(0, 1, 0)>(vb); f.h1 = tr_read<v_rd_off(0, 1, 1)>(vb);
  f.l2 = tr_read<v_rd_off(0, 2, 0)>(vb); f.h2 = tr_read<v_rd_off(0, 2, 1)>(vb); f.l3 = tr_read<v_rd_off(0, 3, 0)>(vb); f.h3 = tr_read<v_rd_off(0, 3, 1)>(vb);
}
__device__ __forceinline__ void pv_mma0(f32x16& od, const VFrag8& f, bf16x8 pa0, bf16x8 pa1, bf16x8 pa2, bf16x8 pa3) {
  asm volatile("s_waitcnt lgkmcnt(0)" ::: "memory"); SBAR();
#define PK(L, H) (bf16x8){L[0], L[1], L[2], L[3], H[0], H[1], H[2], H[3]}
  od = __builtin_amdgcn_mfma_f32_32x32x16_bf16(pa0, PK(f.l0, f.h0), od, 0, 0, 0);
  od = __builtin_amdgcn_mfma_f32_32x32x16_bf16(pa1, PK(f.l1, f.h1), od, 0, 0, 0);
  od = __builtin_amdgcn_mfma_f32_32x32x16_bf16(pa2, PK(f.l2, f.h2), od, 0, 0, 0);
  od = __builtin_amdgcn_mfma_f32_32x32x16_bf16(pa3, PK(f.l3, f.h3), od, 0, 0, 0);
#undef PK
}
__device__ __forceinline__ void pv_all(f32x16* o, int vb, bf16x8 pa0, bf16x8 pa1, bf16x8 pa2, bf16x8 pa3) {
  pv_one<0>(o[0], vb, pa0, pa1, pa2, pa3); pv_one<1>(o[1], vb, pa0, pa1, pa2, pa3);
}

__device__ __forceinline__ void attn_unit(const bool SAMPLE, const bool DRY, const bool PRE, const bf16_t* __restrict__ Qb, const bf16_t* __restrict__ Kh, const bf16_t* __restrict__ Vh, const bf16_t* __restrict__ KRh,
                                          const bf16_t* KhN, const bf16_t* VhN, const bf16_t* KRhN, const bf16_t* QbN, const bool SAMPLE_N, bf16_t* G, int NT, int visb, char* lds) {
  int tid_ = threadIdx.x; asm volatile("" : "+v"(tid_));
  const int tid = tid_, wid = __builtin_amdgcn_readfirstlane(tid >> 6), lane = tid & 63, r32 = lane & 31, hi = lane >> 5;
  char* V_lds = lds + L_V; char* K_lds = lds + L_K;
  float* ws = (float*)(lds + L_WS) + wid * 64; float* li_l = ws; float* al_l = ws + 32;
  float* ost = (float*)(lds + L_OST) + wid * 32 * OSTP;
  const unsigned lds0 = (unsigned)(uintptr_t)lds;
  const int wq = SAMPLE ? (wid & 1) : wid, vis = SAMPLE ? visb : visb + (wid >> 1);
  const unsigned lo = (unsigned)(wid * 1024 + lane * 16), lor = (unsigned)(wid * 512 + (lane & 31) * 16);
  const unsigned kdst = lds0 + L_K + wid * 1024, rdst = lds0 + L_K + 8 * 1024 + wid * 512, vdst = lds0 + L_V + wid * 1024;
#define DMA_K(t, slot) do { const unsigned t_ = (unsigned)(t); glds16((const char*)Kh + (size_t)t_ * 8192u, lo, (unsigned)__builtin_amdgcn_readfirstlane(kdst + (slot))); \
    if (lane < 32) glds16((const char*)KRh + (size_t)t_ * 4096u, lor, (unsigned)__builtin_amdgcn_readfirstlane(rdst + (slot))); } while (0)
#define DMA_V(t, slot) glds16((const char*)Vh + (size_t)(unsigned)(t) * 8192u, lo, (unsigned)__builtin_amdgcn_readfirstlane(vdst + (slot) / 3 * 2))
#define SLOTK(t) ((((unsigned)(t)) & (NSLOT - 1)) * KSLOT)
#define ISSUE_PAIR(j_, FULL) do { if ((FULL) || (j_) + 2 < NT) DMA_K((j_) + 2, SLOTK((j_) + 2)); if ((FULL) || (j_) + 3 < NT) DMA_K((j_) + 3, SLOTK((j_) + 3)); \
    if ((FULL) || (j_) + 1 < NT) DMA_V((j_) + 1, SLOTK((j_) + 1)); if ((FULL) || (j_) + 2 < NT) DMA_V((j_) + 2, SLOTK((j_) + 2)); } while (0)
  if (!PRE) { DMA_K(0, 0); DMA_V(0, 0); DMA_K(1, KSLOT); DMA_K(2, 2 * KSLOT); }
  if (SAMPLE && wid >= 2) {
    asm volatile("s_waitcnt vmcnt(0)" ::: "memory"); WAIT_BAR(0);
    DMA_V(1, SLOTK(1)); WAIT_BAR(0);
    for (int j = 1; j + 1 < NT; j += 2) { ISSUE_PAIR(j, false); WAIT_BAR(0); }
    WAIT_BAR(0);
    if (KhN) { const unsigned t0_ = 0u; (void)t0_;
      glds16((const char*)KhN, lo, (unsigned)__builtin_amdgcn_readfirstlane(kdst)); if (lane < 32) glds16((const char*)KRhN, lor, (unsigned)__builtin_amdgcn_readfirstlane(rdst));
      glds16((const char*)VhN, lo, (unsigned)__builtin_amdgcn_readfirstlane(vdst));
      glds16((const char*)KhN + 8192, lo, (unsigned)__builtin_amdgcn_readfirstlane(kdst + KSLOT)); if (lane < 32) glds16((const char*)KRhN + 4096, lor, (unsigned)__builtin_amdgcn_readfirstlane(rdst + KSLOT));
      glds16((const char*)KhN + 16384, lo, (unsigned)__builtin_amdgcn_readfirstlane(kdst + 2 * KSLOT)); if (lane < 32) glds16((const char*)KRhN + 8192, lor, (unsigned)__builtin_amdgcn_readfirstlane(rdst + 2 * KSLOT)); }
    asm volatile("s_waitcnt lgkmcnt(0)\n\ts_barrier" ::: "memory");
    return;
  }
  float mhat = 0.f, l_reg = 0; f32x16 o[2] = {}; f32x16 negm = {}; bf16x8 kf[12], qr[6];
  { const unsigned qof = (unsigned)((wq * QBLK + r32) * DQK + hi * 8);
#pragma unroll
    for (int d0 = 0; d0 < 6; ++d0) qr[d0] = *reinterpret_cast<const bf16x8*>(Qb + (qof + d0 * 16)); }
  const int vb0 = (int)(uintptr_t)V_lds + v_rd_base(lane);
#define RESC(a) do { if (hi == 0) al_l[r32] = (a); asm volatile("s_waitcnt lgkmcnt(0)" ::: "memory"); \
    _Pragma("unroll") for (int d = 0; d < 2; ++d) _Pragma("unroll") for (int r = 0; r < 16; ++r) o[d][r] *= al_l[crow(r, hi)]; } while (0)
#define MASK(P0, P1, t) do { if ((t) > vis) { _Pragma("unroll") for (int r = 0; r < 16; ++r) { P0[r] = -INFINITY; P1[r] = -INFINITY; } } } while (0)
  f32x16 pA0, pA1, pB0, pB1; float alA, alB; bf16x8 pa0, pa1, pa2, pa3;
#define VOFF(s) ((s) / 3 * 2)
  asm volatile("s_waitcnt vmcnt(0)" ::: "memory");
  WAIT_BAR(0);
  kload<0, 6>(kf, K_lds, r32, hi);
  qkt(pA0, pA1, kf, qr, negm); rowmax_dec<true>(pA0, pA1, mhat, negm, alA); alA = 0.f;
  DMA_V(1, SLOTK(1));
  WAIT_BAR(0);
#define QK_SGB() do { __builtin_amdgcn_sched_group_barrier(0x100, 12, 0); __builtin_amdgcn_sched_group_barrier(0x400, 4, 0); __builtin_amdgcn_sched_group_barrier(0x002, 4, 0); _Pragma("unroll") for (int i_ = 0; i_ < 12; ++i_) { __builtin_amdgcn_sched_group_barrier(0x008, 1, 0); \
      __builtin_amdgcn_sched_group_barrier(0x400, 3, 0); __builtin_amdgcn_sched_group_barrier(0x002, 5, 0); } } while (0)
#define STEP(C0, C1, P0, P1, alC, alP, t, MSK, DMA_) do { \
    const bool vc_ = !(MSK) || (t) <= vis, vp_ = !(MSK) || (t) - 1 <= vis; \
    SBAR(); if (vc_) { kload<0, 6>(kf, K_lds + SLOTK(t), r32, hi); qkt(C0, C1, kf, qr, negm); } \
    if (vp_) finishSM(P0, P1, alP, l_reg, pa0, pa1, pa2, pa3); if (!(MSK)) QK_SGB(); SBAR(); \
    VFrag8 vf_; if (vp_) pv_read0(vf_, vb0 + VOFF(SLOTK((t) - 1))); SBAR(); \
    DMA_; SBAR(); \
    if (vp_) { pv_mma0(o[0], vf_, pa0, pa1, pa2, pa3); pv_one<1>(o[1], vb0 + VOFF(SLOTK((t) - 1)), pa0, pa1, pa2, pa3); } \
    if (vc_) { if (rowmax_dec<false>(C0, C1, mhat, negm, alC)) RESC(alC); } else alC = 1.f; } while (0)
  int j = 1; const int jm = visb < NT - 4 ? visb : NT - 4;
  for (; j + 1 <= jm; j += 2) { STEP(pB0, pB1, pA0, pA1, alB, alA, j, false, ISSUE_PAIR(j, true)); STEP(pA0, pA1, pB0, pB1, alA, alB, j + 1, false, (void)0); WAIT_BAR(0); }
  for (; j + 1 < NT; j += 2) { STEP(pB0, pB1, pA0, pA1, alB, alA, j, true, ISSUE_PAIR(j, false)); STEP(pA0, pA1, pB0, pB1, alA, alB, j + 1, true, (void)0); WAIT_BAR(0); }
  STEP(pB0, pB1, pA0, pA1, alB, alA, NT - 1, true, (void)0); WAIT_BAR(0);
  const unsigned sl_prev = SLOTK(NT - 1);
  if (KhN) {
#define DMA_KN(t, slot) do { const unsigned t_ = (unsigned)(t); glds16((const char*)KhN + (size_t)t_ * 8192u, lo, (unsigned)__builtin_amdgcn_readfirstlane(kdst + (slot))); \
    if (lane < 32) glds16((const char*)KRhN + (size_t)t_ * 4096u, lor, (unsigned)__builtin_amdgcn_readfirstlane(rdst + (slot))); } while (0)
    DMA_KN(0, 0); glds16((const char*)VhN, lo, (unsigned)__builtin_amdgcn_readfirstlane(vdst)); DMA_KN(1, KSLOT); DMA_KN(2, 2 * KSLOT);
#undef DMA_KN
  }
  u32x4 zz[4];
  if ((!SAMPLE || wid < 2) && !DRY) {
#pragma unroll
    for (int i = 0; i < 4; ++i) zz[i] = __builtin_nontemporal_load((const u32x4*)(G + (unsigned)((wq * QBLK + i * 8 + (lane >> 3)) * DM + (lane & 7) * 8))); }
  if (NT - 1 <= vis) { finishSM(pB0, pB1, alB, l_reg, pa0, pa1, pa2, pa3); SBAR();
    pv_all(o, vb0 + VOFF(sl_prev), pa0, pa1, pa2, pa3); }
  if (hi == 0) li_l[r32] = l_reg; asm volatile("s_waitcnt lgkmcnt(0)" ::: "memory");
#pragma unroll
  for (int r = 0; r < 16; ++r) { const int orow = crow(r, hi); const float rl = __builtin_amdgcn_rcpf(li_l[orow]);
    ost[orow * OSTP + r32] = o[0][r] * rl; ost[orow * OSTP + 32 + r32] = o[1][r] * rl; }
  asm volatile("s_waitcnt lgkmcnt(0)" ::: "memory");
  if ((!SAMPLE || wid < 2) && !DRY) {
#pragma unroll
    for (int i = 0; i < 4; ++i) { const int row = i * 8 + (lane >> 3), ch = lane & 7;
      const f32x4 a = *(const f32x4*)(ost + row * OSTP + ch * 8), b = *(const f32x4*)(ost + row * OSTP + ch * 8 + 4);
      bf16_t* gp = G + (unsigned)((wq * QBLK + row) * DM + ch * 8); const u32x4 z_ = zz[i]; u32x4 w;
      w.x = cvtpk(a[0] * __uint_as_float(z_.x << 16), a[1] * __uint_as_float(z_.x & 0xffff0000u));
      w.y = cvtpk(a[2] * __uint_as_float(z_.y << 16), a[3] * __uint_as_float(z_.y & 0xffff0000u));
      w.z = cvtpk(b[0] * __uint_as_float(z_.z << 16), b[1] * __uint_as_float(z_.z & 0xffff0000u));
      w.w = cvtpk(b[2] * __uint_as_float(z_.w << 16), b[3] * __uint_as_float(z_.w & 0xffff0000u));
      *(u32x4*)gp = w; }
  }
  asm volatile("s_waitcnt lgkmcnt(0)\n\ts_barrier" ::: "memory");
#undef DMA_K
#undef DMA_V
#undef RESC
#undef MASK
#undef ROT
#undef VOFF
#undef SLOTK
#undef ISSUE_PAIR
#undef ENDW
#undef QK_SGB
#undef STEP
}
#undef WAIT_BAR
#undef SBAR
}

constexpr int NWAVES = 8;
constexpr int RING_OFF = 0, RING_BYTES = 153600;
constexpr int LDSCTL_OFF = RING_BYTES, MISC_OFF = LDSCTL_OFF + 320;
constexpr int LDS_BYTES = 155648;
static_assert(att::L_END <= RING_BYTES && MISC_OFF + 128 <= LDS_BYTES, "LDS map");

#define GAS __attribute__((address_space(1)))
#define LAS __attribute__((address_space(3)))
typedef unsigned short bf16;
typedef unsigned v4u __attribute__((ext_vector_type(4)));
typedef unsigned v2u __attribute__((ext_vector_type(2)));
typedef float f32x4 __attribute__((ext_vector_type(4)));
typedef GAS unsigned gu32;
#define RLX_AGENT __ATOMIC_RELAXED, __HIP_MEMORY_SCOPE_AGENT
#define LDS_WAIT() asm volatile("s_waitcnt lgkmcnt(0)" ::: "memory")
#define VM_WAIT() asm volatile("s_waitcnt vmcnt(0)" ::: "memory")
typedef float f32x2_ __attribute__((ext_vector_type(2))); typedef __bf16 bf16x2_ __attribute__((ext_vector_type(2)));
__device__ __forceinline__ unsigned pk2(float lo, float hi) { f32x2_ v = {lo, hi}; bf16x2_ b = __builtin_convertvector(v, bf16x2_); return __builtin_bit_cast(unsigned, b); }

#define XB_TMO      128
#define XB_XCNT(j)  (256  + 64 * (j))
#define XB_XSUB(j)  (1280 + 64 * (j))
#define XB_XGEN(j)  (2304 + 64 * (j))
#define XB_TOP      3328
#define XB_TOPGEN   3392
#define XCD_BAR_WORDS 3456
#define XB_SPIN_CAP (1u << 18)

__device__ __forceinline__ unsigned xb_ld(unsigned* p)              { return __hip_atomic_load(p, __ATOMIC_RELAXED, __HIP_MEMORY_SCOPE_AGENT); }
__device__ __forceinline__ unsigned xb_add(unsigned* p, unsigned v) { return __hip_atomic_fetch_add(p, v, __ATOMIC_RELAXED, __HIP_MEMORY_SCOPE_AGENT); }
__device__ __forceinline__ unsigned xb_xcc_id() { return (unsigned)__builtin_amdgcn_s_getreg((3 << 11) | 20) & 0xFu; }
#define XB_SPIN(cond, bar) do { unsigned _sp = 0; while (cond) { __builtin_amdgcn_s_sleep(1); \
    if ((++_sp & 255u) == 0u) { if (xb_ld(&(bar)[XB_TMO])) break; if (_sp > XB_SPIN_CAP) { atomicAdd(&(bar)[XB_TMO], 1u); break; } } } } while (0)

struct XcdBarrier {
    unsigned* bar; unsigned x;
    volatile LAS unsigned* st;
};

__device__ __forceinline__ XcdBarrier xcd_barrier_post(unsigned* bar, volatile LAS unsigned* st) {
    XcdBarrier b; b.bar = bar; b.x = xb_xcc_id(); b.st = st;
    if (threadIdx.x == 0) (void)xb_add(&bar[XB_XCNT(b.x)], 1u);
    return b;
}
__device__ __forceinline__ void xcd_barrier_complete(unsigned* bar, unsigned x, unsigned& nloc, unsigned& nx) {
    const unsigned G = gridDim.x * gridDim.y * gridDim.z;
    unsigned sum, cnt, mine, sp = 0u;
    for (;;) {
        sum = 0u; cnt = 0u; mine = 0u;
#pragma unroll
        for (unsigned j = 0; j < 16; ++j) { const unsigned c = xb_ld(&bar[XB_XCNT(j)]); sum += c; cnt += (c > 0u) ? 1u : 0u; mine = (j == x) ? c : mine; }
        if (sum == G) break;
        __builtin_amdgcn_s_sleep(1);
        if ((++sp & 255u) == 0u) { if (xb_ld(&bar[XB_TMO])) break; if (sp > XB_SPIN_CAP) { atomicAdd(&bar[XB_TMO], 1u); break; } }
    }
    nloc = mine > 0u ? mine : 1u; nx = cnt > 0u ? cnt : 1u;
}

__device__ __forceinline__ void xcd_barrier(const XcdBarrier& b) {
    asm volatile("s_waitcnt vmcnt(0)" ::: "memory");
    __syncthreads();
    if (threadIdx.x == 0) {
        unsigned* bar = b.bar;
        __builtin_amdgcn_s_waitcnt(0);
        unsigned nloc = b.st[0], nx = b.st[1];
        if (nloc == 0u) { xcd_barrier_complete(bar, b.x, nloc, nx); b.st[0] = nloc; b.st[1] = nx; }
        const unsigned round = b.st[2];
        const unsigned old = xb_add(&bar[XB_XSUB(b.x)], 1u);
        if (old + 1u == (round + 1u) * nloc) {
            __builtin_amdgcn_fence(__ATOMIC_RELEASE, "agent");
            asm volatile("s_waitcnt vmcnt(0)" ::: "memory");
            const unsigned og = xb_add(&bar[XB_TOP], 1u);
            if (og + 1u == (round + 1u) * nx) xb_add(&bar[XB_TOPGEN], 1u);
            else XB_SPIN(xb_ld(&bar[XB_TOPGEN]) == round, bar);
        } else {
            XB_SPIN(xb_ld(&bar[XB_TOPGEN]) == round, bar);
        }
        __builtin_amdgcn_fence(__ATOMIC_ACQUIRE, "agent");
        asm volatile("s_waitcnt vmcnt(0)" ::: "memory");
        b.st[2] = round + 1u;
    }
    __syncthreads();
}


struct Args { const float* in[16]; float* out; unsigned char* ws; int ph_lo, ph_hi, li, pad; };
struct Frame {
    LAS unsigned char* lds; volatile LAS unsigned* MISC; gu32* ctl;
    int tid, lane, wave, vcu, G;
};
__device__ __forceinline__ float wave_sum(float v) {
#pragma unroll
    for (int o = 1; o < 64; o <<= 1) v += __shfl_xor(v, o);
    return v;
}
__device__ __forceinline__ int p8map(int cl) { return (cl & ~31) | (((cl >> 2) & 3) << 3) | (((cl >> 4) & 1) << 2) | (cl & 3); }
__device__ __forceinline__ int wcol(int g, int j) {
    const int pn = j >> 8, cl = j & 255;
    if (g == 0) return ((cl >> 7) * 2 + ((cl >> 4) & 1)) * 1024 + pn * 64 + ((cl >> 5) & 3) * 16 + (cl & 15);
    if (g == 2) { if (pn == 0) return p8map(cl); if (pn == 1) return cl < 160 ? 256 + cl : -1; return 416 + (pn - 2) * 256 + p8map(cl); }
    if (g == 3) { if (pn < 4) { const int L = pn * 256 + p8map(cl); return (L >> 6) * 96 + (L & 63); } const int L = (pn - 4) * 256 + cl; return (L >> 5) * 96 + 64 + (L & 31); }
    if (g == 4) { const int L = (pn & 3) * 256 + p8map(cl); return (L >> 6) * 128 + (pn >= 4 ? 64 : 0) + (L & 63); }
    return (j & ~255) | p8map(j & 255);
}
__device__ __forceinline__ void p0_wt_item(const float* W, int K, int Nsrc, const float* rscale, float cscale, int g, bf16* WT, LAS float* scr, int item, int nblk, int lane) {
    const int kb = item / nblk, nb = item % nblk, k0 = 64 * kb, j0 = 32 * nb;
    const int col = wcol(g, j0 + (lane & 31));
    float wv[32];
#pragma unroll
    for (int i = 0; i < 32; ++i) { const int kk = 2 * i + (lane >> 5); wv[i] = col >= 0 ? __builtin_nontemporal_load(W + (size_t)(k0 + kk) * Nsrc + col) : 0.f; }
#pragma unroll
    for (int i = 0; i < 32; ++i) { const int kk = 2 * i + (lane >> 5); float v = wv[i] * cscale; if (rscale) v *= rscale[k0 + kk];
        scr[kk * 33 + (lane & 31)] = v; }
    LDS_WAIT(); asm volatile("" ::: "memory");
    const int c = lane & 7;
#pragma unroll
    for (int jq = 0; jq < 4; ++jq) { const int n = (lane >> 3) + 8 * jq; const LAS float* s = scr + (8 * c) * 33 + n;
        v4u o; o.x = pk2(s[0 * 33], s[1 * 33]); o.y = pk2(s[2 * 33], s[3 * 33]); o.z = pk2(s[4 * 33], s[5 * 33]); o.w = pk2(s[6 * 33], s[7 * 33]);
        *(GAS v4u*)(WT + (size_t)(j0 + n) * K + k0 + 8 * c) = o; }
    LDS_WAIT(); asm volatile("" ::: "memory");
}
__device__ __forceinline__ void sincos_tab(float ang, float& s, float& c) {
    const double x = (double)ang, q = rint(x * 0.63661977236758134308), r = x - q * 1.57079632679489661923, r2 = r * r;
    const double sp = r * (1.0 + r2 * (-1.0 / 6 + r2 * (1.0 / 120 + r2 * (-1.0 / 5040 + r2 * (1.0 / 362880 - r2 * (1.0 / 39916800))))));
    const double cp = 1.0 + r2 * (-0.5 + r2 * (1.0 / 24 + r2 * (-1.0 / 720 + r2 * (1.0 / 40320 + r2 * (-1.0 / 3628800 + r2 * (1.0 / 479001600))))));
    const int k = ((int)q) & 3;
    s = (float)(k == 0 ? sp : k == 1 ? cp : k == 2 ? -sp : -cp); c = (float)(k == 0 ? cp : k == 1 ? -sp : k == 2 ? -cp : sp);
}
__device__ __forceinline__ void p0_prologue(Frame& F, const Args& a) {
    unsigned char* ws = a.ws;
    LAS float* scr = (LAS float*)(F.lds + RING_OFF + F.wave * 16384);
    const int gw = F.vcu * NWAVES + F.wave, NGW = F.G * NWAVES;
    constexpr int I0 = 16 * 128, I1 = 16 * 32, I2 = 16 * 48, I3 = 4 * 48, I4 = 2 * 64, I5 = 16 * 32, NITEMS = I0 + I1 + I2 + I3 + I4 + I5;
    for (int it = gw; it < NITEMS; it += NGW) {
        int r = it;
        if (r < I0) { p0_wt_item(a.in[7], 1024, 4096, a.in[5], 1.f, 0, (bf16*)(ws + WS_W1T), scr, r, 128, F.lane); continue; } r -= I0;
        if (r < I1) { p0_wt_item(a.in[9], 1024, 1024, nullptr, 1.f, 1, (bf16*)(ws + WS_W2T), scr, r, 32, F.lane); continue; } r -= I1;
        if (r < I2) { p0_wt_item(a.in[10], 1024, 1440, a.in[5] + 1024, 1.f, 2, (bf16*)(ws + WS_W3T), scr, r, 48, F.lane); continue; } r -= I2;
        if (r < I3) { p0_wt_item(a.in[12], 256, 1536, a.in[11], C2, 3, (bf16*)(ws + WS_W4T), scr, r, 48, F.lane); continue; } r -= I3;
        if (r < I4) { p0_wt_item(a.in[14], 128, 2048, nullptr, 1.f, 4, (bf16*)(ws + WS_W5T), scr, r, 64, F.lane); continue; } r -= I4;
        p0_wt_item(a.in[15], 1024, 1024, nullptr, 1.f, 5, (bf16*)(ws + WS_W6T), scr, r, 32, F.lane);
    }
    { bf16* xb = (bf16*)(ws + WS_A); float* rs0 = (float*)(ws + WS_RS0);
      for (int m = gw; m < MT; m += NGW) {
        const float* xrow = m < MP ? a.in[0] + (size_t)m * DM : a.in[1] + (size_t)(m - MP) * DM;
        const GAS f32x4* xr = (const GAS f32x4*)xrow + F.lane; f32x4 v[4]; float s = 0.f;
#pragma unroll
        for (int j = 0; j < 4; ++j) { v[j] = __builtin_nontemporal_load(xr + 64 * j); s += (v[j].x * v[j].x + v[j].y * v[j].y) + (v[j].z * v[j].z + v[j].w * v[j].w); }
        s = wave_sum(s);
        const float rms = sqrtf(s * (1.0f / DM) + EPS), rn = 1.0f / rms;
        if (F.lane == 0) rs0[m] = rms;
        GAS v2u* o8 = (GAS v2u*)(xb + (size_t)m * DM) + F.lane;
#pragma unroll
        for (int j = 0; j < 4; ++j) { v2u w; w.x = pk2(v[j].x * rn, v[j].y * rn); w.y = pk2(v[j].z * rn, v[j].w * rn); o8[64 * j] = w; }
      } }
    { const long gt = (long)F.vcu * (NWAVES * 64) + F.tid, NT_ = (long)F.G * NWAVES * 64;
      { unsigned* xs = (unsigned*)(ws + WS_SSQ2); for (long i = gt; i < 130 * 4 * 256; i += NT_) xs[i] = 0xFFFFFFFFu; }
      bf16* ckva = (bf16*)(ws + WS_CKVA) + (size_t)MP * KVL; const float* cc = a.in[3];
      bf16* krs = (bf16*)(ws + WS_KRS); const float* ck = a.in[4];
      constexpr long NCC = (long)SB * PAST * KVL / 8, NCK = (long)SB * PAST * DR / 8;
      bool first = true;
      for (long base = gt; base < NCC; base += 4 * NT_) {
          f32x4 cv[4][2], kv[2]; const bool dok = first && gt < NCK;
#pragma unroll
          for (int k = 0; k < 4; ++k) { const long i = base + k * NT_; if (i < NCC) { cv[k][0] = __builtin_nontemporal_load((const f32x4*)(cc + i * 8)); cv[k][1] = __builtin_nontemporal_load((const f32x4*)(cc + i * 8 + 4)); } }
          if (dok) { kv[0] = __builtin_nontemporal_load((const f32x4*)(ck + gt * 8)); kv[1] = __builtin_nontemporal_load((const f32x4*)(ck + gt * 8 + 4)); }
          if (first) { float* tab = (float*)(ws + WS_ROPE);
              for (long i = gt; i < 8192L * 16; i += NT_) { const int pos = (int)(i >> 4), k = (int)(i & 15);
                  const float inv = 1.0f / powf(10000.0f, (float)(2 * k) * (1.0f / 32.0f)); const float ang = (float)pos * inv; float s, c; sincos_tab(ang, s, c);
                  tab[pos * 32 + k] = c; tab[pos * 32 + 16 + k] = s; } }
#pragma unroll
          for (int k = 0; k < 4; ++k) { const long i = base + k * NT_; if (i < NCC) { const f32x4 x0 = cv[k][0], x1 = cv[k][1];
              v4u w; w.x = pk2(x0.x, x0.y); w.y = pk2(x0.z, x0.w); w.z = pk2(x1.x, x1.y); w.w = pk2(x1.z, x1.w); *(v4u*)(ckva + i * 8) = w; } }
          if (dok) { const long i = gt, row = i >> 2; const int c8 = (int)(i & 3); const long b = row >> 12, s = row & (PAST - 1); const f32x4 x0 = kv[0], x1 = kv[1];
              v4u w; w.x = pk2(x0.x, x0.y); w.y = pk2(x0.z, x0.w); w.z = pk2(x1.x, x1.y); w.w = pk2(x1.z, x1.w); *(v4u*)(krs + ((b * (SKVP / 64) + (s >> 6)) * 4 + c8) * 512 + (s & 63) * 8) = w; }
          first = false;
      }
      for (long i = gt + NT_; i < NCK; i += NT_) { const long row = i >> 2; const int c8 = (int)(i & 3); const long b = row >> 12, s = row & (PAST - 1);
          const f32x4 x0 = __builtin_nontemporal_load((const f32x4*)(ck + i * 8)), x1 = __builtin_nontemporal_load((const f32x4*)(ck + i * 8 + 4));
          v4u w; w.x = pk2(x0.x, x0.y); w.y = pk2(x0.z, x0.w); w.z = pk2(x1.x, x1.y); w.w = pk2(x1.z, x1.w); *(v4u*)(krs + ((b * (SKVP / 64) + (s >> 6)) * 4 + c8) * 512 + (s & 63) * 8) = w; }
      bf16* Ks = (bf16*)(ws + WS_K) + KP_ELEMS; bf16* Vs = (bf16*)(ws + WS_V) + KP_ELEMS; const v4u z4 = {0u, 0u, 0u, 0u};
      for (long i = gt; i < (long)SB * NH * 512; i += NT_) { const long bh = i >> 9, r = i & 511;
          *(v4u*)(Ks + (bh * (SKVP / 64) + 65) * 4096 + r * 8) = z4; *(v4u*)(Vs + (bh * (SKVP / 64) + 65) * 4096 + r * 8) = z4; }
      for (long i = gt; i < (long)SB * 256; i += NT_) { const long b = i >> 8, r = i & 255; *(v4u*)(krs + (b * (SKVP / 64) + 65) * 2048 + r * 8) = z4; }
    }
}
__device__ __forceinline__ void p2_fixup(Frame& F, const Args& a) {
    unsigned char* ws = a.ws;
    const float* whead = (const float*)(ws + WS_WHEAD); const float* pchead = (const float*)(ws + WS_PCHEAD); const float* utail = (const float*)(ws + WS_UTAIL);
    const float* cw = a.in[8]; const float* st = a.in[2]; bf16* g = (bf16*)(ws + WS_B);
    const long gt = (long)F.vcu * (NWAVES * 64) + F.tid, NT_ = (long)F.G * NWAVES * 64;
    for (long i = gt; i < (long)NCHUNK * 256; i += NT_) { const int c = (int)(i >> 8), ch = (int)(i & 255) * 4;
        f32x4 p1, p2;
        if (c < MP / 64) { if ((c & 127) == 0) { p1 = (f32x4){0.f, 0.f, 0.f, 0.f}; p2 = p1; } else { p1 = *(const f32x4*)(utail + (size_t)((c - 1) * 2 + 1) * DM + ch); p2 = *(const f32x4*)(utail + (size_t)((c - 1) * 2) * DM + ch); } }
        else { const int b = c - MP / 64; p1 = *(const f32x4*)(st + (size_t)(b * 2 + 1) * DM + ch); p2 = *(const f32x4*)(st + (size_t)(b * 2) * DM + ch); }
        const f32x4 cw0 = *(const f32x4*)(cw + ch), cw1 = *(const f32x4*)(cw + DM + ch);
        const f32x4 w0 = *(const f32x4*)(whead + (size_t)(c * 2) * DM + ch), w1 = *(const f32x4*)(whead + (size_t)(c * 2 + 1) * DM + ch);
        const f32x4 q0 = *(const f32x4*)(pchead + (size_t)(c * 2) * DM + ch), q1 = *(const f32x4*)(pchead + (size_t)(c * 2 + 1) * DM + ch);
        const f32x4 g0 = w0 * (q0 + cw1 * p1 + cw0 * p2), g1 = w1 * (q1 + cw0 * p1);
        v2u o0, o1; o0.x = pk2(g0.x, g0.y); o0.y = pk2(g0.z, g0.w); o1.x = pk2(g1.x, g1.y); o1.y = pk2(g1.z, g1.w);
        *(v2u*)(g + (size_t)(c * 64) * DM + ch) = o0; *(v2u*)(g + (size_t)(c * 64 + 1) * DM + ch) = o1;
    }
    for (long i = gt; i < (long)(NB + SB) * 2 * 256; i += NT_) { const int sidx = (int)(i >> 9), j = (int)(i >> 8) & 1, ch = (int)(i & 255) * 4;
        const int c = sidx < NB ? 128 * (sidx + 1) - 1 : MP / 64 + (sidx - NB);
        const f32x4 v = *(const f32x4*)(utail + (size_t)(c * 2 + j) * DM + ch);
        float* o = a.out + (sidx < NB ? O_CONVP + (size_t)(sidx * 2 + j) * DM : O_CONVS + (size_t)((sidx - NB) * 2 + j) * DM) + ch;
        *(f32x4*)o = v; }
}
__device__ __forceinline__ void p8_final(Frame& F, const Args& a) {
    const float* ssq2 = (const float*)(a.ws + WS_SSQ2); const float* gf = a.in[6]; const bf16* x2 = (const bf16*)(a.ws + WS_K);
    const int gw = F.vcu * NWAVES + F.wave, NGW = F.G * NWAVES;
    int ln = threadIdx.x; asm volatile("" : "+v"(ln)); ln &= 63;
    f32x4 gv[4];
#pragma unroll
    for (int j = 0; j < 2; ++j) { gv[2 * j] = *(const f32x4*)(gf + 512 * j + 8 * ln); gv[2 * j + 1] = *(const f32x4*)(gf + 512 * j + 8 * ln + 4); }
    for (int m = gw; m < MT; m += NGW) {
        const float rs = 1.0f / sqrtf(pg8::sum16(ssq2 + (size_t)m * 16) * (1.0f / DM) + EPS);
        const v4u x0 = __builtin_nontemporal_load((const v4u*)(x2 + (size_t)m * DM + 8 * ln)), x1 = __builtin_nontemporal_load((const v4u*)(x2 + (size_t)m * DM + 512 + 8 * ln));
        float* yr = a.out + (size_t)m * DM + 8 * ln;
        f32x4 v;
        v = (f32x4){__uint_as_float(x0.x << 16), __uint_as_float(x0.x & 0xffff0000u), __uint_as_float(x0.y << 16), __uint_as_float(x0.y & 0xffff0000u)}; *(f32x4*)yr = v * rs * gv[0];
        v = (f32x4){__uint_as_float(x0.z << 16), __uint_as_float(x0.z & 0xffff0000u), __uint_as_float(x0.w << 16), __uint_as_float(x0.w & 0xffff0000u)}; *(f32x4*)(yr + 4) = v * rs * gv[1];
        v = (f32x4){__uint_as_float(x1.x << 16), __uint_as_float(x1.x & 0xffff0000u), __uint_as_float(x1.y << 16), __uint_as_float(x1.y & 0xffff0000u)}; *(f32x4*)(yr + 512) = v * rs * gv[2];
        v = (f32x4){__uint_as_float(x1.z << 16), __uint_as_float(x1.z & 0xffff0000u), __uint_as_float(x1.w << 16), __uint_as_float(x1.w & 0xffff0000u)}; *(f32x4*)(yr + 516) = v * rs * gv[3];
    }
}
__device__ __forceinline__ void p6_attention(Frame& F, const Args& a, char* lds, const bool dry) {
    unsigned char* ws = a.ws;
    const bf16* Qp = (const bf16*)a.out; const bf16* Qs = Qp + QP_ELEMS; const bf16* Kp = (const bf16*)(ws + WS_K); const bf16* Ks = Kp + KP_ELEMS;
    const bf16* Vp = (const bf16*)(ws + WS_V); const bf16* Vs = Vp + KP_ELEMS; const bf16* krp = (const bf16*)(ws + WS_KRP); const bf16* krs = (const bf16*)(ws + WS_KRS);
    bf16* sz = (bf16*)(ws + WS_B);
    int nun, typeA = 0, grp = 0, s = 0; unsigned long long tab = 0;
    if (F.G == 256) { grp = F.vcu >> 3; const int j = F.vcu & 7; s = j & 3; typeA = j < 4; nun = typeA ? 9 : 8;
        tab = j == 0 ? 0x00720d41561eull : j == 1 ? 0x827a2dc35e3eull : j == 2 ? 0x08528c45465cull : j == 3 ? 0x8a5aacc74e7cull : j == 4 ? 0x04624f49769full : j == 5 ? 0x866a6fcb7ebfull : j == 6 ? 0x0c42ce4d66ddull : 0x8e4aeecf6efdull; }
    else nun = (64 * 32 + 128 - F.vcu + F.G - 1) / F.G;
#define UDESC(i, smp, idx, qb) do { \
        if (F.G == 256) { smp = typeA && (i) == 8; const unsigned e_ = (unsigned)(tab >> (6 * ((i) & 7))) & 63u; qb = (int)(e_ & 31u); idx = smp ? grp * 4 + s : 2 * grp + (int)(e_ >> 5); \
        } else { const int u_ = F.vcu + (i) * F.G; smp = u_ >= 2048; idx = smp ? u_ - 2048 : (u_ >> 5); qb = 31 - (u_ & 31); } } while (0)
#define UPTRS(smp, idx, K_, V_, R_) do { const int b__ = (idx) >> 4; K_ = smp ? Ks + (size_t)(idx) * SKVP * DN : Kp + (size_t)(idx) * SEQ * DN; V_ = smp ? Vs + (size_t)(idx) * SKVP * DV : Vp + (size_t)(idx) * SEQ * DV; \
        R_ = smp ? krs + (size_t)b__ * SKVP * DR : krp + (size_t)b__ * SEQ * DR; } while (0)
    for (int i = 0; i < nun; ++i) {
        bool smp; int idx, qb = 0; UDESC(i, smp, idx, qb);
        const int b_ = idx >> 4, h_ = idx & 15;
        const bf16* Qb = smp ? Qs + (size_t)idx * ST * DQK : Qp + ((size_t)idx * SEQ + 256 * qb) * DQK;
        const bf16 *Kh, *Vh, *KRh, *KhN = nullptr, *VhN = nullptr, *KRhN = nullptr, *QbN = nullptr; bool smpn = false; UPTRS(smp, idx, Kh, Vh, KRh);
        if (i + 1 < nun) { int idxn, qbn = 0; UDESC(i + 1, smpn, idxn, qbn); UPTRS(smpn, idxn, KhN, VhN, KRhN); QbN = smpn ? Qs + (size_t)idxn * ST * DQK : Qp + ((size_t)idxn * SEQ + 256 * qbn) * DQK; }
        bf16* Gp = sz + (smp ? ((size_t)MP + b_ * ST) * DM : ((size_t)b_ * SEQ + 256 * qb) * DM) + h_ * 64;
        att::attn_unit(smp, dry, i > 0, Qb, Kh, Vh, KRh, KhN, VhN, KRhN, QbN, smpn, Gp, smp ? 66 : 4 * qb + 4, smp ? 64 : 4 * qb, lds);
    }
#undef UDESC
#undef UPTRS
}

constexpr int PER_PHASE = 9;
constexpr int N_LAUNCHES = MK_N_LAUNCHES;
static_assert(N_LAUNCHES == 1 || N_LAUNCHES == PER_PHASE, "MK_N_LAUNCHES is 1 or 9");
constexpr int CW_BAR = 4096, CW_SPLIT = 8192;
#ifndef PROBE_DUP
#define PROBE_DUP 0
#endif
#define DUP(k) (((PROBE_DUP) >> (k)) & 1)

__global__ void __launch_bounds__(NWAVES * 64, 2) mk_fwd(Args args) {
    extern __shared__ __attribute__((aligned(16))) unsigned char lds[];
    Frame F;
    F.lds = (LAS unsigned char*)lds;
    F.MISC = (volatile LAS unsigned*)(F.lds + MISC_OFF);
    F.tid = threadIdx.x; F.lane = F.tid & 63; F.wave = __builtin_amdgcn_readfirstlane(F.tid >> 6);
    F.G = gridDim.x; { const int bx = blockIdx.x; F.vcu = (F.G % 8 == 0) ? (bx % 8) * (F.G / 8) + bx / 8 : bx; }
    unsigned char* ws = args.ws;
    F.ctl = (gu32*)(ws + WS_CTL);
    for (int u = F.tid; u < (LDS_BYTES - LDSCTL_OFF) / 4; u += NWAVES * 64) ((LAS unsigned*)(F.lds + LDSCTL_OFF))[u] = 0u;
    __syncthreads();
    XcdBarrier bar; bar.bar = (unsigned*)(F.ctl + CW_BAR); bar.x = 0; bar.st = nullptr;
    if (N_LAUNCHES == 1) bar = xcd_barrier_post((unsigned*)(F.ctl + CW_BAR), F.MISC + 8);
#define GRID_BAR() do { if (N_LAUNCHES == 1) xcd_barrier(bar); } while (0)
#define KV_CACHED(U0, N) do { pg8::Gemm g{(const pg8::bf16_t*)(ws + WS_CKVA), (const pg8::bf16_t*)(ws + WS_W5T), MKV, 2048, 128}; pg8::CachedOrder S{(U0), (N)}; \
        pg8::EpiKV E{(const float*)(ws + WS_SSQKV), (pg8::bf16_t*)(ws + WS_K), (pg8::bf16_t*)(ws + WS_V), args.out, 0}; \
        pg8::gemm_phase<pg8::EpiKV, pg8::CachedOrder, true, true>(F.lds + RING_OFF, g, S, E); } while (0)
    const bool tails = (F.G == 256);
    const bool split = tails && N_LAUNCHES == 1;
#define SPLIT_TAIL(EPI, E_, A_, B_, N_, PM_, PN_, TU_, SL_, SCR_, K_) do { \
        pg8::Gemm gs{(const pg8::bf16_t*)(A_) + (SL_) * 128, (const pg8::bf16_t*)(B_) + (SL_) * 128, MT, (N_), 1024, 2}; pg8::OneUnit O1{(PM_), (PN_), 1}; \
        pg8::EpiSplit<EPI> ES{E_, (float*)(SCR_), (unsigned*)(F.ctl + CW_SPLIT + 256 * (K_)), (TU_), (SL_)}; \
        pg8::gemm_phase<pg8::EpiSplit<EPI>, pg8::OneUnit, true, true>(F.lds + RING_OFF, gs, O1, ES); } while (0)
    const int lo = args.ph_lo, hi = args.ph_hi;
#define IN(k) (lo <= (k) && (k) < hi)
#define BOTH(k) (IN(k) && IN((k) + 1))
    const int bx = (int)blockIdx.x;

    if (IN(0)) { for (int rep = 0; rep <= DUP(0); ++rep) { p0_prologue(F, args); if (BOTH(0)) GRID_BAR(); } }
    if (IN(1)) for (int rep = 0; rep <= DUP(1); ++rep) {
        pg8::Gemm g{(const pg8::bf16_t*)(ws + WS_A), (const pg8::bf16_t*)(ws + WS_W1T), MT, 4096, 1024}; pg8::StaticOrder S; S.init(MT, 4096, F.G, bx);
        { LAS f32x4* cwl = (LAS f32x4*)(F.lds + RING_OFF + pg8::STAGE_BYTES); const f32x4* cwg = (const f32x4*)args.in[8];
          for (int i = F.tid; i < 3 * DM / 4; i += NWAVES * 64) cwl[i] = cwg[i]; __syncthreads(); }
        pg8::EpiConvIn E{(PG8_LAS const float*)(F.lds + RING_OFF + pg8::STAGE_BYTES), (pg8::bf16_t*)(ws + WS_B), (float*)(ws + WS_WHEAD), (float*)(ws + WS_PCHEAD), (float*)(ws + WS_UTAIL)};
        pg8::gemm_phase<pg8::EpiConvIn, pg8::StaticOrder, true, true>(F.lds + RING_OFF, g, S, E);
        if (tails && rep == 0 && bx >= 32) { if (!split) KV_CACHED(bx - 32, 1); else if (bx < 128) KV_CACHED(2 * (bx - 32), 2); else KV_CACHED(192 + (bx - 128), 1); }
        if (BOTH(1)) GRID_BAR();
    }
    if (IN(2)) { for (int rep = 0; rep <= DUP(2); ++rep) { p2_fixup(F, args); if (BOTH(2)) GRID_BAR(); } }
    if (IN(3)) for (int rep = 0; rep <= DUP(3); ++rep) {
        pg8::Gemm g{(const pg8::bf16_t*)(ws + WS_B), (const pg8::bf16_t*)(ws + WS_W2T), MT, 1024, 1024}; pg8::StaticOrder S; S.init(MT, 1024, F.G, bx);
        pg8::EpiResid E{(const pg8::bf16_t*)(ws + WS_A), (pg8::bf16_t*)(ws + WS_A), (float*)(ws + WS_SSQ1), (const float*)(ws + WS_RS0)};
        if (split) S.lim = 512;
        pg8::gemm_phase<pg8::EpiResid, pg8::StaticOrder, true, true>(F.lds + RING_OFF, g, S, E);
        if (split) { if (bx < 64) { pg8::Unit tv; S.unit_of(512 + (bx >> 3), tv); SPLIT_TAIL(pg8::EpiResid, E, ws + WS_B, ws + WS_W2T, 1024, tv.pm, tv.pn, bx >> 3, bx & 7, args.out, 0); }
                     else if (rep == 0) KV_CACHED(320 + 2 * (bx - 64), 2); }
        else if (tails && rep == 0 && bx >= 8) KV_CACHED(224 + 2 * (bx - 8), 2);
        if (BOTH(3)) GRID_BAR();
    }
    if (IN(4)) for (int rep = 0; rep <= DUP(4); ++rep) {
        pg8::Gemm g{(const pg8::bf16_t*)(ws + WS_A), (const pg8::bf16_t*)(ws + WS_W3T), MT, 1536, 1024}; pg8::StaticOrder S; S.init(MT, 1536, F.G, bx);
        pg8::EpiMlaIn E{(const float*)(ws + WS_SSQ1), args.in[13], (const float*)(ws + WS_ROPE), (pg8::bf16_t*)(ws + WS_QLAT), (pg8::bf16_t*)(ws + WS_CKVA), (pg8::bf16_t*)(ws + WS_KRP),
                        (pg8::bf16_t*)(ws + WS_KRS), (pg8::bf16_t*)(ws + WS_B), args.out, (float*)(ws + WS_SSQKV), (PG8_LAS float*)(F.lds + RING_OFF + pg8::STAGE_BYTES)};
        if (split) S.lim = 768;
        pg8::gemm_phase<pg8::EpiMlaIn, pg8::StaticOrder, true, true>(F.lds + RING_OFF, g, S, E);
        if (split) { if (bx < 96) { pg8::Unit tv; S.unit_of(768 + (bx >> 3), tv); SPLIT_TAIL(pg8::EpiMlaIn, E, ws + WS_A, ws + WS_W3T, 1536, tv.pm, tv.pn, bx >> 3, bx & 7, args.out + (size_t)4 * 1024 * 1024, 1); }
                     else if (rep == 0) KV_CACHED(704 + 2 * (bx - 96), 2); }
        else if (tails && rep == 0 && bx >= 12) { if (bx < 72) KV_CACHED(720 + 2 * (bx - 12), 2); else KV_CACHED(840 + (bx - 72), 1); }
        if (BOTH(4)) GRID_BAR();
    }
#define P5A() { pg8::Gemm g{(const pg8::bf16_t*)(ws + WS_QLAT), (const pg8::bf16_t*)(ws + WS_W4T), MT, 1536, 256}; pg8::StaticOrder S; S.init(MT, 1536, F.G, bx); \
          pg8::EpiQ E{(const float*)(ws + WS_SSQQ), (const float*)(ws + WS_ROPE), (pg8::bf16_t*)args.out, (pg8::bf16_t*)args.out + QP_ELEMS}; \
          pg8::gemm_phase<pg8::EpiQ, pg8::StaticOrder, true, true>(F.lds + RING_OFF, g, S, E); }
#define P5B(FIX) { pg8::Gemm g{(const pg8::bf16_t*)(ws + WS_CKVA), (const pg8::bf16_t*)(ws + WS_W5T), MKV, 2048, 128}; \
          pg8::EpiKV E{(const float*)(ws + WS_SSQKV), (pg8::bf16_t*)(ws + WS_K), (pg8::bf16_t*)(ws + WS_V), args.out, FIX}; \
          if (tails) { pg8::KvOrder S; S.init(130 * 256, 2048, F.G, bx); pg8::gemm_phase<pg8::EpiKV, pg8::KvOrder, true, true>(F.lds + RING_OFF, g, S, E); } \
          else { pg8::StaticOrder S; S.init(MKV, 2048, F.G, bx); pg8::gemm_phase<pg8::EpiKV, pg8::StaticOrder, true, true>(F.lds + RING_OFF, g, S, E); } }
    if (IN(5)) {
#if (PROBE_DUP) & 32
        P5A(); GRID_BAR();
#endif
#if (PROBE_DUP) & 512
        P5B(0); GRID_BAR();
#endif
        P5A(); P5B(0);
        if (BOTH(5)) GRID_BAR();
    }
    if (IN(6)) { for (int rep = 0; rep <= DUP(6); ++rep) { p6_attention(F, args, (char*)lds + RING_OFF, rep < DUP(6)); if (BOTH(6)) GRID_BAR(); } }
    const bool fuse78 = tails && N_LAUNCHES == 1 && IN(7) && IN(8);
    if (fuse78) {
        pg8::Gemm g{(const pg8::bf16_t*)(ws + WS_B), (const pg8::bf16_t*)(ws + WS_W6T), MT, 1024, 1024}; pg8::PanelOrder S{bx, split ? 128 : 130};
        pg8::EpiResidNorm E{(const pg8::bf16_t*)(ws + WS_A), args.out, args.in[6], (float*)(ws + WS_SSQ2), (PG8_LAS float*)(F.lds + RING_OFF + pg8::STAGE_BYTES)};
        pg8::gemm_phase<pg8::EpiResidNorm, pg8::PanelOrder, true, true>(F.lds + RING_OFF, g, S, E);
        if (split && bx < 64) SPLIT_TAIL(pg8::EpiResidNorm, E, ws + WS_B, ws + WS_W6T, 1024, 128 + (bx >> 5), (bx >> 3) & 3, bx >> 3, bx & 7, ws + WS_K, 2);
    }
    if (IN(7) && !fuse78) for (int rep = 0; rep <= DUP(7); ++rep) {
        pg8::Gemm g{(const pg8::bf16_t*)(ws + WS_B), (const pg8::bf16_t*)(ws + WS_W6T), MT, 1024, 1024}; pg8::StaticOrder S; S.init(MT, 1024, F.G, bx);
        pg8::EpiResid E{(const pg8::bf16_t*)(ws + WS_A), (pg8::bf16_t*)(ws + WS_K), (float*)(ws + WS_SSQ2), nullptr};
        pg8::gemm_phase<pg8::EpiResid, pg8::StaticOrder, true, true>(F.lds + RING_OFF, g, S, E);
        if (BOTH(7)) GRID_BAR();
    }
    if (IN(8) && !fuse78) { p8_final(F, args); }
#undef IN
#undef BOTH
#undef GRID_BAR
}

extern "C" void kernel_launch(void* const* d_in, const int* in_sizes, int n_in, void* d_out, int out_size, void* d_ws, size_t ws_size, hipStream_t stream) {
    static int grid = 0;
    if (grid == 0) {
        if (n_in != 16 || in_sizes[0] != MP * DM || in_sizes[1] != MS * DM || (size_t)out_size != O_END || ws_size < WS_END) {
            fprintf(stderr, "kernel_launch: shape mismatch: n_in %d in0 %d in1 %d out %d ws %zu (need >= %zu)\n", n_in, n_in > 0 ? in_sizes[0] : -1, n_in > 1 ? in_sizes[1] : -1, out_size, ws_size, (size_t)WS_END); grid = -1; return; }
        int dev = 0, cus = 0, per_cu = 0;
        if (hipGetDevice(&dev) != hipSuccess || hipDeviceGetAttribute(&cus, hipDeviceAttributeMultiprocessorCount, dev) != hipSuccess) { fprintf(stderr, "kernel_launch: device query failed\n"); grid = -1; return; }
        if (hipFuncSetAttribute((const void*)mk_fwd, hipFuncAttributeMaxDynamicSharedMemorySize, LDS_BYTES) != hipSuccess) { fprintf(stderr, "kernel_launch: hipFuncSetAttribute failed\n"); grid = -1; return; }
        if (hipOccupancyMaxActiveBlocksPerMultiprocessor(&per_cu, (const void*)mk_fwd, NWAVES * 64, LDS_BYTES) != hipSuccess || per_cu < 1) { fprintf(stderr, "kernel_launch: occupancy query says %d blocks per CU\n", per_cu); per_cu = 1; }
        (void)hipGetLastError();
        grid = cus;
        fprintf(stderr, "kernel_launch: grid %d (occupancy %d per CU)\n", grid, per_cu);
    }
    if (grid < 0) return;
    if (hipMemsetAsync((char*)d_ws + WS_CTL, 0, CTL_ZERO_BYTES, stream) != hipSuccess) { fprintf(stderr, "kernel_launch: memset failed\n"); return; }
    Args a{};
    for (int i = 0; i < 16; ++i) a.in[i] = (const float*)d_in[i];
    a.out = (float*)d_out; a.ws = (unsigned char*)d_ws;
    if (N_LAUNCHES == 1) {
        a.ph_lo = 0; a.ph_hi = PER_PHASE; a.li = 0;
        void* kargs[] = {&a};
        const hipError_t le = hipLaunchCooperativeKernel((const void*)mk_fwd, dim3(grid), dim3(NWAVES * 64), kargs, LDS_BYTES, stream);
        if (le != hipSuccess) fprintf(stderr, "kernel_launch: cooperative launch failed: %s (grid %d)\n", hipGetErrorName(le), grid);
    } else {
        for (int li = 0; li < PER_PHASE; ++li) {
            a.ph_lo = li; a.ph_hi = li + 1; a.li = li;
            hipLaunchKernelGGL(mk_fwd, dim3(grid), dim3(NWAVES * 64), LDS_BYTES, stream, a);
            const hipError_t le = hipPeekAtLastError();
            if (le != hipSuccess) { fprintf(stderr, "kernel_launch: launch %d failed: %s\n", li, hipGetErrorName(le)); break; }
        }
    }
}
```

```cpp
#include <hip/hip_runtime.h>
#include <hip/hip_bf16.h>
#include <cstdio>
#include <cstdint>
#include <cmath>

#ifndef MK_N_LAUNCHES
#define MK_N_LAUNCHES 1
#endif

constexpr int DM = 1024, SEQ = 8192, NB = 4, MP = NB * SEQ, SB = 8, ST = 64, MS = SB * ST, MT = MP + MS;
constexpr int PAST = 4096, SKV = PAST + ST, SKVP = 4224;
constexpr int NH = 16, DN = 64, DR = 32, DQK = 96, DV = 64, QL = 256, KVL = 128;
constexpr int MKV = MP + SB * PAST + MS;
constexpr int NCHUNK = MT / 64;
constexpr float EPS = 1e-6f;
constexpr float LOG2E = 1.4426950408889634f;
constexpr float C2 = 0.10206207261596577f * 1.4426950408889634f;
constexpr size_t O_YP = 0, O_YS = (size_t)MP * DM, O_CONVP = O_YS + (size_t)MS * DM, O_CKVP = O_CONVP + NB * 2 * DM, O_KRP = O_CKVP + (size_t)MP * KVL,
                 O_CONVS = O_KRP + (size_t)MP * DR, O_CKVS = O_CONVS + SB * 2 * DM, O_KRS = O_CKVS + (size_t)MS * KVL, O_END = O_KRS + (size_t)MS * DR;
static_assert(O_END == 39428096, "output size");

constexpr size_t MiB = 1u << 20;
constexpr size_t al256(size_t x) { return (x + 255) & ~(size_t)255; }
constexpr size_t WS_CTL = 0, CTL_ZERO_BYTES = 1 * MiB;
constexpr size_t WS_W1T = CTL_ZERO_BYTES;
constexpr size_t WS_W2T = WS_W1T + (size_t)4096 * 1024 * 2;
constexpr size_t WS_W3T = WS_W2T + (size_t)1024 * 1024 * 2;
constexpr size_t WS_W4T = WS_W3T + (size_t)1536 * 1024 * 2;
constexpr size_t WS_W5T = WS_W4T + (size_t)1536 * 256 * 2;
constexpr size_t WS_W6T = WS_W5T + (size_t)2048 * 128 * 2;
constexpr size_t WS_ROPE = WS_W6T + (size_t)1024 * 1024 * 2;
constexpr size_t WS_RS0 = WS_ROPE + (size_t)8192 * 32 * 4;
constexpr size_t WS_SSQ1 = al256(WS_RS0 + (size_t)MT * 4);
constexpr size_t WS_SSQ2 = WS_SSQ1 + (size_t)MT * 16 * 4;
constexpr size_t WS_SSQQ = WS_SSQ2 + (size_t)MT * 16 * 4;
constexpr size_t WS_SSQKV = WS_SSQQ + (size_t)MT * 4 * 4;
constexpr size_t WS_WHEAD = WS_SSQKV + (size_t)MT * 4 * 4;
constexpr size_t WS_PCHEAD = WS_WHEAD + (size_t)NCHUNK * 2 * DM * 4;
constexpr size_t WS_UTAIL = WS_PCHEAD + (size_t)NCHUNK * 2 * DM * 4;
constexpr size_t WS_KRP = WS_UTAIL + (size_t)NCHUNK * 2 * DM * 4;
constexpr size_t WS_KRS = WS_KRP + (size_t)MP * DR * 2;
constexpr size_t WS_SMALL_END = WS_KRS + (size_t)SB * SKVP * DR * 2;
constexpr size_t WS_B = 40 * MiB;
constexpr size_t WS_A = WS_B + 65 * MiB;
constexpr size_t QP_ELEMS = (size_t)NB * NH * SEQ * DQK, QS_ELEMS = (size_t)SB * NH * ST * DQK;
static_assert((QP_ELEMS + QS_ELEMS) * 2 <= (size_t)MT * DM * 4, "Q fits in the y region of d_out");
constexpr size_t WS_QLAT = al256(WS_A + (QP_ELEMS + QS_ELEMS) * 2);
constexpr size_t WS_CKVA = WS_QLAT + (size_t)MT * QL * 2;
constexpr size_t KP_ELEMS = (size_t)NB * NH * SEQ * DN, KS_ELEMS = (size_t)SB * NH * SKVP * DN;
constexpr size_t WS_K = al256(WS_CKVA + (size_t)MKV * KVL * 2);
constexpr size_t WS_V = WS_K + (KP_ELEMS + KS_ELEMS) * 2;
constexpr size_t WS_END = WS_V + (KP_ELEMS + KS_ELEMS) * 2;
static_assert(WS_SMALL_END <= WS_B && (size_t)MT * DM * 2 <= 65 * MiB && WS_END <= 512 * MiB, "d_ws map");

namespace pg8 {
#define PG8_LAS __attribute__((address_space(3)))
typedef unsigned short bf16_t;
typedef short bf16x8 __attribute__((ext_vector_type(8)));
typedef float f32x4 __attribute__((ext_vector_type(4)));
typedef unsigned u32x4 __attribute__((ext_vector_type(4)));
constexpr int BM = 256, BK = 64, HALF = 128, HTB = HALF * BK * 2  , STAGE_BYTES = 8 * HTB, NXCD = 8, WGM = 8;

__host__ __device__ __forceinline__ int lds_byte(int r, int c) { const int st = (r >> 4) * 2 + (c >> 5), rr = r & 15, cc = c & 31, ob = rr * 64 + cc * 2; return st * 1024 + (ob ^ (((ob >> 9) & 1) << 5)); }
__host__ __device__ __forceinline__ void stage_rc(int b, int& R, int& C) { const int st = b / 1024, sb = b % 1024, swz = sb ^ (((sb >> 9) & 1) << 5); R = (st >> 1) * 16 + swz / 64; C = (st & 1) * 32 + (swz % 64) / 2; }
__host__ __device__ __forceinline__ int perm32(int rho) { const int n = rho >> 4, i = rho & 15; return 8 * (i >> 2) + 4 * n + (i & 3); }

struct Unit { int pm, pn; };
struct Gemm { const bf16_t* A; const bf16_t* Bt; int M, N, K; int kt = 0; };

struct StaticOrder {
    int nM, nN, nwg, G, c, lim;
    __host__ __device__ __forceinline__ void init(int M, int N, int G_, int c_) { nM = M / BM; nN = N / BM; nwg = nM * nN; G = G_; c = c_; lim = nwg; }
    __host__ __device__ __forceinline__ bool next(int i, Unit& u) const { const long L = (long)i * G + c; if (L >= lim) return false; unit_of((int)L, u); return true; }
    __host__ __device__ __forceinline__ bool unit_of(int L, Unit& u) const {
        int wgid = L; { const int q = nwg / NXCD, r = nwg % NXCD, xcd = wgid % NXCD, off = wgid / NXCD; wgid = (xcd < r ? xcd * (q + 1) : r * (q + 1) + (xcd - r) * q) + off; }
        const int nig = WGM * nN, gid = wgid / nig, fm = gid * WGM, gsz = (nM - fm) < WGM ? (nM - fm) : WGM;
        u.pm = fm + ((wgid % nig) % gsz); u.pn = (wgid % nig) / gsz; return true;
    }
    __device__ __forceinline__ void a_ready(const Unit&) const {}
    __device__ __forceinline__ void done(const Unit&) const {}
};
struct OneUnit {
    int pm, pn, valid;
    __host__ __device__ __forceinline__ bool next(int i, Unit& u) const { if (i > 0 || !valid) return false; u.pm = pm; u.pn = pn; return true; }
    __device__ __forceinline__ void a_ready(const Unit&) const {}
    __device__ __forceinline__ void done(const Unit&) const {}
};
struct CachedOrder {
    int u0, n;
    __host__ __device__ __forceinline__ bool next(int i, Unit& u) const { if (i >= n) return false; const int x = u0 + i; u.pm = 128 + (x >> 3); u.pn = x & 7; return true; }
    __device__ __forceinline__ void a_ready(const Unit&) const {}
    __device__ __forceinline__ void done(const Unit&) const {}
};
struct KvOrder : StaticOrder {
    __host__ __device__ __forceinline__ bool next(int i, Unit& u) const { if (!StaticOrder::next(i, u)) return false; if (u.pm >= 128) u.pm += 128; return true; }
};
struct PanelOrder {
    int c, np;
    __host__ __device__ __forceinline__ bool next(int i, Unit& u) const { const int x = c & 7, s = c >> 3, p = 64 * i + 8 * x + (s >> 2); if (p >= np) return false; u.pm = p; u.pn = s & 3; return true; }
    __device__ __forceinline__ void a_ready(const Unit&) const {}
    __device__ __forceinline__ void done(const Unit&) const {}
};
typedef float f32x2 __attribute__((ext_vector_type(2)));
typedef unsigned u32x2 __attribute__((ext_vector_type(2)));
typedef __bf16 bf16x2_t __attribute__((ext_vector_type(2)));
__device__ __forceinline__ unsigned cvt_pk_bf16(float lo, float hi) { f32x2 v = {lo, hi}; bf16x2_t b = __builtin_convertvector(v, bf16x2_t); return __builtin_bit_cast(unsigned, b); }
__device__ __forceinline__ u32x2 pack4(const f32x4 v) { u32x2 w; w.x = cvt_pk_bf16(v[0], v[1]); w.y = cvt_pk_bf16(v[2], v[3]); return w; }
__device__ __forceinline__ u32x4 pack8(const f32x4 a, const f32x4 b) { u32x4 w; w.x = cvt_pk_bf16(a[0], a[1]); w.y = cvt_pk_bf16(a[2], a[3]); w.z = cvt_pk_bf16(b[0], b[1]); w.w = cvt_pk_bf16(b[2], b[3]); return w; }
__device__ __forceinline__ float dot4(const f32x4 v) { return (v[0] * v[0] + v[1] * v[1]) + (v[2] * v[2] + v[3] * v[3]); }
__device__ __forceinline__ float silu1(float z) { return z * __builtin_amdgcn_rcpf(1.0f + __builtin_amdgcn_exp2f(-z * LOG2E)); }
__device__ __forceinline__ float sum16(const float* p) { const f32x4 a = *(const f32x4*)p, b = *(const f32x4*)(p + 4), c = *(const f32x4*)(p + 8), d = *(const f32x4*)(p + 12);
    return (((a[0] + a[1]) + (a[2] + a[3])) + ((b[0] + b[1]) + (b[2] + b[3]))) + (((c[0] + c[1]) + (c[2] + c[3])) + ((d[0] + d[1]) + (d[2] + d[3]))); }
__device__ __forceinline__ float sum4(const float* p) { const f32x4 a = *(const f32x4*)p; return (a[0] + a[1]) + (a[2] + a[3]); }

struct EpiConvIn {
    static constexpr bool PERM = false, AFTER_DRAIN = false;
    PG8_LAS const float* convw; bf16_t* g; float* whead; float* pchead; float* utail;
    __device__ __forceinline__ void operator()(const f32x4 (&acc)[2][2][4][2], const Unit& u, int wr, int wc, int fr, int fq) const {
        asm volatile("" : "+v"(fr), "+v"(fq));
        const int lane = fq * 16 + fr, ch0 = u.pn * 64 + wc * 16 + fq * 4;
        const f32x4 cw0 = *(PG8_LAS const f32x4*)(convw + ch0), cw1 = *(PG8_LAS const f32x4*)(convw + DM + ch0), cw2 = *(PG8_LAS const f32x4*)(convw + 2 * DM + ch0);
        (void)lane;
#pragma unroll
        for (int ai = 0; ai < 2; ++ai) {
            const int rowc = u.pm * BM + ai * HALF + wr * 64, chunk = rowc >> 6;
            f32x4 r1p = (f32x4){0.f, 0.f, 0.f, 0.f}, r2p = r1p;
#pragma unroll
            for (int m = 0; m < 4; ++m) {
                const int row = rowc + m * 16 + fr;
                const f32x4 bg = acc[ai][0][m][0], cg = acc[ai][0][m][1], xv = acc[ai][1][m][0], z = acc[ai][1][m][1];
                const f32x4 uu = cg * xv; f32x4 w, p1, p2;
                f32x4 r1, r2;
#pragma unroll
                for (int e = 0; e < 4; ++e) { w[e] = silu1(z[e]) * bg[e];
                    r1[e] = __int_as_float(__builtin_amdgcn_update_dpp(0, __float_as_int(uu[e]), 0x121, 0xf, 0xf, false));
                    r2[e] = __int_as_float(__builtin_amdgcn_update_dpp(0, __float_as_int(uu[e]), 0x122, 0xf, 0xf, false));
                    p1[e] = fr >= 1 ? r1[e] : r1p[e]; p2[e] = fr >= 2 ? r2[e] : r2p[e]; }
                const f32x4 conv = cw2 * uu + cw1 * p1 + cw0 * p2;
                if (m == 0 && fr < 2) { *(f32x4*)(whead + (size_t)(chunk * 2 + fr) * DM + ch0) = w; *(f32x4*)(pchead + (size_t)(chunk * 2 + fr) * DM + ch0) = conv; }
                else { *(u32x2*)(g + (size_t)row * DM + ch0) = pack4(w * conv); }
                if (m == 3 && fr >= 14) *(f32x4*)(utail + (size_t)(chunk * 2 + fr - 14) * DM + ch0) = uu;
                r1p = r1; r2p = r2;
            }
        }
    }
};

struct EpiResid {
    static constexpr bool PERM = false, AFTER_DRAIN = false;
    const bf16_t* xin; bf16_t* xo; float* ssq; const float* rinv;
    __device__ __forceinline__ void operator()(const f32x4 (&acc)[2][2][4][2], const Unit& u, int wr, int wc, int fr, int fq, int only = -1) const {
        asm volatile("" : "+v"(fr), "+v"(fq));
        const unsigned col0 = (unsigned)(u.pn * BM + wc * 32 + 8 * fq), off0 = (unsigned)(u.pm * BM + wr * 64 + fr) * DM + col0;
#pragma unroll
        for (int ai = 0; ai < 2; ++ai) {
            u32x4 xi[4][2]; float riv[4];
#pragma unroll
            for (int m = 0; m < 4; ++m) { if (only >= 0 && only != ai * 4 + m) continue;
                riv[m] = rinv ? rinv[u.pm * BM + ai * HALF + wr * 64 + m * 16 + fr] : 1.f;
#pragma unroll
                for (int bj = 0; bj < 2; ++bj) xi[m][bj] = __builtin_nontemporal_load((const u32x4*)(xin + (off0 + (unsigned)((ai * HALF + m * 16) * DM + bj * HALF)))); }
#pragma unroll
            for (int m = 0; m < 4; ++m) { if (only >= 0 && only != ai * 4 + m) continue; const unsigned row = (unsigned)(u.pm * BM + ai * HALF + wr * 64 + m * 16 + fr), off = off0 + (unsigned)((ai * HALF + m * 16) * DM); float ss = 0.f; const float ri = riv[m];
#pragma unroll
                for (int bj = 0; bj < 2; ++bj) { const u32x4 x = xi[m][bj]; f32x4 a = acc[ai][bj][m][0], b = acc[ai][bj][m][1];
                    a[0] = fmaf(__uint_as_float(x.x << 16), ri, a[0]); a[1] = fmaf(__uint_as_float(x.x & 0xffff0000u), ri, a[1]); a[2] = fmaf(__uint_as_float(x.y << 16), ri, a[2]); a[3] = fmaf(__uint_as_float(x.y & 0xffff0000u), ri, a[3]);
                    b[0] = fmaf(__uint_as_float(x.z << 16), ri, b[0]); b[1] = fmaf(__uint_as_float(x.z & 0xffff0000u), ri, b[1]); b[2] = fmaf(__uint_as_float(x.w << 16), ri, b[2]); b[3] = fmaf(__uint_as_float(x.w & 0xffff0000u), ri, b[3]);
                    ss += dot4(a) + dot4(b); *(u32x4*)(xo + (off + bj * HALF)) = pack8(a, b); }
                ss += __shfl_xor(ss, 16); ss += __shfl_xor(ss, 32);
                if (fq == 0) ssq[row * 16u + u.pn * 4 + wc] = ss; }
        }
    }
};

struct EpiResidNorm {
    static constexpr bool PERM = false, AFTER_DRAIN = false;
    const bf16_t* xin; float* y; const float* gf; float* xs; PG8_LAS float* sc;
    __device__ __forceinline__ void operator()(f32x4 (&acc)[2][2][4][2], const Unit& u, int wr, int wc, int fr, int fq, int only = -1) const {
        asm volatile("" : "+v"(fr), "+v"(fq));
        const unsigned col0 = (unsigned)(u.pn * BM + wc * 32 + 8 * fq);
#pragma unroll
        for (int ai = 0; ai < 2; ++ai)
#pragma unroll
            for (int m = 0; m < 4; ++m) { if (only >= 0 && only != ai * 4 + m) continue; const int rl = ai * HALF + wr * 64 + m * 16 + fr; const unsigned off = (unsigned)(u.pm * BM + rl) * DM + col0; float ss = 0.f;
#pragma unroll
                for (int bj = 0; bj < 2; ++bj) { const u32x4 xi = __builtin_nontemporal_load((const u32x4*)(xin + (off + bj * HALF))); f32x4 a = acc[ai][bj][m][0], b = acc[ai][bj][m][1];
                    a[0] += __uint_as_float(xi.x << 16); a[1] += __uint_as_float(xi.x & 0xffff0000u); a[2] += __uint_as_float(xi.y << 16); a[3] += __uint_as_float(xi.y & 0xffff0000u);
                    b[0] += __uint_as_float(xi.z << 16); b[1] += __uint_as_float(xi.z & 0xffff0000u); b[2] += __uint_as_float(xi.w << 16); b[3] += __uint_as_float(xi.w & 0xffff0000u);
                    ss += dot4(a) + dot4(b); acc[ai][bj][m][0] = a; acc[ai][bj][m][1] = b; }
                ss += __shfl_xor(ss, 16); ss += __shfl_xor(ss, 32);
                if (fq == 0) sc[rl * 4 + wc] = ss; }
        const int t = (wr * 4 + wc) * 64 + fq * 16 + fr;
        asm volatile("s_waitcnt lgkmcnt(0)" ::: "memory"); __builtin_amdgcn_s_barrier();
        if (t < 256 && (only < 0 || only == ((t >> 7) * 4 + ((t >> 4) & 3)))) { const f32x4 q4 = *(const PG8_LAS f32x4*)(sc + t * 4);   const float mine = (q4[0] + q4[1]) + (q4[2] + q4[3]);
            float* sl = xs + ((unsigned)(u.pm * 4) * 256u + t);
            __hip_atomic_store(sl + u.pn * 256, mine, __ATOMIC_RELAXED, __HIP_MEMORY_SCOPE_AGENT);
            float v[4]; unsigned sp = 0; bool ok;
            do { ok = true;
#pragma unroll
                for (int q = 0; q < 4; ++q) v[q] = __hip_atomic_load(sl + q * 256, __ATOMIC_RELAXED, __HIP_MEMORY_SCOPE_AGENT);
#pragma unroll
                for (int q = 0; q < 4; ++q) ok = ok && (q == u.pn || __float_as_uint(v[q]) != 0xFFFFFFFFu);
            } while (!ok && ++sp < (1u << 20));
#pragma unroll
            for (int q = 0; q < 4; ++q) v[q] = (q == u.pn) ? mine : v[q];
            sc[1024 + t] = 1.0f / sqrtf(((v[0] + v[1]) + (v[2] + v[3])) * (1.0f / DM) + EPS); }
        asm volatile("s_waitcnt lgkmcnt(0)" ::: "memory"); __builtin_amdgcn_s_barrier();
#pragma unroll
        for (int ai = 0; ai < 2; ++ai)
#pragma unroll
            for (int m = 0; m < 4; ++m) { if (only >= 0 && only != ai * 4 + m) continue; const int rl = ai * HALF + wr * 64 + m * 16 + fr; const float rs = sc[1024 + rl]; float* yr = y + ((unsigned)(u.pm * BM + rl) * DM + col0);
#pragma unroll
                for (int bj = 0; bj < 2; ++bj) { const f32x4 g0 = *(const f32x4*)(gf + col0 + bj * HALF), g1 = *(const f32x4*)(gf + col0 + bj * HALF + 4);
                    *(f32x4*)(yr + bj * HALF) = acc[ai][bj][m][0] * rs * g0; *(f32x4*)(yr + bj * HALF + 4) = acc[ai][bj][m][1] * rs * g1; } }
        asm volatile("s_waitcnt lgkmcnt(0)" ::: "memory"); __builtin_amdgcn_s_barrier();
    }
};

struct EpiMlaIn {
    static constexpr bool PERM = false, AFTER_DRAIN = false;
    const float* ssq1; const float* gkv; const float* rope; bf16_t* qlat; bf16_t* ckva; bf16_t* krp; bf16_t* krs; bf16_t* sz; float* out; float* ssqkv; PG8_LAS float* sc;
    __device__ __forceinline__ void operator()(const f32x4 (&acc)[2][2][4][2], const Unit& u, int wr, int wc, int fr, int fq, int only = -1) const {
        asm volatile("" : "+v"(fr), "+v"(fq));
        float rsv[2][4];
        { f32x4 q4[2][4];
#pragma unroll
          for (int ai = 0; ai < 2; ++ai)
#pragma unroll
            for (int m = 0; m < 4; ++m) q4[ai][m] = *(const f32x4*)(ssq1 + (size_t)(u.pm * BM + ai * HALF + wr * 64 + m * 16 + fr) * 16 + 4 * fq);
#pragma unroll
          for (int ai = 0; ai < 2; ++ai)
#pragma unroll
            for (int m = 0; m < 4; ++m) rsv[ai][m] = (q4[ai][m][0] + q4[ai][m][1]) + (q4[ai][m][2] + q4[ai][m][3]);
#pragma unroll
          for (int ai = 0; ai < 2; ++ai)
#pragma unroll
            for (int m = 0; m < 4; ++m) rsv[ai][m] += __shfl_xor(rsv[ai][m], 16);
#pragma unroll
          for (int ai = 0; ai < 2; ++ai)
#pragma unroll
            for (int m = 0; m < 4; ++m) { rsv[ai][m] += __shfl_xor(rsv[ai][m], 32); rsv[ai][m] = 1.0f / sqrtf(rsv[ai][m] * (1.0f / DM) + EPS); } }
        if (u.pn < 2) {
            const bool isq = u.pn == 0;
            const f32x4 gk0 = *(const f32x4*)(gkv + wc * 32 + 4 * fq), gk1 = *(const f32x4*)(gkv + wc * 32 + 16 + 4 * fq);
#pragma unroll
            for (int ai = 0; ai < 2; ++ai)
#pragma unroll
                for (int m = 0; m < 4; ++m) { if (only >= 0 && only != ai * 4 + m) continue; const int rl = ai * HALF + wr * 64 + m * 16 + fr; const float rs = rsv[ai][m];
                    const f32x4 a0 = acc[ai][0][m][0] * rs, a1 = acc[ai][0][m][1] * rs; float ss = dot4(a0) + dot4(a1);
                    if (isq) { const f32x4 b0 = acc[ai][1][m][0] * rs, b1 = acc[ai][1][m][1] * rs; ss += dot4(b0) + dot4(b1); }
                    ss += __shfl_xor(ss, 16); ss += __shfl_xor(ss, 32);
                    if (fq == 0) sc[rl * 4 + wc] = ss; }
            asm volatile("s_waitcnt lgkmcnt(0)" ::: "memory"); __builtin_amdgcn_s_barrier();
#pragma unroll
            for (int ai = 0; ai < 2; ++ai)
#pragma unroll
                for (int m = 0; m < 4; ++m) { if (only >= 0 && only != ai * 4 + m) continue; const int rl = ai * HALF + wr * 64 + m * 16 + fr, row = u.pm * BM + rl; const float rs = rsv[ai][m];
                    const f32x4 q = *(const PG8_LAS f32x4*)(sc + rl * 4); const float tot = (q[0] + q[1]) + (q[2] + q[3]);
                    if (isq) { const float f = rs / sqrtf(tot * (1.0f / QL) + EPS);
#pragma unroll
                        for (int bj = 0; bj < 2; ++bj) *(u32x4*)(qlat + (size_t)row * QL + bj * HALF + wc * 32 + 8 * fq) = pack8(acc[ai][bj][m][0] * f, acc[ai][bj][m][1] * f);
                    } else { const float r2 = 1.0f / sqrtf(tot * (1.0f / KVL) + EPS), f = rs * r2;
                        if (fq == 0) ssqkv[(size_t)row * 4 + wc] = q[wc] * (r2 * r2);
                        float* co = out + (row < MP ? O_CKVP + (size_t)row * KVL : O_CKVS + (size_t)(row - MP) * KVL); bf16_t* cb = ckva + (size_t)(row < MP ? row : row + SB * PAST) * KVL;
#pragma unroll
                        for (int n = 0; n < 2; ++n) { const int c = wc * 32 + n * 16 + 4 * fq; const f32x4 v = acc[ai][0][m][n] * f * (n == 0 ? gk0 : gk1); *(f32x4*)(co + c) = v; *(u32x2*)(cb + c) = pack4(v); }
                        if (wc == 0) {
                            const int pos = row < MP ? (row & (SEQ - 1)) : PAST + ((row - MP) & (ST - 1));
                            const f32x4 cs = *(const f32x4*)(rope + (size_t)pos * 32 + 4 * fq), sn = *(const f32x4*)(rope + (size_t)pos * 32 + 16 + 4 * fq);
                            const f32x4 x1 = acc[ai][1][m][0] * rs, x2 = acc[ai][1][m][1] * rs, o1 = x1 * cs - x2 * sn, o2 = x2 * cs + x1 * sn;
                            float* ko = out + (row < MP ? O_KRP + (size_t)row * DR : O_KRS + (size_t)(row - MP) * DR);
                            *(f32x4*)(ko + 4 * fq) = o1; *(f32x4*)(ko + 16 + 4 * fq) = o2;
                            bf16_t* kb = row < MP ? krp + (((unsigned)row >> 6) * 2048u + ((unsigned)row & 63) * 8u) : krs + ((((unsigned)(row - MP) >> 6) * (SKVP / 64) + PAST / 64) * 2048u + ((unsigned)(row - MP) & 63) * 8u);
                            *(u32x2*)(kb + (fq >> 1) * 512 + 4 * (fq & 1)) = pack4(o1); *(u32x2*)(kb + (2 + (fq >> 1)) * 512 + 4 * (fq & 1)) = pack4(o2); } }
                    asm volatile("" ::: "memory"); }
        } else {
#pragma unroll
            for (int ai = 0; ai < 2; ++ai)
#pragma unroll
                for (int m = 0; m < 4; ++m) { if (only >= 0 && only != ai * 4 + m) continue; const int row = u.pm * BM + ai * HALF + wr * 64 + m * 16 + fr; const float rs = rsv[ai][m];
#pragma unroll
                    for (int bj = 0; bj < 2; ++bj) { f32x4 a = acc[ai][bj][m][0] * rs, b = acc[ai][bj][m][1] * rs;
#pragma unroll
                        for (int e = 0; e < 4; ++e) { a[e] = silu1(a[e]); b[e] = silu1(b[e]); }
                        *(u32x4*)(sz + (size_t)row * DM + (u.pn - 2) * BM + bj * HALF + wc * 32 + 8 * fq) = pack8(a, b); }
                    asm volatile("" ::: "memory"); }
        }
    }
};


template <class Inner> struct EpiSplit {
    static constexpr bool PERM = Inner::PERM, AFTER_DRAIN = false;
    Inner in; float* scr; unsigned* cnt; int tu, slice;
    __device__ __forceinline__ void operator()(f32x4 (&acc)[2][2][4][2], const Unit& u, int wr, int wc, int fr, int fq) const {
        int lane_ = fq * 16 + fr; asm volatile("" : "+v"(lane_));
        const unsigned tid = (unsigned)((wr * 4 + wc) * 64 + lane_);
        f32x4* mine = (f32x4*)scr + ((size_t)(tu * 8 + slice) * 32u) * 512u + tid;
#pragma unroll
        for (int ai = 0; ai < 2; ++ai)
#pragma unroll
            for (int bj = 0; bj < 2; ++bj)
#pragma unroll
                for (int m = 0; m < 4; ++m)
#pragma unroll
                    for (int n = 0; n < 2; ++n) mine[(unsigned)(((ai * 2 + bj) * 4 + m) * 2 + n) * 512u] = acc[ai][bj][m][n];
        asm volatile("s_waitcnt vmcnt(0)" ::: "memory"); __builtin_amdgcn_s_barrier();
        if (tid == 0) { unsigned* c = cnt + tu * 16;
            __builtin_amdgcn_fence(__ATOMIC_RELEASE, "agent"); asm volatile("s_waitcnt vmcnt(0)" ::: "memory");
            (void)__hip_atomic_fetch_add(c, 1u, __ATOMIC_RELAXED, __HIP_MEMORY_SCOPE_AGENT);
            unsigned sp = 0; while (__hip_atomic_load(c, __ATOMIC_RELAXED, __HIP_MEMORY_SCOPE_AGENT) < 8u && ++sp < (1u << 22)) __builtin_amdgcn_s_sleep(1);
            __builtin_amdgcn_fence(__ATOMIC_ACQUIRE, "agent"); asm volatile("s_waitcnt vmcnt(0)" ::: "memory"); }
        __builtin_amdgcn_s_barrier();
        const f32x4* all = (const f32x4*)scr + ((size_t)(tu * 8) * 32u) * 512u + tid;
#pragma unroll
        for (int ai = 0; ai < 2; ++ai)
#pragma unroll
            for (int m = 0; m < 4; ++m) { if (slice != ai * 4 + m) continue;
#pragma unroll
                for (int bj = 0; bj < 2; ++bj)
#pragma unroll
                    for (int n = 0; n < 2; ++n) { const unsigned f = (unsigned)(((ai * 2 + bj) * 4 + m) * 2 + n) * 512u; f32x4 t = all[f];
#pragma unroll
                        for (int s = 1; s < 8; ++s) t += all[(unsigned)s * (32u * 512u) + f];
                        acc[ai][bj][m][n] = t; } }
        in(acc, u, wr, wc, fr, fq, slice);
    }
};

struct EpiQ {
    static constexpr bool PERM = false, AFTER_DRAIN = false;
    const float* ssqq; const float* rope; bf16_t* Qp; bf16_t* Qs;
    __device__ __forceinline__ void operator()(const f32x4 (&acc)[2][2][4][2], const Unit& u, int wr, int wc, int fr, int fq) const {
        asm volatile("" : "+v"(fr), "+v"(fq));
        const bool smp = u.pm * BM >= MP;
        bf16_t* Qb = smp ? Qs : Qp; const unsigned hs = smp ? (unsigned)(ST * DQK) : (unsigned)(SEQ * DQK);
#pragma unroll
        for (int ai = 0; ai < 2; ++ai) {
            f32x4 csv[4], snv[4];
            if (u.pn >= 4) {
#pragma unroll
                for (int m = 0; m < 4; ++m) { const int row = u.pm * BM + ai * HALF + wr * 64 + m * 16 + fr; const int pos = smp ? PAST + ((row - MP) & 63) : (row & (SEQ - 1));
                    csv[m] = *(const f32x4*)(rope + (unsigned)(pos * 32 + 4 * fq)); snv[m] = *(const f32x4*)(rope + (unsigned)(pos * 32 + 16 + 4 * fq)); }
            }
#pragma unroll
            for (int m = 0; m < 4; ++m) { const int row = u.pm * BM + ai * HALF + wr * 64 + m * 16 + fr;
                const float rq = 1.f;
                unsigned qo; int pos;
                if (!smp) { const unsigned b = (unsigned)row >> 13, s = (unsigned)row & (SEQ - 1); qo = (b * (NH * SEQ) + s) * DQK; pos = (int)s; }
                else { const unsigned r2 = (unsigned)(row - MP), b = r2 >> 6, s = r2 & 63; qo = (b * (NH * ST) + s) * DQK; pos = PAST + (int)s; }
                if (u.pn < 4) {
#pragma unroll
                    for (int bj = 0; bj < 2; ++bj) { const unsigned L = (unsigned)(u.pn * BM + bj * HALF + wc * 32 + 8 * fq), head = L >> 6, d = L & 63;
                        *(u32x4*)(Qb + (qo + head * hs + d)) = pack8(acc[ai][bj][m][0] * rq, acc[ai][bj][m][1] * rq); }
                } else {
                    const f32x4 cs = csv[m], sn = snv[m];
#pragma unroll
                    for (int bj = 0; bj < 2; ++bj) { const unsigned head = (unsigned)((u.pn - 4) * 8 + bj * 4 + wc);
                        const f32x4 x1 = acc[ai][bj][m][0] * rq, x2 = acc[ai][bj][m][1] * rq, o1 = x1 * cs - x2 * sn, o2 = x2 * cs + x1 * sn;
                        *(u32x2*)(Qb + (qo + head * hs + DN + 4 * fq)) = pack4(o1); *(u32x2*)(Qb + (qo + head * hs + DN + 16 + 4 * fq)) = pack4(o2); }
                }
                asm volatile("" ::: "memory");
            } }
    }
};

struct EpiKV {
    static constexpr bool PERM = false, AFTER_DRAIN = false;
    const float* ssqkv; bf16_t* K; bf16_t* V; float* out; int fix;
    __device__ __forceinline__ void operator()(const f32x4 (&acc)[2][2][4][2], const Unit& u, int wr, int wc, int fr, int fq) const {
        asm volatile("" : "+v"(fr), "+v"(fq));
        const bool isK = u.pn < 4; bf16_t* T = isK ? K : V; const int pn4 = u.pn & 3;
        const int cat = u.pm * BM < MP ? 0 : (u.pm * BM < MP + SB * PAST ? 1 : 2);
        const unsigned hs = cat == 0 ? (unsigned)(SEQ * DN) : (unsigned)(SKVP * DN);
        const int rbase = cat == 0 ? u.pm * BM : (cat == 2 ? u.pm * BM - SB * PAST : -1);
        float rkv[2][4];
        { f32x4 sq[2][4];
          if (rbase >= 0) {
#pragma unroll
            for (int ai = 0; ai < 2; ++ai)
#pragma unroll
                for (int m = 0; m < 4; ++m) sq[ai][m] = *(const f32x4*)(ssqkv + (unsigned)(rbase + ai * HALF + wr * 64 + m * 16 + fr) * 4u);
          }
#pragma unroll
          for (int ai = 0; ai < 2; ++ai)
#pragma unroll
            for (int m = 0; m < 4; ++m) rkv[ai][m] = rbase >= 0 ? 1.0f / sqrtf(((sq[ai][m][0] + sq[ai][m][1]) + (sq[ai][m][2] + sq[ai][m][3])) * (1.0f / KVL) + EPS) : 1.f; }
#pragma unroll
        for (int ai = 0; ai < 2; ++ai)
#pragma unroll
            for (int m = 0; m < 4; ++m) { const unsigned R = (unsigned)(u.pm * BM + ai * HALF + wr * 64 + m * 16 + fr);
                unsigned sb, s; float rk = 1.f; int r = -1;
                if (cat == 0) { const unsigned b = R >> 13; s = R & (SEQ - 1); sb = b * (NH * SEQ * DN); r = (int)R; }
                else if (cat == 1) { const unsigned r2 = R - MP, b = r2 >> 12; s = r2 & (PAST - 1); sb = (unsigned)KP_ELEMS + b * (NH * SKVP * DN); }
                else { const unsigned r2 = R - MP - SB * PAST, b = r2 >> 6; s = PAST + (r2 & 63); sb = (unsigned)KP_ELEMS + b * (NH * SKVP * DN); r = MP + (int)r2; }
                rk = rkv[ai][m];
                const unsigned key = s & 63, kk = key, tb = sb + (s >> 6) * 4096u;
#pragma unroll
                for (int bj = 0; bj < 2; ++bj) { const unsigned L = (unsigned)(pn4 * BM + bj * HALF + wc * 32 + 8 * fq), head = L >> 6, c = (L & 63) >> 3;
                    const unsigned off = isK ? c * 512u + key * 8u : ((kk >> 3) * 2 + (c >> 2)) * 256u + (kk & 7) * 32u + (c & 3) * 8u;
                    *(u32x4*)(T + (tb + head * hs + off)) = pack8(acc[ai][bj][m][0] * rk, acc[ai][bj][m][1] * rk); }
                if (fix && u.pn == 0 && r >= 0) { float* co = out + ((unsigned)(r < MP ? O_CKVP : O_CKVS - (size_t)MP * KVL) + (unsigned)r * KVL + wc * 32 + 8 * fq);
                    const f32x4 a = *(const f32x4*)co, b = *(const f32x4*)(co + 4); *(f32x4*)co = a * rk; *(f32x4*)(co + 4) = b * rk; }
                asm volatile("" ::: "memory");
            }
    }
};

template <class Epi, class Sched, bool ALIGN_EPI = false, bool SP2 = false>
__device__ __forceinline__ void gemm_phase(PG8_LAS unsigned char* lds, const Gemm g, const Sched& S, const Epi& E) {
    int tid_ = threadIdx.x; asm volatile("" : "+v"(tid_));
    const int tid = tid_, wid = __builtin_amdgcn_readfirstlane(tid >> 6), lane = tid & 63, wr = wid >> 2, wc = wid & 3, fr = lane & 15, fq = lane >> 4;
    const int K = g.K, nt = g.kt > 0 ? g.kt : K / BK;
    unsigned voffA[2], voffB[2];
#pragma unroll
    for (int i = 0; i < 2; ++i) { int R, C; stage_rc(tid * 16 + i * 8192, R, C); const int Rb = Epi::PERM ? ((R & ~31) + perm32(R & 31)) : R;
        voffA[i] = (unsigned)(R * K + C) * 2u; voffB[i] = (unsigned)(Rb * K + C) * 2u; }
    const size_t kstep = (size_t)(BK * 2);
    const size_t hstep = (size_t)HALF * K * 2;
    const size_t tstep = 2 * hstep;
    const unsigned ldsw = (unsigned)wid * 1024u;
    const int aoff = lds_byte(wr * 64 + fr, fq * 8), boff = lds_byte(wc * 32 + fr, fq * 8);
#define PG8_SA(b, h) (((b) * 2 + (h)) * HTB)
#define PG8_SB(b, h) ((4 + (b) * 2 + (h)) * HTB)
#define PG8_STAGE(bufoff, gbase, voff) do { _Pragma("unroll") for (int _i = 0; _i < 2; ++_i) \
        __builtin_amdgcn_global_load_lds((const unsigned*)((const char*)(gbase) + (voff)[_i]), (PG8_LAS unsigned*)(lds + (bufoff) + ldsw + _i * 8192), 16, 0, 0); } while (0)
#define PG8_LDA(dst, b, h) do { _Pragma("unroll") for (int m = 0; m < 4; ++m) _Pragma("unroll") for (int k = 0; k < 2; ++k) dst[m][k] = *(const PG8_LAS bf16x8*)(lds + PG8_SA(b, h) + aoff + m * 2048 + k * 1024); } while (0)
#define PG8_LDB(dst, b, h) do { _Pragma("unroll") for (int n = 0; n < 2; ++n) _Pragma("unroll") for (int k = 0; k < 2; ++k) dst[n][k] = *(const PG8_LAS bf16x8*)(lds + PG8_SB(b, h) + boff + n * 2048 + k * 1024); } while (0)
#define PG8_MMA(ai, bj, At, Bt) do { __builtin_amdgcn_s_setprio(1); _Pragma("unroll") for (int m = 0; m < 4; ++m) _Pragma("unroll") for (int n = 0; n < 2; ++n) _Pragma("unroll") for (int k = 0; k < 2; ++k) \
        acc[ai][bj][m][n] = __builtin_amdgcn_mfma_f32_16x16x32_bf16(Bt[n][k], At[m][k], acc[ai][bj][m][n], 0, 0, 0); __builtin_amdgcn_s_setprio(0); } while (0)
#define PG8_WAIT_V(n) asm volatile("s_waitcnt vmcnt(" #n ")" ::: "memory")
#define PG8_WAIT_L(n) asm volatile("s_waitcnt lgkmcnt(" #n ")" ::: "memory")
#define PG8_BAR __builtin_amdgcn_s_barrier()
#define PG8_SCHED __builtin_amdgcn_sched_barrier(0)
    Unit cur, nxt; int ui = 0;
    if (!S.next(0, cur)) return;
    f32x4 acc[2][2][4][2];
#pragma unroll
    for (int a = 0; a < 2; ++a)
#pragma unroll
        for (int b = 0; b < 2; ++b)
#pragma unroll
            for (int m = 0; m < 4; ++m)
#pragma unroll
                for (int n = 0; n < 2; ++n) acc[a][b][m][n] = (f32x4){0.f, 0.f, 0.f, 0.f};
    bf16x8 At[4][2], B0[2][2], B1[2][2];
    const char* cA = (const char*)g.A + (size_t)cur.pm * tstep; const char* cB = (const char*)g.Bt + (size_t)cur.pn * tstep;
    S.a_ready(cur);
    if constexpr (SP2) {
        PG8_STAGE(PG8_SB(0, 0), cB, voffB); PG8_STAGE(PG8_SB(0, 1), cB + hstep, voffB); PG8_STAGE(PG8_SA(0, 0), cA, voffA); PG8_STAGE(PG8_SA(0, 1), cA + hstep, voffA);
        if (wr == 1) PG8_BAR;
        PG8_WAIT_V(2); PG8_BAR;
        PG8_STAGE(PG8_SB(1, 0), cB + kstep, voffB); PG8_STAGE(PG8_SA(1, 0), cA + kstep, voffA); PG8_STAGE(PG8_SB(1, 1), cB + hstep + kstep, voffB);
        PG8_WAIT_V(6); PG8_BAR;
    } else {
        PG8_STAGE(PG8_SB(0, 0), cB, voffB); PG8_STAGE(PG8_SA(0, 0), cA, voffA); PG8_STAGE(PG8_SB(0, 1), cB + hstep, voffB); PG8_STAGE(PG8_SA(0, 1), cA + hstep, voffA);
        if (wr == 1) PG8_BAR;
        PG8_WAIT_V(4); PG8_BAR;
        PG8_STAGE(PG8_SB(1, 0), cB + kstep, voffB); PG8_STAGE(PG8_SA(1, 0), cA + kstep, voffA); PG8_STAGE(PG8_SB(1, 1), cB + hstep + kstep, voffB);
        PG8_WAIT_V(6); PG8_BAR;
    }
    for (;;) {
        const bool has_next = S.next(ui + 1, nxt);
        const char* nA = has_next ? (const char*)g.A + (size_t)nxt.pm * tstep : cA; const char* nB = has_next ? (const char*)g.Bt + (size_t)nxt.pn * tstep : cB;
#pragma unroll 1
        for (int t = 0; t < nt; t += 2) {
            const bool last = (t == nt - 2);
            const char* a1 = cA + (size_t)(t + 1) * kstep;
            const char* a2 = last ? nA : cA + (size_t)(t + 2) * kstep; const char* b2 = last ? nB : cB + (size_t)(t + 2) * kstep;
            const char* a3 = a2 + kstep; const char* b3 = b2 + kstep;
            if (last && has_next) S.a_ready(nxt);
            if constexpr (SP2) {
            PG8_LDB(B0, 0, 0); PG8_LDB(B1, 0, 1); PG8_SCHED; PG8_LDA(At, 0, 0); PG8_STAGE(PG8_SA(1, 1), a1 + hstep, voffA);
            PG8_WAIT_V(8); PG8_WAIT_L(0); PG8_BAR; PG8_MMA(0, 0, At, B0); PG8_MMA(0, 1, At, B1); PG8_BAR; PG8_SCHED;
            PG8_LDA(At, 0, 1); PG8_STAGE(PG8_SB(0, 0), b2, voffB); PG8_STAGE(PG8_SB(0, 1), b2 + hstep, voffB); PG8_STAGE(PG8_SA(0, 0), a2, voffA);
            PG8_WAIT_V(8); PG8_WAIT_L(0); PG8_BAR; PG8_MMA(1, 0, At, B0); PG8_MMA(1, 1, At, B1); PG8_BAR; PG8_SCHED;
            PG8_LDB(B0, 1, 0); PG8_LDB(B1, 1, 1); PG8_SCHED; PG8_LDA(At, 1, 0); PG8_STAGE(PG8_SA(0, 1), a2 + hstep, voffA);
            PG8_WAIT_V(8); PG8_WAIT_L(0); PG8_BAR; PG8_MMA(0, 0, At, B0); PG8_MMA(0, 1, At, B1); PG8_BAR; PG8_SCHED;
            PG8_LDA(At, 1, 1); PG8_STAGE(PG8_SB(1, 0), b3, voffB); PG8_STAGE(PG8_SB(1, 1), b3 + hstep, voffB); PG8_STAGE(PG8_SA(1, 0), a3, voffA);
            PG8_WAIT_V(8); PG8_WAIT_L(0); PG8_BAR; PG8_MMA(1, 0, At, B0); PG8_MMA(1, 1, At, B1); PG8_BAR; PG8_SCHED;
            } else {
            PG8_LDB(B0, 0, 0); PG8_SCHED; PG8_LDA(At, 0, 0); PG8_STAGE(PG8_SA(1, 1), a1 + hstep, voffA);
            PG8_WAIT_L(8); PG8_BAR; PG8_WAIT_L(0); PG8_MMA(0, 0, At, B0); PG8_BAR; PG8_SCHED;
            PG8_LDB(B1, 0, 1); PG8_STAGE(PG8_SB(0, 0), b2, voffB);
            PG8_BAR; PG8_WAIT_L(0); PG8_MMA(0, 1, At, B1); PG8_BAR;
            PG8_LDA(At, 0, 1); PG8_STAGE(PG8_SA(0, 0), a2, voffA);
            PG8_BAR; PG8_WAIT_L(0); PG8_MMA(1, 0, At, B0); PG8_BAR; PG8_SCHED;
            PG8_STAGE(PG8_SB(0, 1), b2 + hstep, voffB);
            PG8_WAIT_V(6); PG8_BAR; PG8_MMA(1, 1, At, B1); PG8_BAR;
            PG8_LDB(B0, 1, 0); PG8_SCHED; PG8_LDA(At, 1, 0); PG8_STAGE(PG8_SA(0, 1), a2 + hstep, voffA);
            PG8_WAIT_L(8); PG8_BAR; PG8_WAIT_L(0); PG8_MMA(0, 0, At, B0); PG8_BAR; PG8_SCHED;
            PG8_LDB(B1, 1, 1); PG8_STAGE(PG8_SB(1, 0), b3, voffB);
            PG8_BAR; PG8_WAIT_L(0); PG8_MMA(0, 1, At, B1); PG8_BAR;
            PG8_LDA(At, 1, 1); PG8_STAGE(PG8_SA(1, 0), a3, voffA);
            PG8_BAR; PG8_WAIT_L(0); PG8_MMA(1, 0, At, B0); PG8_BAR; PG8_SCHED;
            PG8_STAGE(PG8_SB(1, 1), b3 + hstep, voffB);
            PG8_WAIT_V(6); PG8_BAR; PG8_MMA(1, 1, At, B1); PG8_BAR;
            }
        }
        if constexpr (ALIGN_EPI) { if (wr == 0) PG8_BAR; }
        if constexpr (!Epi::AFTER_DRAIN) { E(acc, cur, wr, wc, fr, fq); S.done(cur); }
        if (!has_next) break;
#pragma unroll
        for (int a = 0; a < 2; ++a)
#pragma unroll
            for (int b = 0; b < 2; ++b)
#pragma unroll
                for (int m = 0; m < 4; ++m)
#pragma unroll
                    for (int n = 0; n < 2; ++n) acc[a][b][m][n] = (f32x4){0.f, 0.f, 0.f, 0.f};
        cur = nxt; cA = nA; cB = nB; ++ui;
        if constexpr (ALIGN_EPI) { if (wr == 1) PG8_BAR; }
    }
    PG8_WAIT_V(0);
    if constexpr (!ALIGN_EPI) { if (wr == 0) PG8_BAR; }
    PG8_BAR;
    if constexpr (Epi::AFTER_DRAIN) { E.fused(acc, cur, wr, wc, fr, fq, lds, wid, lane); S.done(cur); }
#undef PG8_SA
#undef PG8_SB
#undef PG8_STAGE
#undef PG8_LDA
#undef PG8_LDB
#undef PG8_MMA
#undef PG8_WAIT_V
#undef PG8_WAIT_L
#undef PG8_BAR
#undef PG8_SCHED
}
}
namespace att {
using bf16x8 = __attribute__((ext_vector_type(8))) short;
using s16x4  = __attribute__((ext_vector_type(4))) short;
using f32x16 = __attribute__((ext_vector_type(16))) float;
using f32x4  = __attribute__((ext_vector_type(4))) float;
using u32x4  = __attribute__((ext_vector_type(4))) unsigned;
using u32x2  = __attribute__((ext_vector_type(2))) unsigned;
typedef unsigned short bf16_t;
constexpr int NW = 8, QBLK = 32, KVBLK = 64;
constexpr int KSLOT = 12288, VSLOT = 8192, OSTP = 68, NSLOT = 4;
constexpr int L_K = 0, L_V = NSLOT * KSLOT, L_WS = L_V + NSLOT * VSLOT, L_OST = L_WS + NW * 256, L_END = L_OST + NW * 32 * OSTP * 4;
constexpr float THR = 8.f;
#define SBAR() __builtin_amdgcn_sched_barrier(0)
__device__ __forceinline__ int crow(int r, int hi) { return (r & 3) + 8 * (r >> 2) + 4 * hi; }
__device__ __forceinline__ void glds16(const void* gbase, unsigned voff, unsigned lds_dst) { unsigned keep;
  asm volatile("s_mov_b32 %0, m0\n\ts_mov_b32 m0, %3\n\ts_nop 0\n\tglobal_load_lds_dwordx4 %1, %2\n\ts_mov_b32 m0, %0" : "=&s"(keep) : "v"(voff), "s"(gbase), "s"(lds_dst) : "memory"); }
#define WAIT_BAR(N) asm volatile("s_waitcnt vmcnt(" #N ") lgkmcnt(0)\n\ts_barrier" ::: "memory")
typedef float f32x2_t __attribute__((ext_vector_type(2))); typedef __bf16 bf16x2_t __attribute__((ext_vector_type(2)));
__device__ __forceinline__ unsigned cvtpk(float lo, float hi) { f32x2_t v = {lo, hi}; bf16x2_t b = __builtin_convertvector(v, bf16x2_t); return __builtin_bit_cast(unsigned, b); }

template <bool FIRST>
__device__ __forceinline__ bool rowmax_dec(f32x16& p0, f32x16& p1, float& mhat, f32x16& negm, float& alpha) {
  float pmax = p0[0];
#pragma unroll
  for (int r = 1; r < 16; ++r) pmax = fmaxf(pmax, p0[r]);
#pragma unroll
  for (int r = 0; r < 16; ++r) pmax = fmaxf(pmax, p1[r]);
  { auto rr = __builtin_amdgcn_permlane32_swap(__float_as_uint(pmax), __float_as_uint(pmax), false, false);
    pmax = fmaxf(__uint_as_float(rr[0]), __uint_as_float(rr[1])); }
  alpha = 1.f;
  if (FIRST || __builtin_expect(__any(pmax > THR), 0)) {
    const float dl = FIRST ? pmax : fmaxf(pmax, 0.f); mhat += dl;
#pragma unroll
    for (int r = 0; r < 16; ++r) { p0[r] -= dl; p1[r] -= dl; }
#pragma unroll
    for (int r = 0; r < 16; ++r) negm[r] = -mhat;
    alpha = __builtin_amdgcn_exp2f(-dl);
    return true;
  }
  return false;
}
__device__ __forceinline__ void finishSM(f32x16& p0, f32x16& p1, float alpha, float& l_reg, bf16x8& pa0, bf16x8& pa1, bf16x8& pa2, bf16x8& pa3) {
#pragma unroll
  for (int r = 0; r < 16; ++r) p0[r] = __builtin_amdgcn_exp2f(p0[r]);
#pragma unroll
  for (int r = 0; r < 16; ++r) p1[r] = __builtin_amdgcn_exp2f(p1[r]);
  float ps = 0;
#pragma unroll
  for (int r = 0; r < 16; ++r) ps += p0[r];
#pragma unroll
  for (int r = 0; r < 16; ++r) ps += p1[r];
  { auto rr = __builtin_amdgcn_permlane32_swap(__float_as_uint(ps), __float_as_uint(ps), false, false);
    ps = __uint_as_float(rr[0]) + __uint_as_float(rr[1]); }
  l_reg = l_reg * alpha + ps;
#define PK4(P, BASE, OUT) do { u32x4 w = {cvtpk(P[BASE + 0], P[BASE + 1]), cvtpk(P[BASE + 2], P[BASE + 3]), cvtpk(P[BASE + 4], P[BASE + 5]), cvtpk(P[BASE + 6], P[BASE + 7])}; OUT = *reinterpret_cast<bf16x8*>(&w); } while (0)
  PK4(p0, 0, pa0); PK4(p0, 8, pa1); PK4(p1, 0, pa2); PK4(p1, 8, pa3);
#undef PK4
  asm volatile("" :: "v"(pa0), "v"(pa1), "v"(pa2), "v"(pa3));
}
template <int D0A, int D0B> __device__ __forceinline__ void kload(bf16x8* kf, const char* Ks, int r32, int hi) {
  const char* kb = Ks + hi * 1024 + r32 * 16;
#pragma unroll
  for (int d0 = D0A; d0 < D0B; ++d0) { kf[2 * d0] = *reinterpret_cast<const bf16x8*>(kb + d0 * 2048); kf[2 * d0 + 1] = *reinterpret_cast<const bf16x8*>(kb + d0 * 2048 + 512); }
}
constexpr int KPRE = 0;
__device__ __forceinline__ void qkt(f32x16& p0, f32x16& p1, const bf16x8* kf, const bf16x8* qr, const f32x16& negm) {
#pragma unroll
  for (int d0 = 0; d0 < 6; ++d0) {
    if (d0 == 0) { p0 = __builtin_amdgcn_mfma_f32_32x32x16_bf16(kf[0], qr[0], negm, 0, 0, 0); p1 = __builtin_amdgcn_mfma_f32_32x32x16_bf16(kf[1], qr[0], negm, 0, 0, 0); }
    else { p0 = __builtin_amdgcn_mfma_f32_32x32x16_bf16(kf[2 * d0], qr[d0], p0, 0, 0, 0); p1 = __builtin_amdgcn_mfma_f32_32x32x16_bf16(kf[2 * d0 + 1], qr[d0], p1, 0, 0, 0); } }
}
__device__ __forceinline__ int v_rd_base(int lane) { return ((lane & 3) << 3) | (((lane >> 2) & 3) << 6) | (((lane >> 4) & 1) << 5) | (((lane >> 5) & 1) << 8); }
constexpr int v_rd_off(int d0, int ks, int half) { return d0 * 512 + ks * 2048 + half * 1024; }
template <int OFF> __device__ __forceinline__ s16x4 tr_read(int vb) {
  s16x4 r; asm volatile("ds_read_b64_tr_b16 %0, %1 offset:%2" : "=&v"(r) : "v"(vb), "i"(OFF) : "memory"); return r;
}
template <int D0> __device__ __forceinline__ void pv_one(f32x16& od, int vb, bf16x8 pa0, bf16x8 pa1, bf16x8 pa2, bf16x8 pa3) {
  const s16x4 l0 = tr_read<v_rd_off(D0, 0, 0)>(vb), h0 = tr_read<v_rd_off(D0, 0, 1)>(vb), l1 = tr_read<v_rd_off(D0, 1, 0)>(vb), h1 = tr_read<v_rd_off(D0, 1, 1)>(vb);
  const s16x4 l2 = tr_read<v_rd_off(D0, 2, 0)>(vb), h2 = tr_read<v_rd_off(D0, 2, 1)>(vb), l3 = tr_read<v_rd_off(D0, 3, 0)>(vb), h3 = tr_read<v_rd_off(D0, 3, 1)>(vb);
  asm volatile("s_waitcnt lgkmcnt(0)" ::: "memory"); SBAR();
#define PK(L, H) (bf16x8){L[0], L[1], L[2], L[3], H[0], H[1], H[2], H[3]}
  od = __builtin_amdgcn_mfma_f32_32x32x16_bf16(pa0, PK(l0, h0), od, 0, 0, 0);
  od = __builtin_amdgcn_mfma_f32_32x32x16_bf16(pa1, PK(l1, h1), od, 0, 0, 0);
  od = __builtin_amdgcn_mfma_f32_32x32x16_bf16(pa2, PK(l2, h2), od, 0, 0, 0);
  od = __builtin_amdgcn_mfma_f32_32x32x16_bf16(pa3, PK(l3, h3), od, 0, 0, 0);
#undef PK
}
struct VFrag8 { s16x4 l0, h0, l1, h1, l2, h2, l3, h3; };
__device__ __forceinline__ void pv_read0(VFrag8& f, int vb) {
  f.l0 = tr_read<v_rd_off(0, 0, 0)>(vb); f.h0 = tr_read<v_rd_off(0, 0, 1)>(vb); f.l1 = tr_read<v_rd_off(0, 1, 0)>(vb); f.h1 = tr_read<v_rd_off(0, 1, 1)>(vb);
  f.l2 = tr_read<v_rd_off(0, 2, 0)>(vb); f.h2 = tr_read<v_rd_off(0, 2, 1)>(vb); f.l3 = tr_read<v_rd_off(0, 3, 0)>(vb); f.h3 = tr_read<v_rd_off(0, 3, 1)>(vb);
}
__device__ __forceinline__ void pv_mma0(f32x16& od, const VFrag8& f, bf16x8 pa0, bf16x8 pa1, bf16x8 pa2, bf16x8 pa3) {
  asm volatile("s_waitcnt lgkmcnt(0)" ::: "memory"); SBAR();
#define PK(L, H) (bf16x8){L[0], L[1], L[2], L[3], H[0], H[1], H[2], H[3]}
  od = __builtin_amdgcn_mfma_f32_32x32x16_bf16(pa0, PK(f.l0, f.h0), od, 0, 0, 0);
  od = __builtin_amdgcn_mfma_f32_32x32x16_bf16(pa1, PK(f.l1, f.h1), od, 0, 0, 0);
  od = __builtin_amdgcn_mfma_f32_32x32x16_bf16(pa2, PK(f.l2, f.h2), od, 0, 0, 0);
  od = __builtin_amdgcn_mfma_f32_32x32x16_bf16(pa3, PK(f.l3, f.h3), od, 0, 0, 0);
#undef PK
}
__device__ __forceinline__ void pv_all(f32x16* o, int vb, bf16x8 pa0, bf16x8 pa1, bf16x8 pa2, bf16x8 pa3) {
  pv_one<0>(o[0], vb, pa0, pa1, pa2, pa3); pv_one<1>(o[1], vb, pa0, pa1, pa2, pa3);
}

__device__ __forceinline__ void attn_unit(const bool SAMPLE, const bool DRY, const bool PRE, const bf16_t* __restrict__ Qb, const bf16_t* __restrict__ Kh, const bf16_t* __restrict__ Vh, const bf16_t* __restrict__ KRh,
                                          const bf16_t* KhN, const bf16_t* VhN, const bf16_t* KRhN, const bf16_t* QbN, const bool SAMPLE_N, bf16_t* G, int NT, int visb, char* lds) {
  int tid_ = threadIdx.x; asm volatile("" : "+v"(tid_));
  const int tid = tid_, wid = __builtin_amdgcn_readfirstlane(tid >> 6), lane = tid & 63, r32 = lane & 31, hi = lane >> 5;
  char* V_lds = lds + L_V; char* K_lds = lds + L_K;
  float* ws = (float*)(lds + L_WS) + wid * 64; float* li_l = ws; float* al_l = ws + 32;
  float* ost = (float*)(lds + L_OST) + wid * 32 * OSTP;
  const unsigned lds0 = (unsigned)(uintptr_t)lds;
  const int wq = SAMPLE ? (wid & 1) : wid, vis = SAMPLE ? visb : visb + (wid >> 1);
  const unsigned lo = (unsigned)(wid * 1024 + lane * 16), lor = (unsigned)(wid * 512 + (lane & 31) * 16);
  const unsigned kdst = lds0 + L_K + wid * 1024, rdst = lds0 + L_K + 8 * 1024 + wid * 512, vdst = lds0 + L_V + wid * 1024;
#define DMA_K(t, slot) do { const unsigned t_ = (unsigned)(t); glds16((const char*)Kh + (size_t)t_ * 8192u, lo, (unsigned)__builtin_amdgcn_readfirstlane(kdst + (slot))); \
    if (lane < 32) glds16((const char*)KRh + (size_t)t_ * 4096u, lor, (unsigned)__builtin_amdgcn_readfirstlane(rdst + (slot))); } while (0)
#define DMA_V(t, slot) glds16((const char*)Vh + (size_t)(unsigned)(t) * 8192u, lo, (unsigned)__builtin_amdgcn_readfirstlane(vdst + (slot) / 3 * 2))
#define SLOTK(t) ((((unsigned)(t)) & (NSLOT - 1)) * KSLOT)
#define ISSUE_PAIR(j_, FULL) do { if ((FULL) || (j_) + 2 < NT) DMA_K((j_) + 2, SLOTK((j_) + 2)); if ((FULL) || (j_) + 3 < NT) DMA_K((j_) + 3, SLOTK((j_) + 3)); \
    if ((FULL) || (j_) + 1 < NT) DMA_V((j_) + 1, SLOTK((j_) + 1)); if ((FULL) || (j_) + 2 < NT) DMA_V((j_) + 2, SLOTK((j_) + 2)); } while (0)
  if (!PRE) { DMA_K(0, 0); DMA_V(0, 0); DMA_K(1, KSLOT); DMA_K(2, 2 * KSLOT); }
  if (SAMPLE && wid >= 2) {
    asm volatile("s_waitcnt vmcnt(0)" ::: "memory"); WAIT_BAR(0);
    DMA_V(1, SLOTK(1)); WAIT_BAR(0);
    for (int j = 1; j + 1 < NT; j += 2) { ISSUE_PAIR(j, false); WAIT_BAR(0); }
    WAIT_BAR(0);
    if (KhN) { const unsigned t0_ = 0u; (void)t0_;
      glds16((const char*)KhN, lo, (unsigned)__builtin_amdgcn_readfirstlane(kdst)); if (lane < 32) glds16((const char*)KRhN, lor, (unsigned)__builtin_amdgcn_readfirstlane(rdst));
      glds16((const char*)VhN, lo, (unsigned)__builtin_amdgcn_readfirstlane(vdst));
      glds16((const char*)KhN + 8192, lo, (unsigned)__builtin_amdgcn_readfirstlane(kdst + KSLOT)); if (lane < 32) glds16((const char*)KRhN + 4096, lor, (unsigned)__builtin_amdgcn_readfirstlane(rdst + KSLOT));
      glds16((const char*)KhN + 16384, lo, (unsigned)__builtin_amdgcn_readfirstlane(kdst + 2 * KSLOT)); if (lane < 32) glds16((const char*)KRhN + 8192, lor, (unsigned)__builtin_amdgcn_readfirstlane(rdst + 2 * KSLOT)); }
    asm volatile("s_waitcnt lgkmcnt(0)\n\ts_barrier" ::: "memory");
    return;
  }
  float mhat = 0.f, l_reg = 0; f32x16 o[2] = {}; f32x16 negm = {}; bf16x8 kf[12], qr[6];
  { const unsigned qof = (unsigned)((wq * QBLK + r32) * DQK + hi * 8);
#pragma unroll
    for (int d0 = 0; d0 < 6; ++d0) qr[d0] = *reinterpret_cast<const bf16x8*>(Qb + (qof + d0 * 16)); }
  const int vb0 = (int)(uintptr_t)V_lds + v_rd_base(lane);
#define RESC(a) do { if (hi == 0) al_l[r32] = (a); asm volatile("s_waitcnt lgkmcnt(0)" ::: "memory"); \
    _Pragma("unroll") for (int d = 0; d < 2; ++d) _Pragma("unroll") for (int r = 0; r < 16; ++r) o[d][r] *= al_l[crow(r, hi)]; } while (0)
#define MASK(P0, P1, t) do { if ((t) > vis) { _Pragma("unroll") for (int r = 0; r < 16; ++r) { P0[r] = -INFINITY; P1[r] = -INFINITY; } } } while (0)
  f32x16 pA0, pA1, pB0, pB1; float alA, alB; bf16x8 pa0, pa1, pa2, pa3;
#define VOFF(s) ((s) / 3 * 2)
  asm volatile("s_waitcnt vmcnt(0)" ::: "memory");
  WAIT_BAR(0);
  kload<0, 6>(kf, K_lds, r32, hi);
  qkt(pA0, pA1, kf, qr, negm); rowmax_dec<true>(pA0, pA1, mhat, negm, alA); alA = 0.f;
  DMA_V(1, SLOTK(1));
  WAIT_BAR(0);
#define QK_SGB() do { __builtin_amdgcn_sched_group_barrier(0x100, 12, 0); __builtin_amdgcn_sched_group_barrier(0x400, 4, 0); __builtin_amdgcn_sched_group_barrier(0x002, 4, 0); _Pragma("unroll") for (int i_ = 0; i_ < 12; ++i_) { __builtin_amdgcn_sched_group_barrier(0x008, 1, 0); \
      __builtin_amdgcn_sched_group_barrier(0x400, 3, 0); __builtin_amdgcn_sched_group_barrier(0x002, 5, 0); } } while (0)
#define STEP(C0, C1, P0, P1, alC, alP, t, MSK, DMA_) do { \
    const bool vc_ = !(MSK) || (t) <= vis, vp_ = !(MSK) || (t) - 1 <= vis; \
    SBAR(); if (vc_) { kload<0, 6>(kf, K_lds + SLOTK(t), r32, hi); qkt(C0, C1, kf, qr, negm); } \
    if (vp_) finishSM(P0, P1, alP, l_reg, pa0, pa1, pa2, pa3); if (!(MSK)) QK_SGB(); SBAR(); \
    VFrag8 vf_; if (vp_) pv_read0(vf_, vb0 + VOFF(SLOTK((t) - 1))); SBAR(); \
    DMA_; SBAR(); \
    if (vp_) { pv_mma0(o[0], vf_, pa0, pa1, pa2, pa3); pv_one<1>(o[1], vb0 + VOFF(SLOTK((t) - 1)), pa0, pa1, pa2, pa3); } \
    if (vc_) { if (rowmax_dec<false>(C0, C1, mhat, negm, alC)) RESC(alC); } else alC = 1.f; } while (0)
  int j = 1; const int jm = visb < NT - 4 ? visb : NT - 4;
  for (; j + 1 <= jm; j += 2) { STEP(pB0, pB1, pA0, pA1, alB, alA, j, false, ISSUE_PAIR(j, true)); STEP(pA0, pA1, pB0, pB1, alA, alB, j + 1, false, (void)0); WAIT_BAR(0); }
  for (; j + 1 < NT; j += 2) { STEP(pB0, pB1, pA0, pA1, alB, alA, j, true, ISSUE_PAIR(j, false)); STEP(pA0, pA1, pB0, pB1, alA, alB, j + 1, true, (void)0); WAIT_BAR(0); }
  STEP(pB0, pB1, pA0, pA1, alB, alA, NT - 1, true, (void)0); WAIT_BAR(0);
  const unsigned sl_prev = SLOTK(NT - 1);
  if (KhN) {
#define DMA_KN(t, slot) do { const unsigned t_ = (unsigned)(t); glds16((const char*)KhN + (size_t)t_ * 8192u, lo, (unsigned)__builtin_amdgcn_readfirstlane(kdst + (slot))); \
    if (lane < 32) glds16((const char*)KRhN + (size_t)t_ * 4096u, lor, (unsigned)__builtin_amdgcn_readfirstlane(rdst + (slot))); } while (0)
    DMA_KN(0, 0); glds16((const char*)VhN, lo, (unsigned)__builtin_amdgcn_readfirstlane(vdst)); DMA_KN(1, KSLOT); DMA_KN(2, 2 * KSLOT);
#undef DMA_KN
  }
  u32x4 zz[4];
  if ((!SAMPLE || wid < 2) && !DRY) {
#pragma unroll
    for (int i = 0; i < 4; ++i) zz[i] = __builtin_nontemporal_load((const u32x4*)(G + (unsigned)((wq * QBLK + i * 8 + (lane >> 3)) * DM + (lane & 7) * 8))); }
  if (NT - 1 <= vis) { finishSM(pB0, pB1, alB, l_reg, pa0, pa1, pa2, pa3); SBAR();
    pv_all(o, vb0 + VOFF(sl_prev), pa0, pa1, pa2, pa3); }
  if (hi == 0) li_l[r32] = l_reg; asm volatile("s_waitcnt lgkmcnt(0)" ::: "memory");
#pragma unroll
  for (int r = 0; r < 16; ++r) { const int orow = crow(r, hi); const float rl = __builtin_amdgcn_rcpf(li_l[orow]);
    ost[orow * OSTP + r32] = o[0][r] * rl; ost[orow * OSTP + 32 + r32] = o[1][r] * rl; }
  asm volatile("s_waitcnt lgkmcnt(0)" ::: "memory");
  if ((!SAMPLE || wid < 2) && !DRY) {
#pragma unroll
    for (int i = 0; i < 4; ++i) { const int row = i * 8 + (lane >> 3), ch = lane & 7;
      const f32x4 a = *(const f32x4*)(ost + row * OSTP + ch * 8), b = *(const f32x4*)(ost + row * OSTP + ch * 8 + 4);
      bf16_t* gp = G + (unsigned)((wq * QBLK + row) * DM + ch * 8); const u32x4 z_ = zz[i]; u32x4 w;
      w.x = cvtpk(a[0] * __uint_as_float(z_.x << 16), a[1] * __uint_as_float(z_.x & 0xffff0000u));
      w.y = cvtpk(a[2] * __uint_as_float(z_.y << 16), a[3] * __uint_as_float(z_.y & 0xffff0000u));
      w.z = cvtpk(b[0] * __uint_as_float(z_.z << 16), b[1] * __uint_as_float(z_.z & 0xffff0000u));
      w.w = cvtpk(b[2] * __uint_as_float(z_.w << 16), b[3] * __uint_as_float(z_.w & 0xffff0000u));
      *(u32x4*)gp = w; }
  }
  asm volatile("s_waitcnt lgkmcnt(0)\n\ts_barrier" ::: "memory");
#undef DMA_K
#undef DMA_V
#undef RESC
#undef MASK
#undef ROT
#undef VOFF
#undef SLOTK
#undef ISSUE_PAIR
#undef ENDW
#undef QK_SGB
#undef STEP
}
#undef WAIT_BAR
#undef SBAR
}

constexpr int NWAVES = 8;
constexpr int RING_OFF = 0, RING_BYTES = 153600;
constexpr int LDSCTL_OFF = RING_BYTES, MISC_OFF = LDSCTL_OFF + 320;
constexpr int LDS_BYTES = 155648;
static_assert(att::L_END <= RING_BYTES && MISC_OFF + 128 <= LDS_BYTES, "LDS map");

#define GAS __attribute__((address_space(1)))
#define LAS __attribute__((address_space(3)))
typedef unsigned short bf16;
typedef unsigned v4u __attribute__((ext_vector_type(4)));
typedef unsigned v2u __attribute__((ext_vector_type(2)));
typedef float f32x4 __attribute__((ext_vector_type(4)));
typedef GAS unsigned gu32;
#define RLX_AGENT __ATOMIC_RELAXED, __HIP_MEMORY_SCOPE_AGENT
#define LDS_WAIT() asm volatile("s_waitcnt lgkmcnt(0)" ::: "memory")
#define VM_WAIT() asm volatile("s_waitcnt vmcnt(0)" ::: "memory")
typedef float f32x2_ __attribute__((ext_vector_type(2))); typedef __bf16 bf16x2_ __attribute__((ext_vector_type(2)));
__device__ __forceinline__ unsigned pk2(float lo, float hi) { f32x2_ v = {lo, hi}; bf16x2_ b = __builtin_convertvector(v, bf16x2_); return __builtin_bit_cast(unsigned, b); }

#define XB_TMO      128
#define XB_XCNT(j)  (256  + 64 * (j))
#define XB_XSUB(j)  (1280 + 64 * (j))
#define XB_XGEN(j)  (2304 + 64 * (j))
#define XB_TOP      3328
#define XB_TOPGEN   3392
#define XCD_BAR_WORDS 3456
#define XB_SPIN_CAP (1u << 18)

__device__ __forceinline__ unsigned xb_ld(unsigned* p)              { return __hip_atomic_load(p, __ATOMIC_RELAXED, __HIP_MEMORY_SCOPE_AGENT); }
__device__ __forceinline__ unsigned xb_add(unsigned* p, unsigned v) { return __hip_atomic_fetch_add(p, v, __ATOMIC_RELAXED, __HIP_MEMORY_SCOPE_AGENT); }
__device__ __forceinline__ unsigned xb_xcc_id() { return (unsigned)__builtin_amdgcn_s_getreg((3 << 11) | 20) & 0xFu; }
#define XB_SPIN(cond, bar) do { unsigned _sp = 0; while (cond) { __builtin_amdgcn_s_sleep(1); \
    if ((++_sp & 255u) == 0u) { if (xb_ld(&(bar)[XB_TMO])) break; if (_sp > XB_SPIN_CAP) { atomicAdd(&(bar)[XB_TMO], 1u); break; } } } } while (0)

struct XcdBarrier {
    unsigned* bar; unsigned x;
    volatile LAS unsigned* st;
};

__device__ __forceinline__ XcdBarrier xcd_barrier_post(unsigned* bar, volatile LAS unsigned* st) {
    XcdBarrier b; b.bar = bar; b.x = xb_xcc_id(); b.st = st;
    if (threadIdx.x == 0) (void)xb_add(&bar[XB_XCNT(b.x)], 1u);
    return b;
}
__device__ __forceinline__ void xcd_barrier_complete(unsigned* bar, unsigned x, unsigned& nloc, unsigned& nx) {
    const unsigned G = gridDim.x * gridDim.y * gridDim.z;
    unsigned sum, cnt, mine, sp = 0u;
    for (;;) {
        sum = 0u; cnt = 0u; mine = 0u;
#pragma unroll
        for (unsigned j = 0; j < 16; ++j) { const unsigned c = xb_ld(&bar[XB_XCNT(j)]); sum += c; cnt += (c > 0u) ? 1u : 0u; mine = (j == x) ? c : mine; }
        if (sum == G) break;
        __builtin_amdgcn_s_sleep(1);
        if ((++sp & 255u) == 0u) { if (xb_ld(&bar[XB_TMO])) break; if (sp > XB_SPIN_CAP) { atomicAdd(&bar[XB_TMO], 1u); break; } }
    }
    nloc = mine > 0u ? mine : 1u; nx = cnt > 0u ? cnt : 1u;
}

__device__ __forceinline__ void xcd_barrier(const XcdBarrier& b) {
    asm volatile("s_waitcnt vmcnt(0)" ::: "memory");
    __syncthreads();
    if (threadIdx.x == 0) {
        unsigned* bar = b.bar;
        __builtin_amdgcn_s_waitcnt(0);
        unsigned nloc = b.st[0], nx = b.st[1];
        if (nloc == 0u) { xcd_barrier_complete(bar, b.x, nloc, nx); b.st[0] = nloc; b.st[1] = nx; }
        const unsigned round = b.st[2];
        const unsigned old = xb_add(&bar[XB_XSUB(b.x)], 1u);
        if (old + 1u == (round + 1u) * nloc) {
            __builtin_amdgcn_fence(__ATOMIC_RELEASE, "agent");
            asm volatile("s_waitcnt vmcnt(0)" ::: "memory");
            const unsigned og = xb_add(&bar[XB_TOP], 1u);
            if (og + 1u == (round + 1u) * nx) xb_add(&bar[XB_TOPGEN], 1u);
            else XB_SPIN(xb_ld(&bar[XB_TOPGEN]) == round, bar);
        } else {
            XB_SPIN(xb_ld(&bar[XB_TOPGEN]) == round, bar);
        }
        __builtin_amdgcn_fence(__ATOMIC_ACQUIRE, "agent");
        asm volatile("s_waitcnt vmcnt(0)" ::: "memory");
        b.st[2] = round + 1u;
    }
    __syncthreads();
}


struct Args { const float* in[16]; float* out; unsigned char* ws; int ph_lo, ph_hi, li, pad; };
struct Frame {
    LAS unsigned char* lds; volatile LAS unsigned* MISC; gu32* ctl;
    int tid, lane, wave, vcu, G;
};
__device__ __forceinline__ float wave_sum(float v) {
#pragma unroll
    for (int o = 1; o < 64; o <<= 1) v += __shfl_xor(v, o);
    return v;
}
__device__ __forceinline__ int p8map(int cl) { return (cl & ~31) | (((cl >> 2) & 3) << 3) | (((cl >> 4) & 1) << 2) | (cl & 3); }
__device__ __forceinline__ int wcol(int g, int j) {
    const int pn = j >> 8, cl = j & 255;
    if (g == 0) return ((cl >> 7) * 2 + ((cl >> 4) & 1)) * 1024 + pn * 64 + ((cl >> 5) & 3) * 16 + (cl & 15);
    if (g == 2) { if (pn == 0) return p8map(cl); if (pn == 1) return cl < 160 ? 256 + cl : -1; return 416 + (pn - 2) * 256 + p8map(cl); }
    if (g == 3) { if (pn < 4) { const int L = pn * 256 + p8map(cl); return (L >> 6) * 96 + (L & 63); } const int L = (pn - 4) * 256 + cl; return (L >> 5) * 96 + 64 + (L & 31); }
    if (g == 4) { const int L = (pn & 3) * 256 + p8map(cl); return (L >> 6) * 128 + (pn >= 4 ? 64 : 0) + (L & 63); }
    return (j & ~255) | p8map(j & 255);
}
__device__ __forceinline__ void p0_wt_item(const float* W, int K, int Nsrc, const float* rscale, float cscale, int g, bf16* WT, LAS float* scr, int item, int nblk, int lane) {
    const int kb = item / nblk, nb = item % nblk, k0 = 64 * kb, j0 = 32 * nb;
    const int col = wcol(g, j0 + (lane & 31));
    float wv[32];
#pragma unroll
    for (int i = 0; i < 32; ++i) { const int kk = 2 * i + (lane >> 5); wv[i] = col >= 0 ? __builtin_nontemporal_load(W + (size_t)(k0 + kk) * Nsrc + col) : 0.f; }
#pragma unroll
    for (int i = 0; i < 32; ++i) { const int kk = 2 * i + (lane >> 5); float v = wv[i] * cscale; if (rscale) v *= rscale[k0 + kk];
        scr[kk * 33 + (lane & 31)] = v; }
    LDS_WAIT(); asm volatile("" ::: "memory");
    const int c = lane & 7;
#pragma unroll
    for (int jq = 0; jq < 4; ++jq) { const int n = (lane >> 3) + 8 * jq; const LAS float* s = scr + (8 * c) * 33 + n;
        v4u o; o.x = pk2(s[0 * 33], s[1 * 33]); o.y = pk2(s[2 * 33], s[3 * 33]); o.z = pk2(s[4 * 33], s[5 * 33]); o.w = pk2(s[6 * 33], s[7 * 33]);
        *(GAS v4u*)(WT + (size_t)(j0 + n) * K + k0 + 8 * c) = o; }
    LDS_WAIT(); asm volatile("" ::: "memory");
}
__device__ __forceinline__ void sincos_tab(float ang, float& s, float& c) {
    const double x = (double)ang, q = rint(x * 0.63661977236758134308), r = x - q * 1.57079632679489661923, r2 = r * r;
    const double sp = r * (1.0 + r2 * (-1.0 / 6 + r2 * (1.0 / 120 + r2 * (-1.0 / 5040 + r2 * (1.0 / 362880 - r2 * (1.0 / 39916800))))));
    const double cp = 1.0 + r2 * (-0.5 + r2 * (1.0 / 24 + r2 * (-1.0 / 720 + r2 * (1.0 / 40320 + r2 * (-1.0 / 3628800 + r2 * (1.0 / 479001600))))));
    const int k = ((int)q) & 3;
    s = (float)(k == 0 ? sp : k == 1 ? cp : k == 2 ? -sp : -cp); c = (float)(k == 0 ? cp : k == 1 ? -sp : k == 2 ? -cp : sp);
}
__device__ __forceinline__ void p0_prologue(Frame& F, const Args& a) {
    unsigned char* ws = a.ws;
    LAS float* scr = (LAS float*)(F.lds + RING_OFF + F.wave * 16384);
    const int gw = F.vcu * NWAVES + F.wave, NGW = F.G * NWAVES;
    constexpr int I0 = 16 * 128, I1 = 16 * 32, I2 = 16 * 48, I3 = 4 * 48, I4 = 2 * 64, I5 = 16 * 32, NITEMS = I0 + I1 + I2 + I3 + I4 + I5;
    for (int it = gw; it < NITEMS; it += NGW) {
        int r = it;
        if (r < I0) { p0_wt_item(a.in[7], 1024, 4096, a.in[5], 1.f, 0, (bf16*)(ws + WS_W1T), scr, r, 128, F.lane); continue; } r -= I0;
        if (r < I1) { p0_wt_item(a.in[9], 1024, 1024, nullptr, 1.f, 1, (bf16*)(ws + WS_W2T), scr, r, 32, F.lane); continue; } r -= I1;
        if (r < I2) { p0_wt_item(a.in[10], 1024, 1440, a.in[5] + 1024, 1.f, 2, (bf16*)(ws + WS_W3T), scr, r, 48, F.lane); continue; } r -= I2;
        if (r < I3) { p0_wt_item(a.in[12], 256, 1536, a.in[11], C2, 3, (bf16*)(ws + WS_W4T), scr, r, 48, F.lane); continue; } r -= I3;
        if (r < I4) { p0_wt_item(a.in[14], 128, 2048, nullptr, 1.f, 4, (bf16*)(ws + WS_W5T), scr, r, 64, F.lane); continue; } r -= I4;
        p0_wt_item(a.in[15], 1024, 1024, nullptr, 1.f, 5, (bf16*)(ws + WS_W6T), scr, r, 32, F.lane);
    }
    { bf16* xb = (bf16*)(ws + WS_A); float* rs0 = (float*)(ws + WS_RS0);
      for (int m = gw; m < MT; m += NGW) {
        const float* xrow = m < MP ? a.in[0] + (size_t)m * DM : a.in[1] + (size_t)(m - MP) * DM;
        const GAS f32x4* xr = (const GAS f32x4*)xrow + F.lane; f32x4 v[4]; float s = 0.f;
#pragma unroll
        for (int j = 0; j < 4; ++j) { v[j] = __builtin_nontemporal_load(xr + 64 * j); s += (v[j].x * v[j].x + v[j].y * v[j].y) + (v[j].z * v[j].z + v[j].w * v[j].w); }
        s = wave_sum(s);
        const float rms = sqrtf(s * (1.0f / DM) + EPS), rn = 1.0f / rms;
        if (F.lane == 0) rs0[m] = rms;
        GAS v2u* o8 = (GAS v2u*)(xb + (size_t)m * DM) + F.lane;
#pragma unroll
        for (int j = 0; j < 4; ++j) { v2u w; w.x = pk2(v[j].x * rn, v[j].y * rn); w.y = pk2(v[j].z * rn, v[j].w * rn); o8[64 * j] = w; }
      } }
    { const long gt = (long)F.vcu * (NWAVES * 64) + F.tid, NT_ = (long)F.G * NWAVES * 64;
      { unsigned* xs = (unsigned*)(ws + WS_SSQ2); for (long i = gt; i < 130 * 4 * 256; i += NT_) xs[i] = 0xFFFFFFFFu; }
      bf16* ckva = (bf16*)(ws + WS_CKVA) + (size_t)MP * KVL; const float* cc = a.in[3];
      bf16* krs = (bf16*)(ws + WS_KRS); const float* ck = a.in[4];
      constexpr long NCC = (long)SB * PAST * KVL / 8, NCK = (long)SB * PAST * DR / 8;
      bool first = true;
      for (long base = gt; base < NCC; base += 4 * NT_) {
          f32x4 cv[4][2], kv[2]; const bool dok = first && gt < NCK;
#pragma unroll
          for (int k = 0; k < 4; ++k) { const long i = base + k * NT_; if (i < NCC) { cv[k][0] = __builtin_nontemporal_load((const f32x4*)(cc + i * 8)); cv[k][1] = __builtin_nontemporal_load((const f32x4*)(cc + i * 8 + 4)); } }
          if (dok) { kv[0] = __builtin_nontemporal_load((const f32x4*)(ck + gt * 8)); kv[1] = __builtin_nontemporal_load((const f32x4*)(ck + gt * 8 + 4)); }
          if (first) { float* tab = (float*)(ws + WS_ROPE);
              for (long i = gt; i < 8192L * 16; i += NT_) { const int pos = (int)(i >> 4), k = (int)(i & 15);
                  const float inv = 1.0f / powf(10000.0f, (float)(2 * k) * (1.0f / 32.0f)); const float ang = (float)pos * inv; float s, c; sincos_tab(ang, s, c);
                  tab[pos * 32 + k] = c; tab[pos * 32 + 16 + k] = s; } }
#pragma unroll
          for (int k = 0; k < 4; ++k) { const long i = base + k * NT_; if (i < NCC) { const f32x4 x0 = cv[k][0], x1 = cv[k][1];
              v4u w; w.x = pk2(x0.x, x0.y); w.y = pk2(x0.z, x0.w); w.z = pk2(x1.x, x1.y); w.w = pk2(x1.z, x1.w); *(v4u*)(ckva + i * 8) = w; } }
          if (dok) { const long i = gt, row = i >> 2; const int c8 = (int)(i & 3); const long b = row >> 12, s = row & (PAST - 1); const f32x4 x0 = kv[0], x1 = kv[1];
              v4u w; w.x = pk2(x0.x, x0.y); w.y = pk2(x0.z, x0.w); w.z = pk2(x1.x, x1.y); w.w = pk2(x1.z, x1.w); *(v4u*)(krs + ((b * (SKVP / 64) + (s >> 6)) * 4 + c8) * 512 + (s & 63) * 8) = w; }
          first = false;
      }
      for (long i = gt + NT_; i < NCK; i += NT_) { const long row = i >> 2; const int c8 = (int)(i & 3); const long b = row >> 12, s = row & (PAST - 1);
          const f32x4 x0 = __builtin_nontemporal_load((const f32x4*)(ck + i * 8)), x1 = __builtin_nontemporal_load((const f32x4*)(ck + i * 8 + 4));
          v4u w; w.x = pk2(x0.x, x0.y); w.y = pk2(x0.z, x0.w); w.z = pk2(x1.x, x1.y); w.w = pk2(x1.z, x1.w); *(v4u*)(krs + ((b * (SKVP / 64) + (s >> 6)) * 4 + c8) * 512 + (s & 63) * 8) = w; }
      bf16* Ks = (bf16*)(ws + WS_K) + KP_ELEMS; bf16* Vs = (bf16*)(ws + WS_V) + KP_ELEMS; const v4u z4 = {0u, 0u, 0u, 0u};
      for (long i = gt; i < (long)SB * NH * 512; i += NT_) { const long bh = i >> 9, r = i & 511;
          *(v4u*)(Ks + (bh * (SKVP / 64) + 65) * 4096 + r * 8) = z4; *(v4u*)(Vs + (bh * (SKVP / 64) + 65) * 4096 + r * 8) = z4; }
      for (long i = gt; i < (long)SB * 256; i += NT_) { const long b = i >> 8, r = i & 255; *(v4u*)(krs + (b * (SKVP / 64) + 65) * 2048 + r * 8) = z4; }
    }
}
__device__ __forceinline__ void p2_fixup(Frame& F, const Args& a) {
    unsigned char* ws = a.ws;
    const float* whead = (const float*)(ws + WS_WHEAD); const float* pchead = (const float*)(ws + WS_PCHEAD); const float* utail = (const float*)(ws + WS_UTAIL);
    const float* cw = a.in[8]; const float* st = a.in[2]; bf16* g = (bf16*)(ws + WS_B);
    const long gt = (long)F.vcu * (NWAVES * 64) + F.tid, NT_ = (long)F.G * NWAVES * 64;
    for (long i = gt; i < (long)NCHUNK * 256; i += NT_) { const int c = (int)(i >> 8), ch = (int)(i & 255) * 4;
        f32x4 p1, p2;
        if (c < MP / 64) { if ((c & 127) == 0) { p1 = (f32x4){0.f, 0.f, 0.f, 0.f}; p2 = p1; } else { p1 = *(const f32x4*)(utail + (size_t)((c - 1) * 2 + 1) * DM + ch); p2 = *(const f32x4*)(utail + (size_t)((c - 1) * 2) * DM + ch); } }
        else { const int b = c - MP / 64; p1 = *(const f32x4*)(st + (size_t)(b * 2 + 1) * DM + ch); p2 = *(const f32x4*)(st + (size_t)(b * 2) * DM + ch); }
        const f32x4 cw0 = *(const f32x4*)(cw + ch), cw1 = *(const f32x4*)(cw + DM + ch);
        const f32x4 w0 = *(const f32x4*)(whead + (size_t)(c * 2) * DM + ch), w1 = *(const f32x4*)(whead + (size_t)(c * 2 + 1) * DM + ch);
        const f32x4 q0 = *(const f32x4*)(pchead + (size_t)(c * 2) * DM + ch), q1 = *(const f32x4*)(pchead + (size_t)(c * 2 + 1) * DM + ch);
        const f32x4 g0 = w0 * (q0 + cw1 * p1 + cw0 * p2), g1 = w1 * (q1 + cw0 * p1);
        v2u o0, o1; o0.x = pk2(g0.x, g0.y); o0.y = pk2(g0.z, g0.w); o1.x = pk2(g1.x, g1.y); o1.y = pk2(g1.z, g1.w);
        *(v2u*)(g + (size_t)(c * 64) * DM + ch) = o0; *(v2u*)(g + (size_t)(c * 64 + 1) * DM + ch) = o1;
    }
    for (long i = gt; i < (long)(NB + SB) * 2 * 256; i += NT_) { const int sidx = (int)(i >> 9), j = (int)(i >> 8) & 1, ch = (int)(i & 255) * 4;
        const int c = sidx < NB ? 128 * (sidx + 1) - 1 : MP / 64 + (sidx - NB);
        const f32x4 v = *(const f32x4*)(utail + (size_t)(c * 2 + j) * DM + ch);
        float* o = a.out + (sidx < NB ? O_CONVP + (size_t)(sidx * 2 + j) * DM : O_CONVS + (size_t)((sidx - NB) * 2 + j) * DM) + ch;
        *(f32x4*)o = v; }
}
__device__ __forceinline__ void p8_final(Frame& F, const Args& a) {
    const float* ssq2 = (const float*)(a.ws + WS_SSQ2); const float* gf = a.in[6]; const bf16* x2 = (const bf16*)(a.ws + WS_K);
    const int gw = F.vcu * NWAVES + F.wave, NGW = F.G * NWAVES;
    int ln = threadIdx.x; asm volatile("" : "+v"(ln)); ln &= 63;
    f32x4 gv[4];
#pragma unroll
    for (int j = 0; j < 2; ++j) { gv[2 * j] = *(const f32x4*)(gf + 512 * j + 8 * ln); gv[2 * j + 1] = *(const f32x4*)(gf + 512 * j + 8 * ln + 4); }
    for (int m = gw; m < MT; m += NGW) {
        const float rs = 1.0f / sqrtf(pg8::sum16(ssq2 + (size_t)m * 16) * (1.0f / DM) + EPS);
        const v4u x0 = __builtin_nontemporal_load((const v4u*)(x2 + (size_t)m * DM + 8 * ln)), x1 = __builtin_nontemporal_load((const v4u*)(x2 + (size_t)m * DM + 512 + 8 * ln));
        float* yr = a.out + (size_t)m * DM + 8 * ln;
        f32x4 v;
        v = (f32x4){__uint_as_float(x0.x << 16), __uint_as_float(x0.x & 0xffff0000u), __uint_as_float(x0.y << 16), __uint_as_float(x0.y & 0xffff0000u)}; *(f32x4*)yr = v * rs * gv[0];
        v = (f32x4){__uint_as_float(x0.z << 16), __uint_as_float(x0.z & 0xffff0000u), __uint_as_float(x0.w << 16), __uint_as_float(x0.w & 0xffff0000u)}; *(f32x4*)(yr + 4) = v * rs * gv[1];
        v = (f32x4){__uint_as_float(x1.x << 16), __uint_as_float(x1.x & 0xffff0000u), __uint_as_float(x1.y << 16), __uint_as_float(x1.y & 0xffff0000u)}; *(f32x4*)(yr + 512) = v * rs * gv[2];
        v = (f32x4){__uint_as_float(x1.z << 16), __uint_as_float(x1.z & 0xffff0000u), __uint_as_float(x1.w << 16), __uint_as_float(x1.w & 0xffff0000u)}; *(f32x4*)(yr + 516) = v * rs * gv[3];
    }
}
__device__ __forceinline__ void p6_attention(Frame& F, const Args& a, char* lds, const bool dry) {
    unsigned char* ws = a.ws;
    const bf16* Qp = (const bf16*)a.out; const bf16* Qs = Qp + QP_ELEMS; const bf16* Kp = (const bf16*)(ws + WS_K); const bf16* Ks = Kp + KP_ELEMS;
    const bf16* Vp = (const bf16*)(ws + WS_V); const bf16* Vs = Vp + KP_ELEMS; const bf16* krp = (const bf16*)(ws + WS_KRP); const bf16* krs = (const bf16*)(ws + WS_KRS);
    bf16* sz = (bf16*)(ws + WS_B);
    int nun, typeA = 0, grp = 0, s = 0; unsigned long long tab = 0;
    if (F.G == 256) { grp = F.vcu >> 3; const int j = F.vcu & 7; s = j & 3; typeA = j < 4; nun = typeA ? 9 : 8;
        tab = j == 0 ? 0x00720d41561eull : j == 1 ? 0x827a2dc35e3eull : j == 2 ? 0x08528c45465cull : j == 3 ? 0x8a5aacc74e7cull : j == 4 ? 0x04624f49769full : j == 5 ? 0x866a6fcb7ebfull : j == 6 ? 0x0c42ce4d66ddull : 0x8e4aeecf6efdull; }
    else nun = (64 * 32 + 128 - F.vcu + F.G - 1) / F.G;
#define UDESC(i, smp, idx, qb) do { \
        if (F.G == 256) { smp = typeA && (i) == 8; const unsigned e_ = (unsigned)(tab >> (6 * ((i) & 7))) & 63u; qb = (int)(e_ & 31u); idx = smp ? grp * 4 + s : 2 * grp + (int)(e_ >> 5); \
        } else { const int u_ = F.vcu + (i) * F.G; smp = u_ >= 2048; idx = smp ? u_ - 2048 : (u_ >> 5); qb = 31 - (u_ & 31); } } while (0)
#define UPTRS(smp, idx, K_, V_, R_) do { const int b__ = (idx) >> 4; K_ = smp ? Ks + (size_t)(idx) * SKVP * DN : Kp + (size_t)(idx) * SEQ * DN; V_ = smp ? Vs + (size_t)(idx) * SKVP * DV : Vp + (size_t)(idx) * SEQ * DV; \
        R_ = smp ? krs + (size_t)b__ * SKVP * DR : krp + (size_t)b__ * SEQ * DR; } while (0)
    for (int i = 0; i < nun; ++i) {
        bool smp; int idx, qb = 0; UDESC(i, smp, idx, qb);
        const int b_ = idx >> 4, h_ = idx & 15;
        const bf16* Qb = smp ? Qs + (size_t)idx * ST * DQK : Qp + ((size_t)idx * SEQ + 256 * qb) * DQK;
        const bf16 *Kh, *Vh, *KRh, *KhN = nullptr, *VhN = nullptr, *KRhN = nullptr, *QbN = nullptr; bool smpn = false; UPTRS(smp, idx, Kh, Vh, KRh);
        if (i + 1 < nun) { int idxn, qbn = 0; UDESC(i + 1, smpn, idxn, qbn); UPTRS(smpn, idxn, KhN, VhN, KRhN); QbN = smpn ? Qs + (size_t)idxn * ST * DQK : Qp + ((size_t)idxn * SEQ + 256 * qbn) * DQK; }
        bf16* Gp = sz + (smp ? ((size_t)MP + b_ * ST) * DM : ((size_t)b_ * SEQ + 256 * qb) * DM) + h_ * 64;
        att::attn_unit(smp, dry, i > 0, Qb, Kh, Vh, KRh, KhN, VhN, KRhN, QbN, smpn, Gp, smp ? 66 : 4 * qb + 4, smp ? 64 : 4 * qb, lds);
    }
#undef UDESC
#undef UPTRS
}

constexpr int PER_PHASE = 9;
constexpr int N_LAUNCHES = MK_N_LAUNCHES;
static_assert(N_LAUNCHES == 1 || N_LAUNCHES == PER_PHASE, "MK_N_LAUNCHES is 1 or 9");
constexpr int CW_BAR = 4096, CW_SPLIT = 8192;
#ifndef PROBE_DUP
#define PROBE_DUP 0
#endif
#define DUP(k) (((PROBE_DUP) >> (k)) & 1)

__global__ void __launch_bounds__(NWAVES * 64, 2) mk_fwd(Args args) {
    extern __shared__ __attribute__((aligned(16))) unsigned char lds[];
    Frame F;
    F.lds = (LAS unsigned char*)lds;
    F.MISC = (volatile LAS unsigned*)(F.lds + MISC_OFF);
    F.tid = threadIdx.x; F.lane = F.tid & 63; F.wave = __builtin_amdgcn_readfirstlane(F.tid >> 6);
    F.G = gridDim.x; { const int bx = blockIdx.x; F.vcu = (F.G % 8 == 0) ? (bx % 8) * (F.G / 8) + bx / 8 : bx; }
    unsigned char* ws = args.ws;
    F.ctl = (gu32*)(ws + WS_CTL);
    for (int u = F.tid; u < (LDS_BYTES - LDSCTL_OFF) / 4; u += NWAVES * 64) ((LAS unsigned*)(F.lds + LDSCTL_OFF))[u] = 0u;
    __syncthreads();
    XcdBarrier bar; bar.bar = (unsigned*)(F.ctl + CW_BAR); bar.x = 0; bar.st = nullptr;
    if (N_LAUNCHES == 1) bar = xcd_barrier_post((unsigned*)(F.ctl + CW_BAR), F.MISC + 8);
#define GRID_BAR() do { if (N_LAUNCHES == 1) xcd_barrier(bar); } while (0)
#define KV_CACHED(U0, N) do { pg8::Gemm g{(const pg8::bf16_t*)(ws + WS_CKVA), (const pg8::bf16_t*)(ws + WS_W5T), MKV, 2048, 128}; pg8::CachedOrder S{(U0), (N)}; \
        pg8::EpiKV E{(const float*)(ws + WS_SSQKV), (pg8::bf16_t*)(ws + WS_K), (pg8::bf16_t*)(ws + WS_V), args.out, 0}; \
        pg8::gemm_phase<pg8::EpiKV, pg8::CachedOrder, true, true>(F.lds + RING_OFF, g, S, E); } while (0)
    const bool tails = (F.G == 256);
    const bool split = tails && N_LAUNCHES == 1;
#define SPLIT_TAIL(EPI, E_, A_, B_, N_, PM_, PN_, TU_, SL_, SCR_, K_) do { \
        pg8::Gemm gs{(const pg8::bf16_t*)(A_) + (SL_) * 128, (const pg8::bf16_t*)(B_) + (SL_) * 128, MT, (N_), 1024, 2}; pg8::OneUnit O1{(PM_), (PN_), 1}; \
        pg8::EpiSplit<EPI> ES{E_, (float*)(SCR_), (unsigned*)(F.ctl + CW_SPLIT + 256 * (K_)), (TU_), (SL_)}; \
        pg8::gemm_phase<pg8::EpiSplit<EPI>, pg8::OneUnit, true, true>(F.lds + RING_OFF, gs, O1, ES); } while (0)
    const int lo = args.ph_lo, hi = args.ph_hi;
#define IN(k) (lo <= (k) && (k) < hi)
#define BOTH(k) (IN(k) && IN((k) + 1))
    const int bx = (int)blockIdx.x;

    if (IN(0)) { for (int rep = 0; rep <= DUP(0); ++rep) { p0_prologue(F, args); if (BOTH(0)) GRID_BAR(); } }
    if (IN(1)) for (int rep = 0; rep <= DUP(1); ++rep) {
        pg8::Gemm g{(const pg8::bf16_t*)(ws + WS_A), (const pg8::bf16_t*)(ws + WS_W1T), MT, 4096, 1024}; pg8::StaticOrder S; S.init(MT, 4096, F.G, bx);
        { LAS f32x4* cwl = (LAS f32x4*)(F.lds + RING_OFF + pg8::STAGE_BYTES); const f32x4* cwg = (const f32x4*)args.in[8];
          for (int i = F.tid; i < 3 * DM / 4; i += NWAVES * 64) cwl[i] = cwg[i]; __syncthreads(); }
        pg8::EpiConvIn E{(PG8_LAS const float*)(F.lds + RING_OFF + pg8::STAGE_BYTES), (pg8::bf16_t*)(ws + WS_B), (float*)(ws + WS_WHEAD), (float*)(ws + WS_PCHEAD), (float*)(ws + WS_UTAIL)};
        pg8::gemm_phase<pg8::EpiConvIn, pg8::StaticOrder, true, true>(F.lds + RING_OFF, g, S, E);
        if (tails && rep == 0 && bx >= 32) { if (!split) KV_CACHED(bx - 32, 1); else if (bx < 128) KV_CACHED(2 * (bx - 32), 2); else KV_CACHED(192 + (bx - 128), 1); }
        if (BOTH(1)) GRID_BAR();
    }
    if (IN(2)) { for (int rep = 0; rep <= DUP(2); ++rep) { p2_fixup(F, args); if (BOTH(2)) GRID_BAR(); } }
    if (IN(3)) for (int rep = 0; rep <= DUP(3); ++rep) {
        pg8::Gemm g{(const pg8::bf16_t*)(ws + WS_B), (const pg8::bf16_t*)(ws + WS_W2T), MT, 1024, 1024}; pg8::StaticOrder S; S.init(MT, 1024, F.G, bx);
        pg8::EpiResid E{(const pg8::bf16_t*)(ws + WS_A), (pg8::bf16_t*)(ws + WS_A), (float*)(ws + WS_SSQ1), (const float*)(ws + WS_RS0)};
        if (split) S.lim = 512;
        pg8::gemm_phase<pg8::EpiResid, pg8::StaticOrder, true, true>(F.lds + RING_OFF, g, S, E);
        if (split) { if (bx < 64) { pg8::Unit tv; S.unit_of(512 + (bx >> 3), tv); SPLIT_TAIL(pg8::EpiResid, E, ws + WS_B, ws + WS_W2T, 1024, tv.pm, tv.pn, bx >> 3, bx & 7, args.out, 0); }
                     else if (rep == 0) KV_CACHED(320 + 2 * (bx - 64), 2); }
        else if (tails && rep == 0 && bx >= 8) KV_CACHED(224 + 2 * (bx - 8), 2);
        if (BOTH(3)) GRID_BAR();
    }
    if (IN(4)) for (int rep = 0; rep <= DUP(4); ++rep) {
        pg8::Gemm g{(const pg8::bf16_t*)(ws + WS_A), (const pg8::bf16_t*)(ws + WS_W3T), MT, 1536, 1024}; pg8::StaticOrder S; S.init(MT, 1536, F.G, bx);
        pg8::EpiMlaIn E{(const float*)(ws + WS_SSQ1), args.in[13], (const float*)(ws + WS_ROPE), (pg8::bf16_t*)(ws + WS_QLAT), (pg8::bf16_t*)(ws + WS_CKVA), (pg8::bf16_t*)(ws + WS_KRP),
                        (pg8::bf16_t*)(ws + WS_KRS), (pg8::bf16_t*)(ws + WS_B), args.out, (float*)(ws + WS_SSQKV), (PG8_LAS float*)(F.lds + RING_OFF + pg8::STAGE_BYTES)};
        if (split) S.lim = 768;
        pg8::gemm_phase<pg8::EpiMlaIn, pg8::StaticOrder, true, true>(F.lds + RING_OFF, g, S, E);
        if (split) { if (bx < 96) { pg8::Unit tv; S.unit_of(768 + (bx >> 3), tv); SPLIT_TAIL(pg8::EpiMlaIn, E, ws + WS_A, ws + WS_W3T, 1536, tv.pm, tv.pn, bx >> 3, bx & 7, args.out + (size_t)4 * 1024 * 1024, 1); }
                     else if (rep == 0) KV_CACHED(704 + 2 * (bx - 96), 2); }
        else if (tails && rep == 0 && bx >= 12) { if (bx < 72) KV_CACHED(720 + 2 * (bx - 12), 2); else KV_CACHED(840 + (bx - 72), 1); }
        if (BOTH(4)) GRID_BAR();
    }
#define P5A() { pg8::Gemm g{(const pg8::bf16_t*)(ws + WS_QLAT), (const pg8::bf16_t*)(ws + WS_W4T), MT, 1536, 256}; pg8::StaticOrder S; S.init(MT, 1536, F.G, bx); \
          pg8::EpiQ E{(const float*)(ws + WS_SSQQ), (const float*)(ws + WS_ROPE), (pg8::bf16_t*)args.out, (pg8::bf16_t*)args.out + QP_ELEMS}; \
          pg8::gemm_phase<pg8::EpiQ, pg8::StaticOrder, true, true>(F.lds + RING_OFF, g, S, E); }
#define P5B(FIX) { pg8::Gemm g{(const pg8::bf16_t*)(ws + WS_CKVA), (const pg8::bf16_t*)(ws + WS_W5T), MKV, 2048, 128}; \
          pg8::EpiKV E{(const float*)(ws + WS_SSQKV), (pg8::bf16_t*)(ws + WS_K), (pg8::bf16_t*)(ws + WS_V), args.out, FIX}; \
          if (tails) { pg8::KvOrder S; S.init(130 * 256, 2048, F.G, bx); pg8::gemm_phase<pg8::EpiKV, pg8::KvOrder, true, true>(F.lds + RING_OFF, g, S, E); } \
          else { pg8::StaticOrder S; S.init(MKV, 2048, F.G, bx); pg8::gemm_phase<pg8::EpiKV, pg8::StaticOrder, true, true>(F.lds + RING_OFF, g, S, E); } }
    if (IN(5)) {
#if (PROBE_DUP) & 32
        P5A(); GRID_BAR();
#endif
#if (PROBE_DUP) & 512
        P5B(0); GRID_BAR();
#endif
        P5A(); P5B(0);
        if (BOTH(5)) GRID_BAR();
    }
    if (IN(6)) { for (int rep = 0; rep <= DUP(6); ++rep) { p6_attention(F, args, (char*)lds + RING_OFF, rep < DUP(6)); if (BOTH(6)) GRID_BAR(); } }
    const bool fuse78 = tails && N_LAUNCHES == 1 && IN(7) && IN(8);
    if (fuse78) {
        pg8::Gemm g{(const pg8::bf16_t*)(ws + WS_B), (const pg8::bf16_t*)(ws + WS_W6T), MT, 1024, 1024}; pg8::PanelOrder S{bx, split ? 128 : 130};
        pg8::EpiResidNorm E{(const pg8::bf16_t*)(ws + WS_A), args.out, args.in[6], (float*)(ws + WS_SSQ2), (PG8_LAS float*)(F.lds + RING_OFF + pg8::STAGE_BYTES)};
        pg8::gemm_phase<pg8::EpiResidNorm, pg8::PanelOrder, true, true>(F.lds + RING_OFF, g, S, E);
        if (split && bx < 64) SPLIT_TAIL(pg8::EpiResidNorm, E, ws + WS_B, ws + WS_W6T, 1024, 128 + (bx >> 5), (bx >> 3) & 3, bx >> 3, bx & 7, ws + WS_K, 2);
    }
    if (IN(7) && !fuse78) for (int rep = 0; rep <= DUP(7); ++rep) {
        pg8::Gemm g{(const pg8::bf16_t*)(ws + WS_B), (const pg8::bf16_t*)(ws + WS_W6T), MT, 1024, 1024}; pg8::StaticOrder S; S.init(MT, 1024, F.G, bx);
        pg8::EpiResid E{(const pg8::bf16_t*)(ws + WS_A), (pg8::bf16_t*)(ws + WS_K), (float*)(ws + WS_SSQ2), nullptr};
        pg8::gemm_phase<pg8::EpiResid, pg8::StaticOrder, true, true>(F.lds + RING_OFF, g, S, E);
        if (BOTH(7)) GRID_BAR();
    }
    if (IN(8) && !fuse78) { p8_final(F, args); }
#undef IN
#undef BOTH
#undef GRID_BAR
}

extern "C" void kernel_launch(void* const* d_in, const int* in_sizes, int n_in, void* d_out, int out_size, void* d_ws, size_t ws_size, hipStream_t stream) {
    static int grid = 0;
    if (grid == 0) {
        if (n_in != 16 || in_sizes[0] != MP * DM || in_sizes[1] != MS * DM || (size_t)out_size != O_END || ws_size < WS_END) {
            fprintf(stderr, "kernel_launch: shape mismatch: n_in %d in0 %d in1 %d out %d ws %zu (need >= %zu)\n", n_in, n_in > 0 ? in_sizes[0] : -1, n_in > 1 ? in_sizes[1] : -1, out_size, ws_size, (size_t)WS_END); grid = -1; return; }
        int dev = 0, cus = 0, per_cu = 0;
        if (hipGetDevice(&dev) != hipSuccess || hipDeviceGetAttribute(&cus, hipDeviceAttributeMultiprocessorCount, dev) != hipSuccess) { fprintf(stderr, "kernel_launch: device query failed\n"); grid = -1; return; }
        if (hipFuncSetAttribute((const void*)mk_fwd, hipFuncAttributeMaxDynamicSharedMemorySize, LDS_BYTES) != hipSuccess) { fprintf(stderr, "kernel_launch: hipFuncSetAttribute failed\n"); grid = -1; return; }
        if (hipOccupancyMaxActiveBlocksPerMultiprocessor(&per_cu, (const void*)mk_fwd, NWAVES * 64, LDS_BYTES) != hipSuccess || per_cu < 1) { fprintf(stderr, "kernel_launch: occupancy query says %d blocks per CU\n", per_cu); per_cu = 1; }
        (void)hipGetLastError();
        grid = cus;
        fprintf(stderr, "kernel_launch: grid %d (occupancy %d per CU)\n", grid, per_cu);
    }
    if (grid < 0) return;
    if (hipMemsetAsync((char*)d_ws + WS_CTL, 0, CTL_ZERO_BYTES, stream) != hipSuccess) { fprintf(stderr, "kernel_launch: memset failed\n"); return; }
    Args a{};
    for (int i = 0; i < 16; ++i) a.in[i] = (const float*)d_in[i];
    a.out = (float*)d_out; a.ws = (unsigned char*)d_ws;
    if (N_LAUNCHES == 1) {
        a.ph_lo = 0; a.ph_hi = PER_PHASE; a.li = 0;
        void* kargs[] = {&a};
        const hipError_t le = hipLaunchCooperativeKernel((const void*)mk_fwd, dim3(grid), dim3(NWAVES * 64), kargs, LDS_BYTES, stream);
        if (le != hipSuccess) fprintf(stderr, "kernel_launch: cooperative launch failed: %s (grid %d)\n", hipGetErrorName(le), grid);
    } else {
        for (int li = 0; li < PER_PHASE; ++li) {
            a.ph_lo = li; a.ph_hi = li + 1; a.li = li;
            hipLaunchKernelGGL(mk_fwd, dim3(grid), dim3(NWAVES * 64), LDS_BYTES, stream, a);
            const hipError_t le = hipPeekAtLastError();
            if (le != hipSuccess) { fprintf(stderr, "kernel_launch: launch %d failed: %s\n", li, hipGetErrorName(le)); break; }
        }
    }
}
```

```cpp
#include <hip/hip_runtime.h>
#include <hip/hip_bf16.h>
#include <cstdio>
#include <cstdint>
#include <cmath>

#ifndef MK_N_LAUNCHES
#define MK_N_LAUNCHES 1
#endif

constexpr int DM = 1024, SEQ = 8192, NB = 4, MP = NB * SEQ, SB = 8, ST = 64, MS = SB * ST, MT = MP + MS;
constexpr int PAST = 4096, SKV = PAST + ST, SKVP = 4224;
constexpr int NH = 16, DN = 64, DR = 32, DQK = 96, DV = 64, QL = 256, KVL = 128;
constexpr int MKV = MP + SB * PAST + MS;
constexpr int NCHUNK = MT / 64;
constexpr float EPS = 1e-6f;
constexpr float LOG2E = 1.4426950408889634f;
constexpr float C2 = 0.10206207261596577f * 1.4426950408889634f;
constexpr size_t O_YP = 0, O_YS = (size_t)MP * DM, O_CONVP = O_YS + (size_t)MS * DM, O_CKVP = O_CONVP + NB * 2 * DM, O_KRP = O_CKVP + (size_t)MP * KVL,
                 O_CONVS = O_KRP + (size_t)MP * DR, O_CKVS = O_CONVS + SB * 2 * DM, O_KRS = O_CKVS + (size_t)MS * KVL, O_END = O_KRS + (size_t)MS * DR;
static_assert(O_END == 39428096, "output size");

constexpr size_t MiB = 1u << 20;
constexpr size_t al256(size_t x) { return (x + 255) & ~(size_t)255; }
constexpr size_t WS_CTL = 0, CTL_ZERO_BYTES = 1 * MiB;
constexpr size_t WS_W1T = CTL_ZERO_BYTES;
constexpr size_t WS_W2T = WS_W1T + (size_t)4096 * 1024 * 2;
constexpr size_t WS_W3T = WS_W2T + (size_t)1024 * 1024 * 2;
constexpr size_t WS_W4T = WS_W3T + (size_t)1536 * 1024 * 2;
constexpr size_t WS_W5T = WS_W4T + (size_t)1536 * 256 * 2;
constexpr size_t WS_W6T = WS_W5T + (size_t)2048 * 128 * 2;
constexpr size_t WS_ROPE = WS_W6T + (size_t)1024 * 1024 * 2;
constexpr size_t WS_RS0 = WS_ROPE + (size_t)8192 * 32 * 4;
constexpr size_t WS_SSQ1 = al256(WS_RS0 + (size_t)MT * 4);
constexpr size_t WS_SSQ2 = WS_SSQ1 + (size_t)MT * 16 * 4;
constexpr size_t WS_SSQQ = WS_SSQ2 + (size_t)MT * 16 * 4;
constexpr size_t WS_SSQKV = WS_SSQQ + (size_t)MT * 4 * 4;
constexpr size_t WS_WHEAD = WS_SSQKV + (size_t)MT * 4 * 4;
constexpr size_t WS_PCHEAD = WS_WHEAD + (size_t)NCHUNK * 2 * DM * 4;
constexpr size_t WS_UTAIL = WS_PCHEAD + (size_t)NCHUNK * 2 * DM * 4;
constexpr size_t WS_KRP = WS_UTAIL + (size_t)NCHUNK * 2 * DM * 4;
constexpr size_t WS_KRS = WS_KRP + (size_t)MP * DR * 2;
constexpr size_t WS_SMALL_END = WS_KRS + (size_t)SB * SKVP * DR * 2;
constexpr size_t WS_B = 40 * MiB;
constexpr size_t WS_A = WS_B + 65 * MiB;
constexpr size_t QP_ELEMS = (size_t)NB * NH * SEQ * DQK, QS_ELEMS = (size_t)SB * NH * ST * DQK;
static_assert((QP_ELEMS + QS_ELEMS) * 2 <= (size_t)MT * DM * 4, "Q fits in the y region of d_out");
constexpr size_t WS_QLAT = al256(WS_A + (QP_ELEMS + QS_ELEMS) * 2);
constexpr size_t WS_CKVA = WS_QLAT + (size_t)MT * QL * 2;
constexpr size_t KP_ELEMS = (size_t)NB * NH * SEQ * DN, KS_ELEMS = (size_t)SB * NH * SKVP * DN;
constexpr size_t WS_K = al256(WS_CKVA + (size_t)MKV * KVL * 2);
constexpr size_t WS_V = WS_K + (KP_ELEMS + KS_ELEMS) * 2;
constexpr size_t WS_END = WS_V + (KP_ELEMS + KS_ELEMS) * 2;
static_assert(WS_SMALL_END <= WS_B && (size_t)MT * DM * 2 <= 65 * MiB && WS_END <= 512 * MiB, "d_ws map");

namespace pg8 {
#define PG8_LAS __attribute__((address_space(3)))
typedef unsigned short bf16_t;
typedef short bf16x8 __attribute__((ext_vector_type(8)));
typedef float f32x4 __attribute__((ext_vector_type(4)));
typedef unsigned u32x4 __attribute__((ext_vector_type(4)));
constexpr int BM = 256, BK = 64, HALF = 128, HTB = HALF * BK * 2  , STAGE_BYTES = 8 * HTB, NXCD = 8, WGM = 8;

__host__ __device__ __forceinline__ int lds_byte(int r, int c) { const int st = (r >> 4) * 2 + (c >> 5), rr = r & 15, cc = c & 31, ob = rr * 64 + cc * 2; return st * 1024 + (ob ^ (((ob >> 9) & 1) << 5)); }
__host__ __device__ __forceinline__ void stage_rc(int b, int& R, int& C) { const int st = b / 1024, sb = b % 1024, swz = sb ^ (((sb >> 9) & 1) << 5); R = (st >> 1) * 16 + swz / 64; C = (st & 1) * 32 + (swz % 64) / 2; }
__host__ __device__ __forceinline__ int perm32(int rho) { const int n = rho >> 4, i = rho & 15; return 8 * (i >> 2) + 4 * n + (i & 3); }

struct Unit { int pm, pn; };
struct Gemm { const bf16_t* A; const bf16_t* Bt; int M, N, K; int kt = 0; };

struct StaticOrder {
    int nM, nN, nwg, G, c, lim;
    __host__ __device__ __forceinline__ void init(int M, int N, int G_, int c_) { nM = M / BM; nN = N / BM; nwg = nM * nN; G = G_; c = c_; lim = nwg; }
    __host__ __device__ __forceinline__ bool next(int i, Unit& u) const { const long L = (long)i * G + c; if (L >= lim) return false; unit_of((int)L, u); return true; }
    __host__ __device__ __forceinline__ bool unit_of(int L, Unit& u) const {
        int wgid = L; { const int q = nwg / NXCD, r = nwg % NXCD, xcd = wgid % NXCD, off = wgid / NXCD; wgid = (xcd < r ? xcd * (q + 1) : r * (q + 1) + (xcd - r) * q) + off; }
        const int nig = WGM * nN, gid = wgid / nig, fm = gid * WGM, gsz = (nM - fm) < WGM ? (nM - fm) : WGM;
        u.pm = fm + ((wgid % nig) % gsz); u.pn = (wgid % nig) / gsz; return true;
    }
    __device__ __forceinline__ void a_ready(const Unit&) const {}
    __device__ __forceinline__ void done(const Unit&) const {}
};
struct OneUnit {
    int pm, pn, valid;
    __host__ __device__ __forceinline__ bool next(int i, Unit& u) const { if (i > 0 || !valid) return false; u.pm = pm; u.pn = pn; return true; }
    __device__ __forceinline__ void a_ready(const Unit&) const {}
    __device__ __forceinline__ void done(const Unit&) const {}
};
struct CachedOrder {
    int u0, n;
    __host__ __device__ __forceinline__ bool next(int i, Unit& u) const { if (i >= n) return false; const int x = u0 + i; u.pm = 128 + (x >> 3); u.pn = x & 7; return true; }
    __device__ __forceinline__ void a_ready(const Unit&) const {}
    __device__ __forceinline__ void done(const Unit&) const {}
};
struct KvOrder : StaticOrder {
    __host__ __device__ __forceinline__ bool next(int i, Unit& u) const { if (!StaticOrder::next(i, u)) return false; if (u.pm >= 128) u.pm += 128; return true; }
};
struct PanelOrder {
    int c, np;
    __host__ __device__ __forceinline__ bool next(int i, Unit& u) const { const int x = c & 7, s = c >> 3, p = 64 * i + 8 * x + (s >> 2); if (p >= np) return false; u.pm = p; u.pn = s & 3; return true; }
    __device__ __forceinline__ void a_ready(const Unit&) const {}
    __device__ __forceinline__ void done(const Unit&) const {}
};
typedef float f32x2 __attribute__((ext_vector_type(2)));
typedef unsigned u32x2 __attribute__((ext_vector_type(2)));
typedef __bf16 bf16x2_t __attribute__((ext_vector_type(2)));
__device__ __forceinline__ unsigned cvt_pk_bf16(float lo, float hi) { f32x2 v = {lo, hi}; bf16x2_t b = __builtin_convertvector(v, bf16x2_t); return __builtin_bit_cast(unsigned, b); }
__device__ __forceinline__ u32x2 pack4(const f32x4 v) { u32x2 w; w.x = cvt_pk_bf16(v[0], v[1]); w.y = cvt_pk_bf16(v[2], v[3]); return w; }
__device__ __forceinline__ u32x4 pack8(const f32x4 a, const f32x4 b) { u32x4 w; w.x = cvt_pk_bf16(a[0], a[1]); w.y = cvt_pk_bf16(a[2], a[3]); w.z = cvt_pk_bf16(b[0], b[1]); w.w = cvt_pk_bf16(b[2], b[3]); return w; }
__device__ __forceinline__ float dot4(const f32x4 v) { return (v[0] * v[0] + v[1] * v[1]) + (v[2] * v[2] + v[3] * v[3]); }
__device__ __forceinline__ float silu1(float z) { return z * __builtin_amdgcn_rcpf(1.0f + __builtin_amdgcn_exp2f(-z * LOG2E)); }
__device__ __forceinline__ float sum16(const float* p) { const f32x4 a = *(const f32x4*)p, b = *(const f32x4*)(p + 4), c = *(const f32x4*)(p + 8), d = *(const f32x4*)(p + 12);
    return (((a[0] + a[1]) + (a[2] + a[3])) + ((b[0] + b[1]) + (b[2] + b[3]))) + (((c[0] + c[1]) + (c[2] + c[3])) + ((d[0] + d[1]) + (d[2] + d[3]))); }
__device__ __forceinline__ float sum4(const float* p) { const f32x4 a = *(const f32x4*)p; return (a[0] + a[1]) + (a[2] + a[3]); }

struct EpiConvIn {
    static constexpr bool PERM = false, AFTER_DRAIN = false;
    PG8_LAS const float* convw; bf16_t* g; float* whead; float* pchead; float* utail;
    __device__ __forceinline__ void operator()(const f32x4 (&acc)[2][2][4][2], const Unit& u, int wr, int wc, int fr, int fq) const {
        asm volatile("" : "+v"(fr), "+v"(fq));
        const int lane = fq * 16 + fr, ch0 = u.pn * 64 + wc * 16 + fq * 4;
        const f32x4 cw0 = *(PG8_LAS const f32x4*)(convw + ch0), cw1 = *(PG8_LAS const f32x4*)(convw + DM + ch0), cw2 = *(PG8_LAS const f32x4*)(convw + 2 * DM + ch0);
        (void)lane;
#pragma unroll
        for (int ai = 0; ai < 2; ++ai) {
            const int rowc = u.pm * BM + ai * HALF + wr * 64, chunk = rowc >> 6;
            f32x4 r1p = (f32x4){0.f, 0.f, 0.f, 0.f}, r2p = r1p;
#pragma unroll
            for (int m = 0; m < 4; ++m) {
                const int row = rowc + m * 16 + fr;
                const f32x4 bg = acc[ai][0][m][0], cg = acc[ai][0][m][1], xv = acc[ai][1][m][0], z = acc[ai][1][m][1];
                const f32x4 uu = cg * xv; f32x4 w, p1, p2;
                f32x4 r1, r2;
#pragma unroll
                for (int e = 0; e < 4; ++e) { w[e] = silu1(z[e]) * bg[e];
                    r1[e] = __int_as_float(__builtin_amdgcn_update_dpp(0, __float_as_int(uu[e]), 0x121, 0xf, 0xf, false));
                    r2[e] = __int_as_float(__builtin_amdgcn_update_dpp(0, __float_as_int(uu[e]), 0x122, 0xf, 0xf, false));
                    p1[e] = fr >= 1 ? r1[e] : r1p[e]; p2[e] = fr >= 2 ? r2[e] : r2p[e]; }
                const f32x4 conv = cw2 * uu + cw1 * p1 + cw0 * p2;
                if (m == 0 && fr < 2) { *(f32x4*)(whead + (size_t)(chunk * 2 + fr) * DM + ch0) = w; *(f32x4*)(pchead + (size_t)(chunk * 2 + fr) * DM + ch0) = conv; }
                else { *(u32x2*)(g + (size_t)row * DM + ch0) = pack4(w * conv); }
                if (m == 3 && fr >= 14) *(f32x4*)(utail + (size_t)(chunk * 2 + fr - 14) * DM + ch0) = uu;
                r1p = r1; r2p = r2;
            }
        }
    }
};

struct EpiResid {
    static constexpr bool PERM = false, AFTER_DRAIN = false;
    const bf16_t* xin; bf16_t* xo; float* ssq; const float* rinv;
    __device__ __forceinline__ void operator()(const f32x4 (&acc)[2][2][4][2], const Unit& u, int wr, int wc, int fr, int fq, int only = -1) const {
        asm volatile("" : "+v"(fr), "+v"(fq));
        const unsigned col0 = (unsigned)(u.pn * BM + wc * 32 + 8 * fq), off0 = (unsigned)(u.pm * BM + wr * 64 + fr) * DM + col0;
#pragma unroll
        for (int ai = 0; ai < 2; ++ai) {
            u32x4 xi[4][2]; float riv[4];
#pragma unroll
            for (int m = 0; m < 4; ++m) { if (only >= 0 && only != ai * 4 + m) continue;
                riv[m] = rinv ? rinv[u.pm * BM + ai * HALF + wr * 64 + m * 16 + fr] : 1.f;
#pragma unroll
                for (int bj = 0; bj < 2; ++bj) xi[m][bj] = __builtin_nontemporal_load((const u32x4*)(xin + (off0 + (unsigned)((ai * HALF + m * 16) * DM + bj * HALF)))); }
#pragma unroll
            for (int m = 0; m < 4; ++m) { if (only >= 0 && only != ai * 4 + m) continue; const unsigned row = (unsigned)(u.pm * BM + ai * HALF + wr * 64 + m * 16 + fr), off = off0 + (unsigned)((ai * HALF + m * 16) * DM); float ss = 0.f; const float ri = riv[m];
#pragma unroll
                for (int bj = 0; bj < 2; ++bj) { const u32x4 x = xi[m][bj]; f32x4 a = acc[ai][bj][m][0], b = acc[ai][bj][m][1];
                    a[0] = fmaf(__uint_as_float(x.x << 16), ri, a[0]); a[1] = fmaf(__uint_as_float(x.x & 0xffff0000u), ri, a[1]); a[2] = fmaf(__uint_as_float(x.y << 16), ri, a[2]); a[3] = fmaf(__uint_as_float(x.y & 0xffff0000u), ri, a[3]);
                    b[0] = fmaf(__uint_as_float(x.z << 16), ri, b[0]); b[1] = fmaf(__uint_as_float(x.z & 0xffff0000u), ri, b[1]); b[2] = fmaf(__uint_as_float(x.w << 16), ri, b[2]); b[3] = fmaf(__uint_as_float(x.w & 0xffff0000u), ri, b[3]);
                    ss += dot4(a) + dot4(b); *(u32x4*)(xo + (off + bj * HALF)) = pack8(a, b); }
                ss += __shfl_xor(ss, 16); ss += __shfl_xor(ss, 32);
                if (fq == 0) ssq[row * 16u + u.pn * 4 + wc] = ss; }
        }
    }
};

struct EpiResidNorm {
    static constexpr bool PERM = false, AFTER_DRAIN = false;
    const bf16_t* xin; float* y; const float* gf; float* xs; PG8_LAS float* sc;
    __device__ __forceinline__ void operator()(f32x4 (&acc)[2][2][4][2], const Unit& u, int wr, int wc, int fr, int fq, int only = -1) const {
        asm volatile("" : "+v"(fr), "+v"(fq));
        const unsigned col0 = (unsigned)(u.pn * BM + wc * 32 + 8 * fq);
#pragma unroll
        for (int ai = 0; ai < 2; ++ai) {
            u32x4 xv[4][2];
#pragma unroll
            for (int m = 0; m < 4; ++m) { if (only >= 0 && only != ai * 4 + m) continue; const unsigned off = (unsigned)(u.pm * BM + ai * HALF + wr * 64 + m * 16 + fr) * DM + col0;
#pragma unroll
                for (int bj = 0; bj < 2; ++bj) xv[m][bj] = __builtin_nontemporal_load((const u32x4*)(xin + (off + bj * HALF))); }
#pragma unroll
            for (int m = 0; m < 4; ++m) { if (only >= 0 && only != ai * 4 + m) continue; const int rl = ai * HALF + wr * 64 + m * 16 + fr; float ss = 0.f;
#pragma unroll
                for (int bj = 0; bj < 2; ++bj) { const u32x4 xi = xv[m][bj]; f32x4 a = acc[ai][bj][m][0], b = acc[ai][bj][m][1];
                    a[0] += __uint_as_float(xi.x << 16); a[1] += __uint_as_float(xi.x & 0xffff0000u); a[2] += __uint_as_float(xi.y << 16); a[3] += __uint_as_float(xi.y & 0xffff0000u);
                    b[0] += __uint_as_float(xi.z << 16); b[1] += __uint_as_float(xi.z & 0xffff0000u); b[2] += __uint_as_float(xi.w << 16); b[3] += __uint_as_float(xi.w & 0xffff0000u);
                    ss += dot4(a) + dot4(b); acc[ai][bj][m][0] = a; acc[ai][bj][m][1] = b; }
                ss += __shfl_xor(ss, 16); ss += __shfl_xor(ss, 32);
                if (fq == 0) sc[rl * 4 + wc] = ss; }
        }
        const int t = (wr * 4 + wc) * 64 + fq * 16 + fr;
        asm volatile("s_waitcnt lgkmcnt(0)" ::: "memory"); __builtin_amdgcn_s_barrier();
        if (t < 256 && (only < 0 || only == ((t >> 7) * 4 + ((t >> 4) & 3)))) { const f32x4 q4 = *(const PG8_LAS f32x4*)(sc + t * 4);   const float mine = (q4[0] + q4[1]) + (q4[2] + q4[3]);
            float* sl = xs + ((unsigned)(u.pm * 4) * 256u + t);
            __hip_atomic_store(sl + u.pn * 256, mine, __ATOMIC_RELAXED, __HIP_MEMORY_SCOPE_AGENT);
            float v[4]; unsigned sp = 0; bool ok;
            do { ok = true;
#pragma unroll
                for (int q = 0; q < 4; ++q) v[q] = __hip_atomic_load(sl + q * 256, __ATOMIC_RELAXED, __HIP_MEMORY_SCOPE_AGENT);
#pragma unroll
                for (int q = 0; q < 4; ++q) ok = ok && (q == u.pn || __float_as_uint(v[q]) != 0xFFFFFFFFu);
            } while (!ok && ++sp < (1u << 20));
#pragma unroll
            for (int q = 0; q < 4; ++q) v[q] = (q == u.pn) ? mine : v[q];
            sc[1024 + t] = 1.0f / sqrtf(((v[0] + v[1]) + (v[2] + v[3])) * (1.0f / DM) + EPS); }
        asm volatile("s_waitcnt lgkmcnt(0)" ::: "memory"); __builtin_amdgcn_s_barrier();
#pragma unroll
        for (int ai = 0; ai < 2; ++ai)
#pragma unroll
            for (int m = 0; m < 4; ++m) { if (only >= 0 && only != ai * 4 + m) continue; const int rl = ai * HALF + wr * 64 + m * 16 + fr; const float rs = sc[1024 + rl]; float* yr = y + ((unsigned)(u.pm * BM + rl) * DM + col0);
#pragma unroll
                for (int bj = 0; bj < 2; ++bj) { const f32x4 g0 = *(const f32x4*)(gf + col0 + bj * HALF), g1 = *(const f32x4*)(gf + col0 + bj * HALF + 4);
                    *(f32x4*)(yr + bj * HALF) = acc[ai][bj][m][0] * rs * g0; *(f32x4*)(yr + bj * HALF + 4) = acc[ai][bj][m][1] * rs * g1; } }
        asm volatile("s_waitcnt lgkmcnt(0)" ::: "memory"); __builtin_amdgcn_s_barrier();
    }
};

struct EpiMlaIn {
    static constexpr bool PERM = false, AFTER_DRAIN = false;
    const float* ssq1; const float* gkv; const float* rope; bf16_t* qlat; bf16_t* ckva; bf16_t* krp; bf16_t* krs; bf16_t* sz; float* out; float* ssqkv; PG8_LAS float* sc;
    __device__ __forceinline__ void operator()(const f32x4 (&acc)[2][2][4][2], const Unit& u, int wr, int wc, int fr, int fq, int only = -1) const {
        asm volatile("" : "+v"(fr), "+v"(fq));
        float rsv[2][4];
        { f32x4 q4[2][4];
#pragma unroll
          for (int ai = 0; ai < 2; ++ai)
#pragma unroll
            for (int m = 0; m < 4; ++m) q4[ai][m] = *(const f32x4*)(ssq1 + (size_t)(u.pm * BM + ai * HALF + wr * 64 + m * 16 + fr) * 16 + 4 * fq);
#pragma unroll
          for (int ai = 0; ai < 2; ++ai)
#pragma unroll
            for (int m = 0; m < 4; ++m) rsv[ai][m] = (q4[ai][m][0] + q4[ai][m][1]) + (q4[ai][m][2] + q4[ai][m][3]);
#pragma unroll
          for (int ai = 0; ai < 2; ++ai)
#pragma unroll
            for (int m = 0; m < 4; ++m) rsv[ai][m] += __shfl_xor(rsv[ai][m], 16);
#pragma unroll
          for (int ai = 0; ai < 2; ++ai)
#pragma unroll
            for (int m = 0; m < 4; ++m) { rsv[ai][m] += __shfl_xor(rsv[ai][m], 32); rsv[ai][m] = 1.0f / sqrtf(rsv[ai][m] * (1.0f / DM) + EPS); } }
        if (u.pn < 2) {
            const bool isq = u.pn == 0;
            const f32x4 gk0 = *(const f32x4*)(gkv + wc * 32 + 4 * fq), gk1 = *(const f32x4*)(gkv + wc * 32 + 16 + 4 * fq);
#pragma unroll
            for (int ai = 0; ai < 2; ++ai)
#pragma unroll
                for (int m = 0; m < 4; ++m) { if (only >= 0 && only != ai * 4 + m) continue; const int rl = ai * HALF + wr * 64 + m * 16 + fr; const float rs = rsv[ai][m];
                    const f32x4 a0 = acc[ai][0][m][0] * rs, a1 = acc[ai][0][m][1] * rs; float ss = dot4(a0) + dot4(a1);
                    if (isq) { const f32x4 b0 = acc[ai][1][m][0] * rs, b1 = acc[ai][1][m][1] * rs; ss += dot4(b0) + dot4(b1); }
                    ss += __shfl_xor(ss, 16); ss += __shfl_xor(ss, 32);
                    if (fq == 0) sc[rl * 4 + wc] = ss; }
            asm volatile("s_waitcnt lgkmcnt(0)" ::: "memory"); __builtin_amdgcn_s_barrier();
#pragma unroll
            for (int ai = 0; ai < 2; ++ai)
#pragma unroll
                for (int m = 0; m < 4; ++m) { if (only >= 0 && only != ai * 4 + m) continue; const int rl = ai * HALF + wr * 64 + m * 16 + fr, row = u.pm * BM + rl; const float rs = rsv[ai][m];
                    const f32x4 q = *(const PG8_LAS f32x4*)(sc + rl * 4); const float tot = (q[0] + q[1]) + (q[2] + q[3]);
                    if (isq) { const float f = rs / sqrtf(tot * (1.0f / QL) + EPS);
#pragma unroll
                        for (int bj = 0; bj < 2; ++bj) *(u32x4*)(qlat + (size_t)row * QL + bj * HALF + wc * 32 + 8 * fq) = pack8(acc[ai][bj][m][0] * f, acc[ai][bj][m][1] * f);
                    } else { const float r2 = 1.0f / sqrtf(tot * (1.0f / KVL) + EPS), f = rs * r2;
                        if (fq == 0) ssqkv[(size_t)row * 4 + wc] = q[wc] * (r2 * r2);
                        float* co = out + (row < MP ? O_CKVP + (size_t)row * KVL : O_CKVS + (size_t)(row - MP) * KVL); bf16_t* cb = ckva + (size_t)(row < MP ? row : row + SB * PAST) * KVL;
#pragma unroll
                        for (int n = 0; n < 2; ++n) { const int c = wc * 32 + n * 16 + 4 * fq; const f32x4 v = acc[ai][0][m][n] * f * (n == 0 ? gk0 : gk1); *(f32x4*)(co + c) = v; *(u32x2*)(cb + c) = pack4(v); }
                        if (wc == 0) {
                            const int pos = row < MP ? (row & (SEQ - 1)) : PAST + ((row - MP) & (ST - 1));
                            const f32x4 cs = *(const f32x4*)(rope + (size_t)pos * 32 + 4 * fq), sn = *(const f32x4*)(rope + (size_t)pos * 32 + 16 + 4 * fq);
                            const f32x4 x1 = acc[ai][1][m][0] * rs, x2 = acc[ai][1][m][1] * rs, o1 = x1 * cs - x2 * sn, o2 = x2 * cs + x1 * sn;
                            float* ko = out + (row < MP ? O_KRP + (size_t)row * DR : O_KRS + (size_t)(row - MP) * DR);
                            *(f32x4*)(ko + 4 * fq) = o1; *(f32x4*)(ko + 16 + 4 * fq) = o2;
                            bf16_t* kb = row < MP ? krp + (((unsigned)row >> 6) * 2048u + ((unsigned)row & 63) * 8u) : krs + ((((unsigned)(row - MP) >> 6) * (SKVP / 64) + PAST / 64) * 2048u + ((unsigned)(row - MP) & 63) * 8u);
                            *(u32x2*)(kb + (fq >> 1) * 512 + 4 * (fq & 1)) = pack4(o1); *(u32x2*)(kb + (2 + (fq >> 1)) * 512 + 4 * (fq & 1)) = pack4(o2); } }
                    asm volatile("" ::: "memory"); }
        } else {
#pragma unroll
            for (int ai = 0; ai < 2; ++ai)
#pragma unroll
                for (int m = 0; m < 4; ++m) { if (only >= 0 && only != ai * 4 + m) continue; const int row = u.pm * BM + ai * HALF + wr * 64 + m * 16 + fr; const float rs = rsv[ai][m];
#pragma unroll
                    for (int bj = 0; bj < 2; ++bj) { f32x4 a = acc[ai][bj][m][0] * rs, b = acc[ai][bj][m][1] * rs;
#pragma unroll
                        for (int e = 0; e < 4; ++e) { a[e] = silu1(a[e]); b[e] = silu1(b[e]); }
                        *(u32x4*)(sz + (size_t)row * DM + (u.pn - 2) * BM + bj * HALF + wc * 32 + 8 * fq) = pack8(a, b); }
                    asm volatile("" ::: "memory"); }
        }
    }
};


template <class Inner> struct EpiSplit {
    static constexpr bool PERM = Inner::PERM, AFTER_DRAIN = false;
    Inner in; float* scr; unsigned* cnt; int tu, slice;
    __device__ __forceinline__ void operator()(f32x4 (&acc)[2][2][4][2], const Unit& u, int wr, int wc, int fr, int fq) const {
        int lane_ = fq * 16 + fr; asm volatile("" : "+v"(lane_));
        const unsigned tid = (unsigned)((wr * 4 + wc) * 64 + lane_);
        f32x4* mine = (f32x4*)scr + ((size_t)(tu * 8 + slice) * 32u) * 512u + tid;
#pragma unroll
        for (int ai = 0; ai < 2; ++ai)
#pragma unroll
            for (int bj = 0; bj < 2; ++bj)
#pragma unroll
                for (int m = 0; m < 4; ++m)
#pragma unroll
                    for (int n = 0; n < 2; ++n) mine[(unsigned)(((ai * 2 + bj) * 4 + m) * 2 + n) * 512u] = acc[ai][bj][m][n];
        asm volatile("s_waitcnt vmcnt(0)" ::: "memory"); __builtin_amdgcn_s_barrier();
        if (tid == 0) { unsigned* c = cnt + tu * 16;
            __builtin_amdgcn_fence(__ATOMIC_RELEASE, "agent"); asm volatile("s_waitcnt vmcnt(0)" ::: "memory");
            (void)__hip_atomic_fetch_add(c, 1u, __ATOMIC_RELAXED, __HIP_MEMORY_SCOPE_AGENT);
            unsigned sp = 0; while (__hip_atomic_load(c, __ATOMIC_RELAXED, __HIP_MEMORY_SCOPE_AGENT) < 8u && ++sp < (1u << 22)) __builtin_amdgcn_s_sleep(1);
            __builtin_amdgcn_fence(__ATOMIC_ACQUIRE, "agent"); asm volatile("s_waitcnt vmcnt(0)" ::: "memory"); }
        __builtin_amdgcn_s_barrier();
        const f32x4* all = (const f32x4*)scr + ((size_t)(tu * 8) * 32u) * 512u + tid;
#pragma unroll
        for (int ai = 0; ai < 2; ++ai)
#pragma unroll
            for (int m = 0; m < 4; ++m) { if (slice != ai * 4 + m) continue;
#pragma unroll
                for (int bj = 0; bj < 2; ++bj)
#pragma unroll
                    for (int n = 0; n < 2; ++n) { const unsigned f = (unsigned)(((ai * 2 + bj) * 4 + m) * 2 + n) * 512u; f32x4 t = all[f];
#pragma unroll
                        for (int s = 1; s < 8; ++s) t += all[(unsigned)s * (32u * 512u) + f];
                        acc[ai][bj][m][n] = t; } }
        in(acc, u, wr, wc, fr, fq, slice);
    }
};

struct EpiQ {
    static constexpr bool PERM = false, AFTER_DRAIN = false;
    const float* ssqq; const float* rope; bf16_t* Qp; bf16_t* Qs;
    __device__ __forceinline__ void operator()(const f32x4 (&acc)[2][2][4][2], const Unit& u, int wr, int wc, int fr, int fq) const {
        asm volatile("" : "+v"(fr), "+v"(fq));
        const bool smp = u.pm * BM >= MP;
        bf16_t* Qb = smp ? Qs : Qp; const unsigned hs = smp ? (unsigned)(ST * DQK) : (unsigned)(SEQ * DQK);
#pragma unroll
        for (int ai = 0; ai < 2; ++ai) {
            f32x4 csv[4], snv[4];
            if (u.pn >= 4) {
#pragma unroll
                for (int m = 0; m < 4; ++m) { const int row = u.pm * BM + ai * HALF + wr * 64 + m * 16 + fr; const int pos = smp ? PAST + ((row - MP) & 63) : (row & (SEQ - 1));
                    csv[m] = *(const f32x4*)(rope + (unsigned)(pos * 32 + 4 * fq)); snv[m] = *(const f32x4*)(rope + (unsigned)(pos * 32 + 16 + 4 * fq)); }
            }
#pragma unroll
            for (int m = 0; m < 4; ++m) { const int row = u.pm * BM + ai * HALF + wr * 64 + m * 16 + fr;
                const float rq = 1.f;
                unsigned qo; int pos;
                if (!smp) { const unsigned b = (unsigned)row >> 13, s = (unsigned)row & (SEQ - 1); qo = (b * (NH * SEQ) + s) * DQK; pos = (int)s; }
                else { const unsigned r2 = (unsigned)(row - MP), b = r2 >> 6, s = r2 & 63; qo = (b * (NH * ST) + s) * DQK; pos = PAST + (int)s; }
                if (u.pn < 4) {
#pragma unroll
                    for (int bj = 0; bj < 2; ++bj) { const unsigned L = (unsigned)(u.pn * BM + bj * HALF + wc * 32 + 8 * fq), head = L >> 6, d = L & 63;
                        *(u32x4*)(Qb + (qo + head * hs + d)) = pack8(acc[ai][bj][m][0] * rq, acc[ai][bj][m][1] * rq); }
                } else {
                    const f32x4 cs = csv[m], sn = snv[m];
#pragma unroll
                    for (int bj = 0; bj < 2; ++bj) { const unsigned head = (unsigned)((u.pn - 4) * 8 + bj * 4 + wc);
                        const f32x4 x1 = acc[ai][bj][m][0] * rq, x2 = acc[ai][bj][m][1] * rq, o1 = x1 * cs - x2 * sn, o2 = x2 * cs + x1 * sn;
                        *(u32x2*)(Qb + (qo + head * hs + DN + 4 * fq)) = pack4(o1); *(u32x2*)(Qb + (qo + head * hs + DN + 16 + 4 * fq)) = pack4(o2); }
                }
                asm volatile("" ::: "memory");
            } }
    }
};

struct EpiKV {
    static constexpr bool PERM = false, AFTER_DRAIN = false;
    const float* ssqkv; bf16_t* K; bf16_t* V; float* out; int fix;
    __device__ __forceinline__ void operator()(const f32x4 (&acc)[2][2][4][2], const Unit& u, int wr, int wc, int fr, int fq) const {
        asm volatile("" : "+v"(fr), "+v"(fq));
        const bool isK = u.pn < 4; bf16_t* T = isK ? K : V; const int pn4 = u.pn & 3;
        const int cat = u.pm * BM < MP ? 0 : (u.pm * BM < MP + SB * PAST ? 1 : 2);
        const unsigned hs = cat == 0 ? (unsigned)(SEQ * DN) : (unsigned)(SKVP * DN);
        const int rbase = cat == 0 ? u.pm * BM : (cat == 2 ? u.pm * BM - SB * PAST : -1);
        float rkv[2][4];
        { f32x4 sq[2][4];
          if (rbase >= 0) {
#pragma unroll
            for (int ai = 0; ai < 2; ++ai)
#pragma unroll
                for (int m = 0; m < 4; ++m) sq[ai][m] = *(const f32x4*)(ssqkv + (unsigned)(rbase + ai * HALF + wr * 64 + m * 16 + fr) * 4u);
          }
#pragma unroll
          for (int ai = 0; ai < 2; ++ai)
#pragma unroll
            for (int m = 0; m < 4; ++m) rkv[ai][m] = rbase >= 0 ? 1.0f / sqrtf(((sq[ai][m][0] + sq[ai][m][1]) + (sq[ai][m][2] + sq[ai][m][3])) * (1.0f / KVL) + EPS) : 1.f; }
#pragma unroll
        for (int ai = 0; ai < 2; ++ai)
#pragma unroll
            for (int m = 0; m < 4; ++m) { const unsigned R = (unsigned)(u.pm * BM + ai * HALF + wr * 64 + m * 16 + fr);
                unsigned sb, s; float rk = 1.f; int r = -1;
                if (cat == 0) { const unsigned b = R >> 13; s = R & (SEQ - 1); sb = b * (NH * SEQ * DN); r = (int)R; }
                else if (cat == 1) { const unsigned r2 = R - MP, b = r2 >> 12; s = r2 & (PAST - 1); sb = (unsigned)KP_ELEMS + b * (NH * SKVP * DN); }
                else { const unsigned r2 = R - MP - SB * PAST, b = r2 >> 6; s = PAST + (r2 & 63); sb = (unsigned)KP_ELEMS + b * (NH * SKVP * DN); r = MP + (int)r2; }
                rk = rkv[ai][m];
                const unsigned key = s & 63, kk = key, tb = sb + (s >> 6) * 4096u;
#pragma unroll
                for (int bj = 0; bj < 2; ++bj) { const unsigned L = (unsigned)(pn4 * BM + bj * HALF + wc * 32 + 8 * fq), head = L >> 6, c = (L & 63) >> 3;
                    const unsigned off = isK ? c * 512u + key * 8u : ((kk >> 3) * 2 + (c >> 2)) * 256u + (kk & 7) * 32u + (c & 3) * 8u;
                    *(u32x4*)(T + (tb + head * hs + off)) = pack8(acc[ai][bj][m][0] * rk, acc[ai][bj][m][1] * rk); }
                if (fix && u.pn == 0 && r >= 0) { float* co = out + ((unsigned)(r < MP ? O_CKVP : O_CKVS - (size_t)MP * KVL) + (unsigned)r * KVL + wc * 32 + 8 * fq);
                    const f32x4 a = *(const f32x4*)co, b = *(const f32x4*)(co + 4); *(f32x4*)co = a * rk; *(f32x4*)(co + 4) = b * rk; }
                asm volatile("" ::: "memory");
            }
    }
};

template <class Epi, class Sched, bool ALIGN_EPI = false, bool SP2 = false>
__device__ __forceinline__ void gemm_phase(PG8_LAS unsigned char* lds, const Gemm g, const Sched& S, const Epi& E) {
    int tid_ = threadIdx.x; asm volatile("" : "+v"(tid_));
    const int tid = tid_, wid = __builtin_amdgcn_readfirstlane(tid >> 6), lane = tid & 63, wr = wid >> 2, wc = wid & 3, fr = lane & 15, fq = lane >> 4;
    const int K = g.K, nt = g.kt > 0 ? g.kt : K / BK;
    unsigned voffA[2], voffB[2];
#pragma unroll
    for (int i = 0; i < 2; ++i) { int R, C; stage_rc(tid * 16 + i * 8192, R, C); const int Rb = Epi::PERM ? ((R & ~31) + perm32(R & 31)) : R;
        voffA[i] = (unsigned)(R * K + C) * 2u; voffB[i] = (unsigned)(Rb * K + C) * 2u; }
    const size_t kstep = (size_t)(BK * 2);
    const size_t hstep = (size_t)HALF * K * 2;
    const size_t tstep = 2 * hstep;
    const unsigned ldsw = (unsigned)wid * 1024u;
    const int aoff = lds_byte(wr * 64 + fr, fq * 8), boff = lds_byte(wc * 32 + fr, fq * 8);
#define PG8_SA(b, h) (((b) * 2 + (h)) * HTB)
#define PG8_SB(b, h) ((4 + (b) * 2 + (h)) * HTB)
#define PG8_STAGE(bufoff, gbase, voff) do { _Pragma("unroll") for (int _i = 0; _i < 2; ++_i) \
        __builtin_amdgcn_global_load_lds((const unsigned*)((const char*)(gbase) + (voff)[_i]), (PG8_LAS unsigned*)(lds + (bufoff) + ldsw + _i * 8192), 16, 0, 0); } while (0)
#define PG8_LDA(dst, b, h) do { _Pragma("unroll") for (int m = 0; m < 4; ++m) _Pragma("unroll") for (int k = 0; k < 2; ++k) dst[m][k] = *(const PG8_LAS bf16x8*)(lds + PG8_SA(b, h) + aoff + m * 2048 + k * 1024); } while (0)
#define PG8_LDB(dst, b, h) do { _Pragma("unroll") for (int n = 0; n < 2; ++n) _Pragma("unroll") for (int k = 0; k < 2; ++k) dst[n][k] = *(const PG8_LAS bf16x8*)(lds + PG8_SB(b, h) + boff + n * 2048 + k * 1024); } while (0)
#define PG8_MMA(ai, bj, At, Bt) do { __builtin_amdgcn_s_setprio(1); _Pragma("unroll") for (int m = 0; m < 4; ++m) _Pragma("unroll") for (int n = 0; n < 2; ++n) _Pragma("unroll") for (int k = 0; k < 2; ++k) \
        acc[ai][bj][m][n] = __builtin_amdgcn_mfma_f32_16x16x32_bf16(Bt[n][k], At[m][k], acc[ai][bj][m][n], 0, 0, 0); __builtin_amdgcn_s_setprio(0); } while (0)
#define PG8_WAIT_V(n) asm volatile("s_waitcnt vmcnt(" #n ")" ::: "memory")
#define PG8_WAIT_L(n) asm volatile("s_waitcnt lgkmcnt(" #n ")" ::: "memory")
#define PG8_BAR __builtin_amdgcn_s_barrier()
#define PG8_SCHED __builtin_amdgcn_sched_barrier(0)
    Unit cur, nxt; int ui = 0;
    if (!S.next(0, cur)) return;
    f32x4 acc[2][2][4][2];
#pragma unroll
    for (int a = 0; a < 2; ++a)
#pragma unroll
        for (int b = 0; b < 2; ++b)
#pragma unroll
            for (int m = 0; m < 4; ++m)
#pragma unroll
                for (int n = 0; n < 2; ++n) acc[a][b][m][n] = (f32x4){0.f, 0.f, 0.f, 0.f};
    bf16x8 At[4][2], B0[2][2], B1[2][2];
    const char* cA = (const char*)g.A + (size_t)cur.pm * tstep; const char* cB = (const char*)g.Bt + (size_t)cur.pn * tstep;
    S.a_ready(cur);
    if constexpr (SP2) {
        PG8_STAGE(PG8_SB(0, 0), cB, voffB); PG8_STAGE(PG8_SB(0, 1), cB + hstep, voffB); PG8_STAGE(PG8_SA(0, 0), cA, voffA); PG8_STAGE(PG8_SA(0, 1), cA + hstep, voffA);
        if (wr == 1) PG8_BAR;
        PG8_WAIT_V(2); PG8_BAR;
        PG8_STAGE(PG8_SB(1, 0), cB + kstep, voffB); PG8_STAGE(PG8_SA(1, 0), cA + kstep, voffA); PG8_STAGE(PG8_SB(1, 1), cB + hstep + kstep, voffB);
        PG8_WAIT_V(6); PG8_BAR;
    } else {
        PG8_STAGE(PG8_SB(0, 0), cB, voffB); PG8_STAGE(PG8_SA(0, 0), cA, voffA); PG8_STAGE(PG8_SB(0, 1), cB + hstep, voffB); PG8_STAGE(PG8_SA(0, 1), cA + hstep, voffA);
        if (wr == 1) PG8_BAR;
        PG8_WAIT_V(4); PG8_BAR;
        PG8_STAGE(PG8_SB(1, 0), cB + kstep, voffB); PG8_STAGE(PG8_SA(1, 0), cA + kstep, voffA); PG8_STAGE(PG8_SB(1, 1), cB + hstep + kstep, voffB);
        PG8_WAIT_V(6); PG8_BAR;
    }
    for (;;) {
        const bool has_next = S.next(ui + 1, nxt);
        const char* nA = has_next ? (const char*)g.A + (size_t)nxt.pm * tstep : cA; const char* nB = has_next ? (const char*)g.Bt + (size_t)nxt.pn * tstep : cB;
#pragma unroll 1
        for (int t = 0; t < nt; t += 2) {
            const bool last = (t == nt - 2);
            const char* a1 = cA + (size_t)(t + 1) * kstep;
            const char* a2 = last ? nA : cA + (size_t)(t + 2) * kstep; const char* b2 = last ? nB : cB + (size_t)(t + 2) * kstep;
            const char* a3 = a2 + kstep; const char* b3 = b2 + kstep;
            if (last && has_next) S.a_ready(nxt);
            if constexpr (SP2) {
            PG8_LDB(B0, 0, 0); PG8_LDB(B1, 0, 1); PG8_SCHED; PG8_LDA(At, 0, 0); PG8_STAGE(PG8_SA(1, 1), a1 + hstep, voffA);
            PG8_WAIT_V(8); PG8_WAIT_L(0); PG8_BAR; PG8_MMA(0, 0, At, B0); PG8_MMA(0, 1, At, B1); PG8_BAR; PG8_SCHED;
            PG8_LDA(At, 0, 1); PG8_STAGE(PG8_SB(0, 0), b2, voffB); PG8_STAGE(PG8_SB(0, 1), b2 + hstep, voffB); PG8_STAGE(PG8_SA(0, 0), a2, voffA);
            PG8_WAIT_V(8); PG8_WAIT_L(0); PG8_BAR; PG8_MMA(1, 0, At, B0); PG8_MMA(1, 1, At, B1); PG8_BAR; PG8_SCHED;
            PG8_LDB(B0, 1, 0); PG8_LDB(B1, 1, 1); PG8_SCHED; PG8_LDA(At, 1, 0); PG8_STAGE(PG8_SA(0, 1), a2 + hstep, voffA);
            PG8_WAIT_V(8); PG8_WAIT_L(0); PG8_BAR; PG8_MMA(0, 0, At, B0); PG8_MMA(0, 1, At, B1); PG8_BAR; PG8_SCHED;
            PG8_LDA(At, 1, 1); PG8_STAGE(PG8_SB(1, 0), b3, voffB); PG8_STAGE(PG8_SB(1, 1), b3 + hstep, voffB); PG8_STAGE(PG8_SA(1, 0), a3, voffA);
            PG8_WAIT_V(8); PG8_WAIT_L(0); PG8_BAR; PG8_MMA(1, 0, At, B0); PG8_MMA(1, 1, At, B1); PG8_BAR; PG8_SCHED;
            } else {
            PG8_LDB(B0, 0, 0); PG8_SCHED; PG8_LDA(At, 0, 0); PG8_STAGE(PG8_SA(1, 1), a1 + hstep, voffA);
            PG8_WAIT_L(8); PG8_BAR; PG8_WAIT_L(0); PG8_MMA(0, 0, At, B0); PG8_BAR; PG8_SCHED;
            PG8_LDB(B1, 0, 1); PG8_STAGE(PG8_SB(0, 0), b2, voffB);
            PG8_BAR; PG8_WAIT_L(0); PG8_MMA(0, 1, At, B1); PG8_BAR;
            PG8_LDA(At, 0, 1); PG8_STAGE(PG8_SA(0, 0), a2, voffA);
            PG8_BAR; PG8_WAIT_L(0); PG8_MMA(1, 0, At, B0); PG8_BAR; PG8_SCHED;
            PG8_STAGE(PG8_SB(0, 1), b2 + hstep, voffB);
            PG8_WAIT_V(6); PG8_BAR; PG8_MMA(1, 1, At, B1); PG8_BAR;
            PG8_LDB(B0, 1, 0); PG8_SCHED; PG8_LDA(At, 1, 0); PG8_STAGE(PG8_SA(0, 1), a2 + hstep, voffA);
            PG8_WAIT_L(8); PG8_BAR; PG8_WAIT_L(0); PG8_MMA(0, 0, At, B0); PG8_BAR; PG8_SCHED;
            PG8_LDB(B1, 1, 1); PG8_STAGE(PG8_SB(1, 0), b3, voffB);
            PG8_BAR; PG8_WAIT_L(0); PG8_MMA(0, 1, At, B1); PG8_BAR;
            PG8_LDA(At, 1, 1); PG8_STAGE(PG8_SA(1, 0), a3, voffA);
            PG8_BAR; PG8_WAIT_L(0); PG8_MMA(1, 0, At, B0); PG8_BAR; PG8_SCHED;
            PG8_STAGE(PG8_SB(1, 1), b3 + hstep, voffB);
            PG8_WAIT_V(6); PG8_BAR; PG8_MMA(1, 1, At, B1); PG8_BAR;
            }
        }
        if constexpr (ALIGN_EPI) { if (wr == 0) PG8_BAR; }
        if constexpr (!Epi::AFTER_DRAIN) { E(acc, cur, wr, wc, fr, fq); S.done(cur); }
        if (!has_next) break;
#pragma unroll
        for (int a = 0; a < 2; ++a)
#pragma unroll
            for (int b = 0; b < 2; ++b)
#pragma unroll
                for (int m = 0; m < 4; ++m)
#pragma unroll
                    for (int n = 0; n < 2; ++n) acc[a][b][m][n] = (f32x4){0.f, 0.f, 0.f, 0.f};
        cur = nxt; cA = nA; cB = nB; ++ui;
        if constexpr (ALIGN_EPI) { if (wr == 1) PG8_BAR; }
    }
    PG8_WAIT_V(0);
    if constexpr (!ALIGN_EPI) { if (wr == 0) PG8_BAR; }
    PG8_BAR;
    if constexpr (Epi::AFTER_DRAIN) { E.fused(acc, cur, wr, wc, fr, fq, lds, wid, lane); S.done(cur); }
#undef PG8_SA
#undef PG8_SB
#undef PG8_STAGE
#undef PG8_LDA
#undef PG8_LDB
#undef PG8_MMA
#undef PG8_WAIT_V
#undef PG8_WAIT_L
#undef PG8_BAR
#undef PG8_SCHED
}
}
namespace att {
using bf16x8 = __attribute__((ext_vector_type(8))) short;
using s16x4  = __attribute__((ext_vector_type(4))) short;
using f32x16 = __attribute__((ext_vector_type(16))) float;
using f32x4  = __attribute__((ext_vector_type(4))) float;
using u32x4  = __attribute__((ext_vector_type(4))) unsigned;
using u32x2  = __attribute__((ext_vector_type(2))) unsigned;
typedef unsigned short bf16_t;
constexpr int NW = 8, QBLK = 32, KVBLK = 64;
constexpr int KSLOT = 12288, VSLOT = 8192, OSTP = 68, NSLOT = 4;
constexpr int L_K = 0, L_V = NSLOT * KSLOT, L_WS = L_V + NSLOT * VSLOT, L_OST = L_WS + NW * 256, L_END = L_OST + NW * 32 * OSTP * 4;
constexpr float THR = 8.f;
#define SBAR() __builtin_amdgcn_sched_barrier(0)
__device__ __forceinline__ int crow(int r, int hi) { return (r & 3) + 8 * (r >> 2) + 4 * hi; }
__device__ __forceinline__ void glds16(const void* gbase, unsigned voff, unsigned lds_dst) {
  asm volatile("s_mov_b32 m0, %2\n\ts_nop 0\n\tglobal_load_lds_dwordx4 %0, %1" :: "v"(voff), "s"(gbase), "s"(lds_dst) : "memory", "m0"); }
__device__ __forceinline__ void glds16_lo32(const void* gbase, unsigned voff, unsigned lds_dst) {
  asm volatile("s_mov_b32 m0, %2\n\ts_mov_b32 exec_hi, 0\n\tglobal_load_lds_dwordx4 %0, %1\n\ts_mov_b32 exec_hi, -1" :: "v"(voff), "s"(gbase), "s"(lds_dst) : "memory", "m0"); }
#define WAIT_BAR(N) asm volatile("s_waitcnt vmcnt(" #N ") lgkmcnt(0)\n\ts_barrier" ::: "memory")
typedef float f32x2_t __attribute__((ext_vector_type(2))); typedef __bf16 bf16x2_t __attribute__((ext_vector_type(2)));
__device__ __forceinline__ unsigned cvtpk(float lo, float hi) { f32x2_t v = {lo, hi}; bf16x2_t b = __builtin_convertvector(v, bf16x2_t); return __builtin_bit_cast(unsigned, b); }

template <bool FIRST>
__device__ __forceinline__ bool rowmax_dec(f32x16& p0, f32x16& p1, float& mhat, f32x16& negm, float& alpha) {
  float pmax = p0[0];
#pragma unroll
  for (int r = 1; r < 16; ++r) pmax = fmaxf(pmax, p0[r]);
#pragma unroll
  for (int r = 0; r < 16; ++r) pmax = fmaxf(pmax, p1[r]);
  { auto rr = __builtin_amdgcn_permlane32_swap(__float_as_uint(pmax), __float_as_uint(pmax), false, false);
    pmax = fmaxf(__uint_as_float(rr[0]), __uint_as_float(rr[1])); }
  alpha = 1.f;
  if (FIRST || __builtin_expect(__any(pmax > THR), 0)) {
    const float dl = FIRST ? pmax : fmaxf(pmax, 0.f); mhat += dl;
#pragma unroll
    for (int r = 0; r < 16; ++r) { p0[r] -= dl; p1[r] -= dl; }
#pragma unroll
    for (int r = 0; r < 16; ++r) negm[r] = -mhat;
    alpha = __builtin_amdgcn_exp2f(-dl);
    return true;
  }
  return false;
}
__device__ __forceinline__ void finishSM(f32x16& p0, f32x16& p1, float alpha, float& l_reg, bf16x8& pa0, bf16x8& pa1, bf16x8& pa2, bf16x8& pa3) {
#pragma unroll
  for (int r = 0; r < 16; ++r) p0[r] = __builtin_amdgcn_exp2f(p0[r]);
#pragma unroll
  for (int r = 0; r < 16; ++r) p1[r] = __builtin_amdgcn_exp2f(p1[r]);
  float ps = 0;
#pragma unroll
  for (int r = 0; r < 16; ++r) ps += p0[r];
#pragma unroll
  for (int r = 0; r < 16; ++r) ps += p1[r];
  { auto rr = __builtin_amdgcn_permlane32_swap(__float_as_uint(ps), __float_as_uint(ps), false, false);
    ps = __uint_as_float(rr[0]) + __uint_as_float(rr[1]); }
  l_reg = l_reg * alpha + ps;
#define PK4(P, BASE, OUT) do { u32x4 w = {cvtpk(P[BASE + 0], P[BASE + 1]), cvtpk(P[BASE + 2], P[BASE + 3]), cvtpk(P[BASE + 4], P[BASE + 5]), cvtpk(P[BASE + 6], P[BASE + 7])}; OUT = *reinterpret_cast<bf16x8*>(&w); } while (0)
  PK4(p0, 0, pa0); PK4(p0, 8, pa1); PK4(p1, 0, pa2); PK4(p1, 8, pa3);
#undef PK4
  asm volatile("" :: "v"(pa0), "v"(pa1), "v"(pa2), "v"(pa3));
}
template <int D0A, int D0B> __device__ __forceinline__ void kload(bf16x8* kf, const char* Ks, int r32, int hi) {
  const char* kb = Ks + hi * 1024 + r32 * 16;
#pragma unroll
  for (int d0 = D0A; d0 < D0B; ++d0) { kf[2 * d0] = *reinterpret_cast<const bf16x8*>(kb + d0 * 2048); kf[2 * d0 + 1] = *reinterpret_cast<const bf16x8*>(kb + d0 * 2048 + 512); }
}
constexpr int KPRE = 0;
__device__ __forceinline__ void qkt(f32x16& p0, f32x16& p1, const bf16x8* kf, const bf16x8* qr, const f32x16& negm) {
#pragma unroll
  for (int d0 = 0; d0 < 6; ++d0) {
    if (d0 == 0) { p0 = __builtin_amdgcn_mfma_f32_32x32x16_bf16(kf[0], qr[0], negm, 0, 0, 0); p1 = __builtin_amdgcn_mfma_f32_32x32x16_bf16(kf[1], qr[0], negm, 0, 0, 0); }
    else { p0 = __builtin_amdgcn_mfma_f32_32x32x16_bf16(kf[2 * d0], qr[d0], p0, 0, 0, 0); p1 = __builtin_amdgcn_mfma_f32_32x32x16_bf16(kf[2 * d0 + 1], qr[d0], p1, 0, 0, 0); } }
}
__device__ __forceinline__ int v_rd_base(int lane) { return ((lane & 3) << 3) | (((lane >> 2) & 3) << 6) | (((lane >> 4) & 1) << 5) | (((lane >> 5) & 1) << 8); }
constexpr int v_rd_off(int d0, int ks, int half) { return d0 * 512 + ks * 2048 + half * 1024; }
template <int OFF> __device__ __forceinline__ s16x4 tr_read(int vb) {
  s16x4 r; asm volatile("ds_read_b64_tr_b16 %0, %1 offset:%2" : "=&v"(r) : "v"(vb), "i"(OFF) : "memory"); return r;
}
template <int D0> __device__ __forceinline__ void pv_one(f32x16& od, int vb, bf16x8 pa0, bf16x8 pa1, bf16x8 pa2, bf16x8 pa3) {
  const s16x4 l0 = tr_read<v_rd_off(D0, 0, 0)>(vb), h0 = tr_read<v_rd_off(D0, 0, 1)>(vb), l1 = tr_read<v_rd_off(D0, 1, 0)>(vb), h1 = tr_read<v_rd_off(D0, 1, 1)>(vb);
  const s16x4 l2 = tr_read<v_rd_off(D0, 2, 0)>(vb), h2 = tr_read<v_rd_off(D0, 2, 1)>(vb), l3 = tr_read<v_rd_off(D0, 3, 0)>(vb), h3 = tr_read<v_rd_off(D0, 3, 1)>(vb);
  asm volatile("s_waitcnt lgkmcnt(0)" ::: "memory"); SBAR();
#define PK(L, H) (bf16x8){L[0], L[1], L[2], L[3], H[0], H[1], H[2], H[3]}
  od = __builtin_amdgcn_mfma_f32_32x32x16_bf16(pa0, PK(l0, h0), od, 0, 0, 0);
  od = __builtin_amdgcn_mfma_f32_32x32x16_bf16(pa1, PK(l1, h1), od, 0, 0, 0);
  od = __builtin_amdgcn_mfma_f32_32x32x16_bf16(pa2, PK(l2, h2), od, 0, 0, 0);
  od = __builtin_amdgcn_mfma_f32_32x32x16_bf16(pa3, PK(l3, h3), od, 0, 0, 0);
#undef PK
}
struct VFrag8 { s16x4 l0, h0, l1, h1, l2, h2, l3, h3; };
__device__ __forceinline__ void pv_read0(VFrag8& f, int vb) {
  f.l0 = tr_read<v_rd_off(0, 0, 0)>(vb); f.h0 = tr_read<v_rd_off(0, 0, 1)>(vb); f.l1 = tr_read<v_rd_off(0, 1, 0)>(vb); f.h1 = tr_read<v_rd_off(0, 1, 1)>(vb);
  f.l2 = tr_read<v_rd_off(0, 2, 0)>(vb); f.h2 = tr_read<v_rd_off(0, 2, 1)>(vb); f.l3 = tr_read<v_rd_off(0, 3, 0)>(vb); f.h3 = tr_read<v_rd_off(0, 3, 1)>(vb);
}
__device__ __forceinline__ void pv_mma0(f32x16& od, const VFrag8& f, bf16x8 pa0, bf16x8 pa1, bf16x8 pa2, bf16x8 pa3) {
  asm volatile("s_waitcnt lgkmcnt(0)" ::: "memory"); SBAR();
#define PK(L, H) (bf16x8){L[0], L[1], L[2], L[3], H[0], H[1], H[2], H[3]}
  od = __builtin_amdgcn_mfma_f32_32x32x16_bf16(pa0, PK(f.l0, f.h0), od, 0, 0, 0);
  od = __builtin_amdgcn_mfma_f32_32x32x16_bf16(pa1, PK(f.l1, f.h1), od, 0, 0, 0);
  od = __builtin_amdgcn_mfma_f32_32x32x16_bf16(pa2, PK(f.l2, f.h2), od, 0, 0, 0);
  od = __builtin_amdgcn_mfma_f32_32x32x16_bf16(pa3, PK(f.l3, f.h3), od, 0, 0, 0);
#undef PK
}
__device__ __forceinline__ void pv_all(f32x16* o, int vb, bf16x8 pa0, bf16x8 pa1, bf16x8 pa2, bf16x8 pa3) {
  pv_one<0>(o[0], vb, pa0, pa1, pa2, pa3); pv_one<1>(o[1], vb, pa0, pa1, pa2, pa3);
}

__device__ __forceinline__ void attn_unit(const bool SAMPLE, const bool DRY, const bool PRE, const bf16_t* __restrict__ Qb, const bf16_t* __restrict__ Kh, const bf16_t* __restrict__ Vh, const bf16_t* __restrict__ KRh,
                                          const bf16_t* KhN, const bf16_t* VhN, const bf16_t* KRhN, const bf16_t* QbN, const bool SAMPLE_N, bf16_t* G, int NT, int visb, char* lds) {
  int tid_ = threadIdx.x; asm volatile("" : "+v"(tid_));
  const int tid = tid_, wid = __builtin_amdgcn_readfirstlane(tid >> 6), lane = tid & 63, r32 = lane & 31, hi = lane >> 5;
  char* V_lds = lds + L_V; char* K_lds = lds + L_K;
  float* ws = (float*)(lds + L_WS) + wid * 64; float* li_l = ws; float* al_l = ws + 32;
  float* ost = (float*)(lds + L_OST) + wid * 32 * OSTP;
  const unsigned lds0 = (unsigned)(uintptr_t)lds;
  const int wq = SAMPLE ? (wid & 1) : wid, vis = SAMPLE ? visb : visb + (wid >> 1);
  const unsigned lo = (unsigned)(wid * 1024 + lane * 16), lor = (unsigned)(wid * 512 + (lane & 31) * 16);
  const unsigned kdst = lds0 + L_K + wid * 1024, rdst = lds0 + L_K + 8 * 1024 + wid * 512, vdst = lds0 + L_V + wid * 1024;
#define DMA_K(t, slot) do { const unsigned t_ = (unsigned)(t); glds16((const char*)Kh + (size_t)t_ * 8192u, lo, (unsigned)__builtin_amdgcn_readfirstlane(kdst + (slot))); \
    glds16_lo32((const char*)KRh + (size_t)t_ * 4096u, lor, (unsigned)__builtin_amdgcn_readfirstlane(rdst + (slot))); } while (0)
#define DMA_V(t, slot) glds16((const char*)Vh + (size_t)(unsigned)(t) * 8192u, lo, (unsigned)__builtin_amdgcn_readfirstlane(vdst + (slot) / 3 * 2))
#define SLOTK(t) ((((unsigned)(t)) & (NSLOT - 1)) * KSLOT)
#define ISSUE_PAIR(j_, jc_, FULL) do { if ((FULL) || (j_) + 2 < NT) DMA_K((j_) + 2, SLOTK((jc_) + 2)); if ((FULL) || (j_) + 3 < NT) DMA_K((j_) + 3, SLOTK((jc_) + 3)); \
    if ((FULL) || (j_) + 1 < NT) DMA_V((j_) + 1, SLOTK((jc_) + 1)); if ((FULL) || (j_) + 2 < NT) DMA_V((j_) + 2, SLOTK((jc_) + 2)); } while (0)
  if (!PRE) { DMA_K(0, 0); DMA_V(0, 0); DMA_K(1, KSLOT); DMA_K(2, 2 * KSLOT); }
  if (SAMPLE && wid >= 2) {
    asm volatile("s_waitcnt vmcnt(0)" ::: "memory"); WAIT_BAR(0);
    DMA_V(1, SLOTK(1)); WAIT_BAR(0);
    for (int j = 1; j + 1 < NT; j += 2) { ISSUE_PAIR(j, j, false); WAIT_BAR(0); }
    WAIT_BAR(0);
    if (KhN) { const unsigned t0_ = 0u; (void)t0_;
      glds16((const char*)KhN, lo, (unsigned)__builtin_amdgcn_readfirstlane(kdst)); glds16_lo32((const char*)KRhN, lor, (unsigned)__builtin_amdgcn_readfirstlane(rdst));
      glds16((const char*)VhN, lo, (unsigned)__builtin_amdgcn_readfirstlane(vdst));
      glds16((const char*)KhN + 8192, lo, (unsigned)__builtin_amdgcn_readfirstlane(kdst + KSLOT)); glds16_lo32((const char*)KRhN + 4096, lor, (unsigned)__builtin_amdgcn_readfirstlane(rdst + KSLOT));
      glds16((const char*)KhN + 16384, lo, (unsigned)__builtin_amdgcn_readfirstlane(kdst + 2 * KSLOT)); glds16_lo32((const char*)KRhN + 8192, lor, (unsigned)__builtin_amdgcn_readfirstlane(rdst + 2 * KSLOT)); }
    asm volatile("s_waitcnt lgkmcnt(0)\n\ts_barrier" ::: "memory");
    return;
  }
  float mhat = 0.f, l_reg = 0; f32x16 o[2] = {}; f32x16 negm = {}; bf16x8 kf[12], qr[6];
  { const unsigned qof = (unsigned)((wq * QBLK + r32) * DQK + hi * 8);
#pragma unroll
    for (int d0 = 0; d0 < 6; ++d0) qr[d0] = *reinterpret_cast<const bf16x8*>(Qb + (qof + d0 * 16)); }
  const int vb0 = (int)(uintptr_t)V_lds + v_rd_base(lane);
#define RESC(a) do { if (hi == 0) al_l[r32] = (a); asm volatile("s_waitcnt lgkmcnt(0)" ::: "memory"); \
    _Pragma("unroll") for (int d = 0; d < 2; ++d) _Pragma("unroll") for (int r = 0; r < 16; ++r) o[d][r] *= al_l[crow(r, hi)]; } while (0)
#define MASK(P0, P1, t) do { if ((t) > vis) { _Pragma("unroll") for (int r = 0; r < 16; ++r) { P0[r] = -INFINITY; P1[r] = -INFINITY; } } } while (0)
  f32x16 pA0, pA1, pB0, pB1; float alA, alB; bf16x8 pa0, pa1, pa2, pa3;
#define VOFF(s) ((s) / 3 * 2)
  asm volatile("s_waitcnt vmcnt(0)" ::: "memory");
  WAIT_BAR(0);
  kload<0, 6>(kf, K_lds, r32, hi);
  qkt(pA0, pA1, kf, qr, negm); rowmax_dec<true>(pA0, pA1, mhat, negm, alA); alA = 0.f;
  DMA_V(1, SLOTK(1));
  WAIT_BAR(0);
#define QK_SGB() do { __builtin_amdgcn_sched_group_barrier(0x100, 12, 0); __builtin_amdgcn_sched_group_barrier(0x400, 10, 0); __builtin_amdgcn_sched_group_barrier(0x002, 10, 0); _Pragma("unroll") for (int i_ = 0; i_ < 12; ++i_) { __builtin_amdgcn_sched_group_barrier(0x008, 1, 0); \
      __builtin_amdgcn_sched_group_barrier(0x400, 2, 0); __builtin_amdgcn_sched_group_barrier(0x002, 4, 0); } } while (0)
#define STEP(C0, C1, P0, P1, alC, alP, t, tc, MSK, DMA_) do { \
    const bool vc_ = !(MSK) || (t) <= vis, vp_ = !(MSK) || (t) - 1 <= vis; \
    SBAR(); if (vc_) { kload<0, 6>(kf, K_lds + SLOTK(tc), r32, hi); qkt(C0, C1, kf, qr, negm); } \
    if (vp_) finishSM(P0, P1, alP, l_reg, pa0, pa1, pa2, pa3); if (!(MSK)) QK_SGB(); SBAR(); \
    VFrag8 vf_; if (vp_) pv_read0(vf_, vb0 + VOFF(SLOTK((tc) - 1))); SBAR(); \
    DMA_; SBAR(); \
    if (vp_) { pv_mma0(o[0], vf_, pa0, pa1, pa2, pa3); pv_one<1>(o[1], vb0 + VOFF(SLOTK((tc) - 1)), pa0, pa1, pa2, pa3); } \
    if (vc_) { if (__builtin_expect(rowmax_dec<false>(C0, C1, mhat, negm, alC), 0)) RESC(alC); } else alC = 1.f; } while (0)
  int j = 1; const int jm = visb < NT - 4 ? visb : NT - 4;
  for (; j + 3 <= jm; j += 4) {
    STEP(pB0, pB1, pA0, pA1, alB, alA, j, 1, false, ISSUE_PAIR(j, 1, true)); STEP(pA0, pA1, pB0, pB1, alA, alB, j + 1, 2, false, (void)0); WAIT_BAR(0);
    STEP(pB0, pB1, pA0, pA1, alB, alA, j + 2, 3, false, ISSUE_PAIR(j + 2, 3, true)); STEP(pA0, pA1, pB0, pB1, alA, alB, j + 3, 4, false, (void)0); WAIT_BAR(0); }
  for (; j + 1 <= jm; j += 2) { STEP(pB0, pB1, pA0, pA1, alB, alA, j, j, false, ISSUE_PAIR(j, j, true)); STEP(pA0, pA1, pB0, pB1, alA, alB, j + 1, j + 1, false, (void)0); WAIT_BAR(0); }
  for (; j + 1 < NT; j += 2) { STEP(pB0, pB1, pA0, pA1, alB, alA, j, j, true, ISSUE_PAIR(j, j, false)); STEP(pA0, pA1, pB0, pB1, alA, alB, j + 1, j + 1, true, (void)0); WAIT_BAR(0); }
  STEP(pB0, pB1, pA0, pA1, alB, alA, NT - 1, NT - 1, true, (void)0); WAIT_BAR(0);
  const unsigned sl_prev = SLOTK(NT - 1);
  if (KhN) {
#define DMA_KN(t, slot) do { const unsigned t_ = (unsigned)(t); glds16((const char*)KhN + (size_t)t_ * 8192u, lo, (unsigned)__builtin_amdgcn_readfirstlane(kdst + (slot))); \
    glds16_lo32((const char*)KRhN + (size_t)t_ * 4096u, lor, (unsigned)__builtin_amdgcn_readfirstlane(rdst + (slot))); } while (0)
    DMA_KN(0, 0); glds16((const char*)VhN, lo, (unsigned)__builtin_amdgcn_readfirstlane(vdst)); DMA_KN(1, KSLOT); DMA_KN(2, 2 * KSLOT);
#undef DMA_KN
  }
  u32x4 zz[4];
  if ((!SAMPLE || wid < 2) && !DRY) {
#pragma unroll
    for (int i = 0; i < 4; ++i) zz[i] = __builtin_nontemporal_load((const u32x4*)(G + (unsigned)((wq * QBLK + i * 8 + (lane >> 3)) * DM + (lane & 7) * 8))); }
  if (NT - 1 <= vis) { finishSM(pB0, pB1, alB, l_reg, pa0, pa1, pa2, pa3); SBAR();
    pv_all(o, vb0 + VOFF(sl_prev), pa0, pa1, pa2, pa3); }
  if (hi == 0) li_l[r32] = l_reg; asm volatile("s_waitcnt lgkmcnt(0)" ::: "memory");
#pragma unroll
  for (int r = 0; r < 16; ++r) { const int orow = crow(r, hi); const float rl = __builtin_amdgcn_rcpf(li_l[orow]);
    ost[orow * OSTP + r32] = o[0][r] * rl; ost[orow * OSTP + 32 + r32] = o[1][r] * rl; }
  asm volatile("s_waitcnt lgkmcnt(0)" ::: "memory");
  if ((!SAMPLE || wid < 2) && !DRY) {
#pragma unroll
    for (int i = 0; i < 4; ++i) { const int row = i * 8 + (lane >> 3), ch = lane & 7;
      const f32x4 a = *(const f32x4*)(ost + row * OSTP + ch * 8), b = *(const f32x4*)(ost + row * OSTP + ch * 8 + 4);
      bf16_t* gp = G + (unsigned)((wq * QBLK + row) * DM + ch * 8); const u32x4 z_ = zz[i]; u32x4 w;
      w.x = cvtpk(a[0] * __uint_as_float(z_.x << 16), a[1] * __uint_as_float(z_.x & 0xffff0000u));
      w.y = cvtpk(a[2] * __uint_as_float(z_.y << 16), a[3] * __uint_as_float(z_.y & 0xffff0000u));
      w.z = cvtpk(b[0] * __uint_as_float(z_.z << 16), b[1] * __uint_as_float(z_.z & 0xffff0000u));
      w.w = cvtpk(b[2] * __uint_as_float(z_.w << 16), b[3] * __uint_as_float(z_.w & 0xffff0000u));
      *(u32x4*)gp = w; }
  }
  asm volatile("s_waitcnt lgkmcnt(0)\n\ts_barrier" ::: "memory");
#undef DMA_K
#undef DMA_V
#undef RESC
#undef MASK
#undef ROT
#undef VOFF
#undef SLOTK
#undef ISSUE_PAIR
#undef ENDW
#undef QK_SGB
#undef STEP
}
#undef WAIT_BAR
#undef SBAR
}

constexpr int NWAVES = 8;
constexpr int RING_OFF = 0, RING_BYTES = 153600;
constexpr int LDSCTL_OFF = RING_BYTES, MISC_OFF = LDSCTL_OFF + 320;
constexpr int LDS_BYTES = 155648;
static_assert(att::L_END <= RING_BYTES && MISC_OFF + 128 <= LDS_BYTES, "LDS map");

#define GAS __attribute__((address_space(1)))
#define LAS __attribute__((address_space(3)))
typedef unsigned short bf16;
typedef unsigned v4u __attribute__((ext_vector_type(4)));
typedef unsigned v2u __attribute__((ext_vector_type(2)));
typedef float f32x4 __attribute__((ext_vector_type(4)));
typedef GAS unsigned gu32;
#define RLX_AGENT __ATOMIC_RELAXED, __HIP_MEMORY_SCOPE_AGENT
#define LDS_WAIT() asm volatile("s_waitcnt lgkmcnt(0)" ::: "memory")
#define VM_WAIT() asm volatile("s_waitcnt vmcnt(0)" ::: "memory")
typedef float f32x2_ __attribute__((ext_vector_type(2))); typedef __bf16 bf16x2_ __attribute__((ext_vector_type(2)));
__device__ __forceinline__ unsigned pk2(float lo, float hi) { f32x2_ v = {lo, hi}; bf16x2_ b = __builtin_convertvector(v, bf16x2_); return __builtin_bit_cast(unsigned, b); }

#define XB_TMO      128
#define XB_XCNT(j)  (256  + 64 * (j))
#define XB_XSUB(j)  (1280 + 64 * (j))
#define XB_XGEN(j)  (2304 + 64 * (j))
#define XB_TOP      3328
#define XB_TOPGEN   3392
#define XCD_BAR_WORDS 3456
#define XB_SPIN_CAP (1u << 18)

__device__ __forceinline__ unsigned xb_ld(unsigned* p)              { return __hip_atomic_load(p, __ATOMIC_RELAXED, __HIP_MEMORY_SCOPE_AGENT); }
__device__ __forceinline__ unsigned xb_add(unsigned* p, unsigned v) { return __hip_atomic_fetch_add(p, v, __ATOMIC_RELAXED, __HIP_MEMORY_SCOPE_AGENT); }
__device__ __forceinline__ unsigned xb_xcc_id() { return (unsigned)__builtin_amdgcn_s_getreg((3 << 11) | 20) & 0xFu; }
#define XB_SPIN(cond, bar) do { unsigned _sp = 0; while (cond) { __builtin_amdgcn_s_sleep(1); \
    if ((++_sp & 255u) == 0u) { if (xb_ld(&(bar)[XB_TMO])) break; if (_sp > XB_SPIN_CAP) { atomicAdd(&(bar)[XB_TMO], 1u); break; } } } } while (0)

struct XcdBarrier {
    unsigned* bar; unsigned x;
    volatile LAS unsigned* st;
};

__device__ __forceinline__ XcdBarrier xcd_barrier_post(unsigned* bar, volatile LAS unsigned* st) {
    XcdBarrier b; b.bar = bar; b.x = xb_xcc_id(); b.st = st;
    if (threadIdx.x == 0) (void)xb_add(&bar[XB_XCNT(b.x)], 1u);
    return b;
}
__device__ __forceinline__ void xcd_barrier_complete(unsigned* bar, unsigned x, unsigned& nloc, unsigned& nx) {
    const unsigned G = gridDim.x * gridDim.y * gridDim.z;
    unsigned sum, cnt, mine, sp = 0u;
    for (;;) {
        sum = 0u; cnt = 0u; mine = 0u;
#pragma unroll
        for (unsigned j = 0; j < 16; ++j) { const unsigned c = xb_ld(&bar[XB_XCNT(j)]); sum += c; cnt += (c > 0u) ? 1u : 0u; mine = (j == x) ? c : mine; }
        if (sum == G) break;
        __builtin_amdgcn_s_sleep(1);
        if ((++sp & 255u) == 0u) { if (xb_ld(&bar[XB_TMO])) break; if (sp > XB_SPIN_CAP) { atomicAdd(&bar[XB_TMO], 1u); break; } }
    }
    nloc = mine > 0u ? mine : 1u; nx = cnt > 0u ? cnt : 1u;
}

__device__ __forceinline__ void xcd_barrier(const XcdBarrier& b) {
    asm volatile("s_waitcnt vmcnt(0)" ::: "memory");
    __syncthreads();
    if (threadIdx.x == 0) {
        unsigned* bar = b.bar;
        __builtin_amdgcn_s_waitcnt(0);
        unsigned nloc = b.st[0], nx = b.st[1];
        if (nloc == 0u) { xcd_barrier_complete(bar, b.x, nloc, nx); b.st[0] = nloc; b.st[1] = nx; }
        const unsigned round = b.st[2];
        const unsigned old = xb_add(&bar[XB_XSUB(b.x)], 1u);
        if (old + 1u == (round + 1u) * nloc) {
            __builtin_amdgcn_fence(__ATOMIC_RELEASE, "agent");
            asm volatile("s_waitcnt vmcnt(0)" ::: "memory");
            const unsigned og = xb_add(&bar[XB_TOP], 1u);
            if (og + 1u == (round + 1u) * nx) xb_add(&bar[XB_TOPGEN], 1u);
            else XB_SPIN(xb_ld(&bar[XB_TOPGEN]) == round, bar);
        } else {
            XB_SPIN(xb_ld(&bar[XB_TOPGEN]) == round, bar);
        }
        __builtin_amdgcn_fence(__ATOMIC_ACQUIRE, "agent");
        asm volatile("s_waitcnt vmcnt(0)" ::: "memory");
        b.st[2] = round + 1u;
    }
    __syncthreads();
}


struct Args { const float* in[16]; float* out; unsigned char* ws; int ph_lo, ph_hi, li, pad; };
struct Frame {
    LAS unsigned char* lds; volatile LAS unsigned* MISC; gu32* ctl;
    int tid, lane, wave, vcu, G;
};
__device__ __forceinline__ float wave_sum(float v) {
#pragma unroll
    for (int o = 1; o < 64; o <<= 1) v += __shfl_xor(v, o);
    return v;
}
__device__ __forceinline__ int p8map(int cl) { return (cl & ~31) | (((cl >> 2) & 3) << 3) | (((cl >> 4) & 1) << 2) | (cl & 3); }
__device__ __forceinline__ int wcol(int g, int j) {
    const int pn = j >> 8, cl = j & 255;
    if (g == 0) return ((cl >> 7) * 2 + ((cl >> 4) & 1)) * 1024 + pn * 64 + ((cl >> 5) & 3) * 16 + (cl & 15);
    if (g == 2) { if (pn == 0) return p8map(cl); if (pn == 1) return cl < 160 ? 256 + cl : -1; return 416 + (pn - 2) * 256 + p8map(cl); }
    if (g == 3) { if (pn < 4) { const int L = pn * 256 + p8map(cl); return (L >> 6) * 96 + (L & 63); } const int L = (pn - 4) * 256 + cl; return (L >> 5) * 96 + 64 + (L & 31); }
    if (g == 4) { const int L = (pn & 3) * 256 + p8map(cl); return (L >> 6) * 128 + (pn >= 4 ? 64 : 0) + (L & 63); }
    return (j & ~255) | p8map(j & 255);
}
__device__ __forceinline__ void p0_wt_item(const float* W, int K, int Nsrc, const float* rscale, float cscale, int g, bf16* WT, LAS float* scr, int item, int nblk, int lane) {
    const int kb = item / nblk, nb = item % nblk, k0 = 64 * kb, j0 = 32 * nb;
    const int col = wcol(g, j0 + (lane & 31));
    float wv[32];
#pragma unroll
    for (int i = 0; i < 32; ++i) { const int kk = 2 * i + (lane >> 5); wv[i] = col >= 0 ? __builtin_nontemporal_load(W + (size_t)(k0 + kk) * Nsrc + col) : 0.f; }
#pragma unroll
    for (int i = 0; i < 32; ++i) { const int kk = 2 * i + (lane >> 5); float v = wv[i] * cscale; if (rscale) v *= rscale[k0 + kk];
        scr[kk * 33 + (lane & 31)] = v; }
    LDS_WAIT(); asm volatile("" ::: "memory");
    const int c = lane & 7;
#pragma unroll
    for (int jq = 0; jq < 4; ++jq) { const int n = (lane >> 3) + 8 * jq; const LAS float* s = scr + (8 * c) * 33 + n;
        v4u o; o.x = pk2(s[0 * 33], s[1 * 33]); o.y = pk2(s[2 * 33], s[3 * 33]); o.z = pk2(s[4 * 33], s[5 * 33]); o.w = pk2(s[6 * 33], s[7 * 33]);
        *(GAS v4u*)(WT + (size_t)(j0 + n) * K + k0 + 8 * c) = o; }
    LDS_WAIT(); asm volatile("" ::: "memory");
}
__device__ __forceinline__ void sincos_tab(float ang, float& s, float& c) {
    const double x = (double)ang, q = rint(x * 0.63661977236758134308), r = x - q * 1.57079632679489661923, r2 = r * r;
    const double sp = r * (1.0 + r2 * (-1.0 / 6 + r2 * (1.0 / 120 + r2 * (-1.0 / 5040 + r2 * (1.0 / 362880 - r2 * (1.0 / 39916800))))));
    const double cp = 1.0 + r2 * (-0.5 + r2 * (1.0 / 24 + r2 * (-1.0 / 720 + r2 * (1.0 / 40320 + r2 * (-1.0 / 3628800 + r2 * (1.0 / 479001600))))));
    const int k = ((int)q) & 3;
    s = (float)(k == 0 ? sp : k == 1 ? cp : k == 2 ? -sp : -cp); c = (float)(k == 0 ? cp : k == 1 ? -sp : k == 2 ? -cp : sp);
}
__device__ __forceinline__ void p0_prologue(Frame& F, const Args& a) {
    unsigned char* ws = a.ws;
    LAS float* scr = (LAS float*)(F.lds + RING_OFF + F.wave * 16384);
    const int gw = F.vcu * NWAVES + F.wave, NGW = F.G * NWAVES;
    constexpr int I0 = 16 * 128, I1 = 16 * 32, I2 = 16 * 48, I3 = 4 * 48, I4 = 2 * 64, I5 = 16 * 32, NITEMS = I0 + I1 + I2 + I3 + I4 + I5;
    for (int it = gw; it < NITEMS; it += NGW) {
        int r = it;
        if (r < I0) { p0_wt_item(a.in[7], 1024, 4096, a.in[5], 1.f, 0, (bf16*)(ws + WS_W1T), scr, r, 128, F.lane); continue; } r -= I0;
        if (r < I1) { p0_wt_item(a.in[9], 1024, 1024, nullptr, 1.f, 1, (bf16*)(ws + WS_W2T), scr, r, 32, F.lane); continue; } r -= I1;
        if (r < I2) { p0_wt_item(a.in[10], 1024, 1440, a.in[5] + 1024, 1.f, 2, (bf16*)(ws + WS_W3T), scr, r, 48, F.lane); continue; } r -= I2;
        if (r < I3) { p0_wt_item(a.in[12], 256, 1536, a.in[11], C2, 3, (bf16*)(ws + WS_W4T), scr, r, 48, F.lane); continue; } r -= I3;
        if (r < I4) { p0_wt_item(a.in[14], 128, 2048, nullptr, 1.f, 4, (bf16*)(ws + WS_W5T), scr, r, 64, F.lane); continue; } r -= I4;
        p0_wt_item(a.in[15], 1024, 1024, nullptr, 1.f, 5, (bf16*)(ws + WS_W6T), scr, r, 32, F.lane);
    }
    { bf16* xb = (bf16*)(ws + WS_A); float* rs0 = (float*)(ws + WS_RS0);
      for (int m = gw; m < MT; m += NGW) {
        const float* xrow = m < MP ? a.in[0] + (size_t)m * DM : a.in[1] + (size_t)(m - MP) * DM;
        const GAS f32x4* xr = (const GAS f32x4*)xrow + F.lane; f32x4 v[4]; float s = 0.f;
#pragma unroll
        for (int j = 0; j < 4; ++j) { v[j] = __builtin_nontemporal_load(xr + 64 * j); s += (v[j].x * v[j].x + v[j].y * v[j].y) + (v[j].z * v[j].z + v[j].w * v[j].w); }
        s = wave_sum(s);
        const float rms = sqrtf(s * (1.0f / DM) + EPS), rn = 1.0f / rms;
        if (F.lane == 0) rs0[m] = rms;
        GAS v2u* o8 = (GAS v2u*)(xb + (size_t)m * DM) + F.lane;
#pragma unroll
        for (int j = 0; j < 4; ++j) { v2u w; w.x = pk2(v[j].x * rn, v[j].y * rn); w.y = pk2(v[j].z * rn, v[j].w * rn); o8[64 * j] = w; }
      } }
    { const long gt = (long)F.vcu * (NWAVES * 64) + F.tid, NT_ = (long)F.G * NWAVES * 64;
      { unsigned* xs = (unsigned*)(ws + WS_SSQ2); for (long i = gt; i < 130 * 4 * 256; i += NT_) xs[i] = 0xFFFFFFFFu; }
      bf16* ckva = (bf16*)(ws + WS_CKVA) + (size_t)MP * KVL; const float* cc = a.in[3];
      bf16* krs = (bf16*)(ws + WS_KRS); const float* ck = a.in[4];
      constexpr long NCC = (long)SB * PAST * KVL / 8, NCK = (long)SB * PAST * DR / 8;
      bool first = true;
      for (long base = gt; base < NCC; base += 4 * NT_) {
          f32x4 cv[4][2], kv[2]; const bool dok = first && gt < NCK;
#pragma unroll
          for (int k = 0; k < 4; ++k) { const long i = base + k * NT_; if (i < NCC) { cv[k][0] = __builtin_nontemporal_load((const f32x4*)(cc + i * 8)); cv[k][1] = __builtin_nontemporal_load((const f32x4*)(cc + i * 8 + 4)); } }
          if (dok) { kv[0] = __builtin_nontemporal_load((const f32x4*)(ck + gt * 8)); kv[1] = __builtin_nontemporal_load((const f32x4*)(ck + gt * 8 + 4)); }
          if (first) { float* tab = (float*)(ws + WS_ROPE);
              for (long i = gt; i < 8192L * 16; i += NT_) { const int pos = (int)(i >> 4), k = (int)(i & 15);
                  const float inv = 1.0f / powf(10000.0f, (float)(2 * k) * (1.0f / 32.0f)); const float ang = (float)pos * inv; float s, c; sincos_tab(ang, s, c);
                  tab[pos * 32 + k] = c; tab[pos * 32 + 16 + k] = s; } }
#pragma unroll
          for (int k = 0; k < 4; ++k) { const long i = base + k * NT_; if (i < NCC) { const f32x4 x0 = cv[k][0], x1 = cv[k][1];
              v4u w; w.x = pk2(x0.x, x0.y); w.y = pk2(x0.z, x0.w); w.z = pk2(x1.x, x1.y); w.w = pk2(x1.z, x1.w); *(v4u*)(ckva + i * 8) = w; } }
          if (dok) { const long i = gt, row = i >> 2; const int c8 = (int)(i & 3); const long b = row >> 12, s = row & (PAST - 1); const f32x4 x0 = kv[0], x1 = kv[1];
              v4u w; w.x = pk2(x0.x, x0.y); w.y = pk2(x0.z, x0.w); w.z = pk2(x1.x, x1.y); w.w = pk2(x1.z, x1.w); *(v4u*)(krs + ((b * (SKVP / 64) + (s >> 6)) * 4 + c8) * 512 + (s & 63) * 8) = w; }
          first = false;
      }
      for (long i = gt + NT_; i < NCK; i += NT_) { const long row = i >> 2; const int c8 = (int)(i & 3); const long b = row >> 12, s = row & (PAST - 1);
          const f32x4 x0 = __builtin_nontemporal_load((const f32x4*)(ck + i * 8)), x1 = __builtin_nontemporal_load((const f32x4*)(ck + i * 8 + 4));
          v4u w; w.x = pk2(x0.x, x0.y); w.y = pk2(x0.z, x0.w); w.z = pk2(x1.x, x1.y); w.w = pk2(x1.z, x1.w); *(v4u*)(krs + ((b * (SKVP / 64) + (s >> 6)) * 4 + c8) * 512 + (s & 63) * 8) = w; }
      bf16* Ks = (bf16*)(ws + WS_K) + KP_ELEMS; bf16* Vs = (bf16*)(ws + WS_V) + KP_ELEMS; const v4u z4 = {0u, 0u, 0u, 0u};
      for (long i = gt; i < (long)SB * NH * 512; i += NT_) { const long bh = i >> 9, r = i & 511;
          *(v4u*)(Ks + (bh * (SKVP / 64) + 65) * 4096 + r * 8) = z4; *(v4u*)(Vs + (bh * (SKVP / 64) + 65) * 4096 + r * 8) = z4; }
      for (long i = gt; i < (long)SB * 256; i += NT_) { const long b = i >> 8, r = i & 255; *(v4u*)(krs + (b * (SKVP / 64) + 65) * 2048 + r * 8) = z4; }
    }
}
__device__ __forceinline__ void p2_fixup(Frame& F, const Args& a) {
    unsigned char* ws = a.ws;
    const float* whead = (const float*)(ws + WS_WHEAD); const float* pchead = (const float*)(ws + WS_PCHEAD); const float* utail = (const float*)(ws + WS_UTAIL);
    const float* cw = a.in[8]; const float* st = a.in[2]; bf16* g = (bf16*)(ws + WS_B);
    const long gt = (long)F.vcu * (NWAVES * 64) + F.tid, NT_ = (long)F.G * NWAVES * 64;
    for (long i = gt; i < (long)NCHUNK * 256; i += NT_) { const int c = (int)(i >> 8), ch = (int)(i & 255) * 4;
        f32x4 p1, p2;
        if (c < MP / 64) { if ((c & 127) == 0) { p1 = (f32x4){0.f, 0.f, 0.f, 0.f}; p2 = p1; } else { p1 = *(const f32x4*)(utail + (size_t)((c - 1) * 2 + 1) * DM + ch); p2 = *(const f32x4*)(utail + (size_t)((c - 1) * 2) * DM + ch); } }
        else { const int b = c - MP / 64; p1 = *(const f32x4*)(st + (size_t)(b * 2 + 1) * DM + ch); p2 = *(const f32x4*)(st + (size_t)(b * 2) * DM + ch); }
        const f32x4 cw0 = *(const f32x4*)(cw + ch), cw1 = *(const f32x4*)(cw + DM + ch);
        const f32x4 w0 = *(const f32x4*)(whead + (size_t)(c * 2) * DM + ch), w1 = *(const f32x4*)(whead + (size_t)(c * 2 + 1) * DM + ch);
        const f32x4 q0 = *(const f32x4*)(pchead + (size_t)(c * 2) * DM + ch), q1 = *(const f32x4*)(pchead + (size_t)(c * 2 + 1) * DM + ch);
        const f32x4 g0 = w0 * (q0 + cw1 * p1 + cw0 * p2), g1 = w1 * (q1 + cw0 * p1);
        v2u o0, o1; o0.x = pk2(g0.x, g0.y); o0.y = pk2(g0.z, g0.w); o1.x = pk2(g1.x, g1.y); o1.y = pk2(g1.z, g1.w);
        *(v2u*)(g + (size_t)(c * 64) * DM + ch) = o0; *(v2u*)(g + (size_t)(c * 64 + 1) * DM + ch) = o1;
    }
    for (long i = gt; i < (long)(NB + SB) * 2 * 256; i += NT_) { const int sidx = (int)(i >> 9), j = (int)(i >> 8) & 1, ch = (int)(i & 255) * 4;
        const int c = sidx < NB ? 128 * (sidx + 1) - 1 : MP / 64 + (sidx - NB);
        const f32x4 v = *(const f32x4*)(utail + (size_t)(c * 2 + j) * DM + ch);
        float* o = a.out + (sidx < NB ? O_CONVP + (size_t)(sidx * 2 + j) * DM : O_CONVS + (size_t)((sidx - NB) * 2 + j) * DM) + ch;
        *(f32x4*)o = v; }
}
__device__ __forceinline__ void p8_final(Frame& F, const Args& a) {
    const float* ssq2 = (const float*)(a.ws + WS_SSQ2); const float* gf = a.in[6]; const bf16* x2 = (const bf16*)(a.ws + WS_K);
    const int gw = F.vcu * NWAVES + F.wave, NGW = F.G * NWAVES;
    int ln = threadIdx.x; asm volatile("" : "+v"(ln)); ln &= 63;
    f32x4 gv[4];
#pragma unroll
    for (int j = 0; j < 2; ++j) { gv[2 * j] = *(const f32x4*)(gf + 512 * j + 8 * ln); gv[2 * j + 1] = *(const f32x4*)(gf + 512 * j + 8 * ln + 4); }
    for (int m = gw; m < MT; m += NGW) {
        const float rs = 1.0f / sqrtf(pg8::sum16(ssq2 + (size_t)m * 16) * (1.0f / DM) + EPS);
        const v4u x0 = __builtin_nontemporal_load((const v4u*)(x2 + (size_t)m * DM + 8 * ln)), x1 = __builtin_nontemporal_load((const v4u*)(x2 + (size_t)m * DM + 512 + 8 * ln));
        float* yr = a.out + (size_t)m * DM + 8 * ln;
        f32x4 v;
        v = (f32x4){__uint_as_float(x0.x << 16), __uint_as_float(x0.x & 0xffff0000u), __uint_as_float(x0.y << 16), __uint_as_float(x0.y & 0xffff0000u)}; *(f32x4*)yr = v * rs * gv[0];
        v = (f32x4){__uint_as_float(x0.z << 16), __uint_as_float(x0.z & 0xffff0000u), __uint_as_float(x0.w << 16), __uint_as_float(x0.w & 0xffff0000u)}; *(f32x4*)(yr + 4) = v * rs * gv[1];
        v = (f32x4){__uint_as_float(x1.x << 16), __uint_as_float(x1.x & 0xffff0000u), __uint_as_float(x1.y << 16), __uint_as_float(x1.y & 0xffff0000u)}; *(f32x4*)(yr + 512) = v * rs * gv[2];
        v = (f32x4){__uint_as_float(x1.z << 16), __uint_as_float(x1.z & 0xffff0000u), __uint_as_float(x1.w << 16), __uint_as_float(x1.w & 0xffff0000u)}; *(f32x4*)(yr + 516) = v * rs * gv[3];
    }
}
__device__ __forceinline__ void p6_attention(Frame& F, const Args& a, char* lds, const bool dry) {
    unsigned char* ws = a.ws;
    const bf16* Qp = (const bf16*)a.out; const bf16* Qs = Qp + QP_ELEMS; const bf16* Kp = (const bf16*)(ws + WS_K); const bf16* Ks = Kp + KP_ELEMS;
    const bf16* Vp = (const bf16*)(ws + WS_V); const bf16* Vs = Vp + KP_ELEMS; const bf16* krp = (const bf16*)(ws + WS_KRP); const bf16* krs = (const bf16*)(ws + WS_KRS);
    bf16* sz = (bf16*)(ws + WS_B);
    int nun, typeA = 0, grp = 0, s = 0; unsigned long long tab = 0;
    if (F.G == 256) { grp = F.vcu >> 3; const int j = F.vcu & 7; s = j & 3; typeA = j < 4; nun = typeA ? 9 : 8;
        tab = j == 0 ? 0x00720d41561eull : j == 1 ? 0x827a2dc35e3eull : j == 2 ? 0x08528c45465cull : j == 3 ? 0x8a5aacc74e7cull : j == 4 ? 0x04624f49769full : j == 5 ? 0x866a6fcb7ebfull : j == 6 ? 0x0c42ce4d66ddull : 0x8e4aeecf6efdull; }
    else nun = (64 * 32 + 128 - F.vcu + F.G - 1) / F.G;
#define UDESC(i, smp, idx, qb) do { \
        if (F.G == 256) { smp = typeA && (i) == 8; const unsigned e_ = (unsigned)(tab >> (6 * ((i) & 7))) & 63u; qb = (int)(e_ & 31u); idx = smp ? grp * 4 + s : 2 * grp + (int)(e_ >> 5); \
        } else { const int u_ = F.vcu + (i) * F.G; smp = u_ >= 2048; idx = smp ? u_ - 2048 : (u_ >> 5); qb = 31 - (u_ & 31); } } while (0)
#define UPTRS(smp, idx, K_, V_, R_) do { const int b__ = (idx) >> 4; K_ = smp ? Ks + (size_t)(idx) * SKVP * DN : Kp + (size_t)(idx) * SEQ * DN; V_ = smp ? Vs + (size_t)(idx) * SKVP * DV : Vp + (size_t)(idx) * SEQ * DV; \
        R_ = smp ? krs + (size_t)b__ * SKVP * DR : krp + (size_t)b__ * SEQ * DR; } while (0)
    for (int i = 0; i < nun; ++i) {
        bool smp; int idx, qb = 0; UDESC(i, smp, idx, qb);
        const int b_ = idx >> 4, h_ = idx & 15;
        const bf16* Qb = smp ? Qs + (size_t)idx * ST * DQK : Qp + ((size_t)idx * SEQ + 256 * qb) * DQK;
        const bf16 *Kh, *Vh, *KRh, *KhN = nullptr, *VhN = nullptr, *KRhN = nullptr, *QbN = nullptr; bool smpn = false; UPTRS(smp, idx, Kh, Vh, KRh);
        if (i + 1 < nun) { int idxn, qbn = 0; UDESC(i + 1, smpn, idxn, qbn); UPTRS(smpn, idxn, KhN, VhN, KRhN); QbN = smpn ? Qs + (size_t)idxn * ST * DQK : Qp + ((size_t)idxn * SEQ + 256 * qbn) * DQK; }
        bf16* Gp = sz + (smp ? ((size_t)MP + b_ * ST) * DM : ((size_t)b_ * SEQ + 256 * qb) * DM) + h_ * 64;
        att::attn_unit(smp, dry, i > 0, Qb, Kh, Vh, KRh, KhN, VhN, KRhN, QbN, smpn, Gp, smp ? 66 : 4 * qb + 4, smp ? 64 : 4 * qb, lds);
    }
#undef UDESC
#undef UPTRS
}

constexpr int PER_PHASE = 9;
constexpr int N_LAUNCHES = MK_N_LAUNCHES;
static_assert(N_LAUNCHES == 1 || N_LAUNCHES == PER_PHASE, "MK_N_LAUNCHES is 1 or 9");
constexpr size_t CTL_USED_BYTES = 64 * 1024;
static_assert((8192 + 256 * 3) * 4 <= 64 * 1024 && CTL_USED_BYTES <= CTL_ZERO_BYTES, "control words inside the per-call memset");
constexpr int CW_BAR = 4096, CW_SPLIT = 8192;
#ifndef PROBE_DUP
#define PROBE_DUP 0
#endif
#define DUP(k) (((PROBE_DUP) >> (k)) & 1)

__global__ void __launch_bounds__(NWAVES * 64, 2) mk_fwd(Args args) {
    extern __shared__ __attribute__((aligned(16))) unsigned char lds[];
    Frame F;
    F.lds = (LAS unsigned char*)lds;
    F.MISC = (volatile LAS unsigned*)(F.lds + MISC_OFF);
    F.tid = threadIdx.x; F.lane = F.tid & 63; F.wave = __builtin_amdgcn_readfirstlane(F.tid >> 6);
    F.G = gridDim.x; { const int bx = blockIdx.x; F.vcu = (F.G % 8 == 0) ? (bx % 8) * (F.G / 8) + bx / 8 : bx; }
    unsigned char* ws = args.ws;
    F.ctl = (gu32*)(ws + WS_CTL);
    for (int u = F.tid; u < (LDS_BYTES - LDSCTL_OFF) / 4; u += NWAVES * 64) ((LAS unsigned*)(F.lds + LDSCTL_OFF))[u] = 0u;
    __syncthreads();
    XcdBarrier bar; bar.bar = (unsigned*)(F.ctl + CW_BAR); bar.x = 0; bar.st = nullptr;
    if (N_LAUNCHES == 1) bar = xcd_barrier_post((unsigned*)(F.ctl + CW_BAR), F.MISC + 8);
#define GRID_BAR() do { if (N_LAUNCHES == 1) xcd_barrier(bar); } while (0)
#define KV_CACHED(U0, N) do { pg8::Gemm g{(const pg8::bf16_t*)(ws + WS_CKVA), (const pg8::bf16_t*)(ws + WS_W5T), MKV, 2048, 128}; pg8::CachedOrder S{(U0), (N)}; \
        pg8::EpiKV E{(const float*)(ws + WS_SSQKV), (pg8::bf16_t*)(ws + WS_K), (pg8::bf16_t*)(ws + WS_V), args.out, 0}; \
        pg8::gemm_phase<pg8::EpiKV, pg8::CachedOrder, true, true>(F.lds + RING_OFF, g, S, E); } while (0)
    const bool tails = (F.G == 256);
    const bool split = tails && N_LAUNCHES == 1;
#define SPLIT_TAIL(EPI, E_, A_, B_, N_, PM_, PN_, TU_, SL_, SCR_, K_) do { \
        pg8::Gemm gs{(const pg8::bf16_t*)(A_) + (SL_) * 128, (const pg8::bf16_t*)(B_) + (SL_) * 128, MT, (N_), 1024, 2}; pg8::OneUnit O1{(PM_), (PN_), 1}; \
        pg8::EpiSplit<EPI> ES{E_, (float*)(SCR_), (unsigned*)(F.ctl + CW_SPLIT + 256 * (K_)), (TU_), (SL_)}; \
        pg8::gemm_phase<pg8::EpiSplit<EPI>, pg8::OneUnit, true, true>(F.lds + RING_OFF, gs, O1, ES); } while (0)
    const int lo = args.ph_lo, hi = args.ph_hi;
#define IN(k) (lo <= (k) && (k) < hi)
#define BOTH(k) (IN(k) && IN((k) + 1))
    const int bx = (int)blockIdx.x;

    if (IN(0)) { for (int rep = 0; rep <= DUP(0); ++rep) { p0_prologue(F, args); if (BOTH(0)) GRID_BAR(); } }
    if (IN(1)) for (int rep = 0; rep <= DUP(1); ++rep) {
        pg8::Gemm g{(const pg8::bf16_t*)(ws + WS_A), (const pg8::bf16_t*)(ws + WS_W1T), MT, 4096, 1024}; pg8::StaticOrder S; S.init(MT, 4096, F.G, bx);
        { LAS f32x4* cwl = (LAS f32x4*)(F.lds + RING_OFF + pg8::STAGE_BYTES); const f32x4* cwg = (const f32x4*)args.in[8];
          for (int i = F.tid; i < 3 * DM / 4; i += NWAVES * 64) cwl[i] = cwg[i]; __syncthreads(); }
        pg8::EpiConvIn E{(PG8_LAS const float*)(F.lds + RING_OFF + pg8::STAGE_BYTES), (pg8::bf16_t*)(ws + WS_B), (float*)(ws + WS_WHEAD), (float*)(ws + WS_PCHEAD), (float*)(ws + WS_UTAIL)};
        pg8::gemm_phase<pg8::EpiConvIn, pg8::StaticOrder, true, true>(F.lds + RING_OFF, g, S, E);
        if (tails && rep == 0 && bx >= 32) { if (!split) KV_CACHED(bx - 32, 1); else if (bx < 128) KV_CACHED(2 * (bx - 32), 2); else KV_CACHED(192 + (bx - 128), 1); }
        if (BOTH(1)) GRID_BAR();
    }
    if (IN(2)) { for (int rep = 0; rep <= DUP(2); ++rep) { p2_fixup(F, args); if (BOTH(2)) GRID_BAR(); } }
    if (IN(3)) for (int rep = 0; rep <= DUP(3); ++rep) {
        pg8::Gemm g{(const pg8::bf16_t*)(ws + WS_B), (const pg8::bf16_t*)(ws + WS_W2T), MT, 1024, 1024}; pg8::StaticOrder S; S.init(MT, 1024, F.G, bx);
        pg8::EpiResid E{(const pg8::bf16_t*)(ws + WS_A), (pg8::bf16_t*)(ws + WS_A), (float*)(ws + WS_SSQ1), (const float*)(ws + WS_RS0)};
        if (split) S.lim = 512;
        pg8::gemm_phase<pg8::EpiResid, pg8::StaticOrder, true, true>(F.lds + RING_OFF, g, S, E);
        if (split) { if (bx < 64) { pg8::Unit tv; S.unit_of(512 + (bx >> 3), tv); SPLIT_TAIL(pg8::EpiResid, E, ws + WS_B, ws + WS_W2T, 1024, tv.pm, tv.pn, bx >> 3, bx & 7, args.out, 0); }
                     else if (rep == 0) KV_CACHED(320 + 2 * (bx - 64), 2); }
        else if (tails && rep == 0 && bx >= 8) KV_CACHED(224 + 2 * (bx - 8), 2);
        if (BOTH(3)) GRID_BAR();
    }
    if (IN(4)) for (int rep = 0; rep <= DUP(4); ++rep) {
        pg8::Gemm g{(const pg8::bf16_t*)(ws + WS_A), (const pg8::bf16_t*)(ws + WS_W3T), MT, 1536, 1024}; pg8::StaticOrder S; S.init(MT, 1536, F.G, bx);
        pg8::EpiMlaIn E{(const float*)(ws + WS_SSQ1), args.in[13], (const float*)(ws + WS_ROPE), (pg8::bf16_t*)(ws + WS_QLAT), (pg8::bf16_t*)(ws + WS_CKVA), (pg8::bf16_t*)(ws + WS_KRP),
                        (pg8::bf16_t*)(ws + WS_KRS), (pg8::bf16_t*)(ws + WS_B), args.out, (float*)(ws + WS_SSQKV), (PG8_LAS float*)(F.lds + RING_OFF + pg8::STAGE_BYTES)};
        if (split) S.lim = 768;
        pg8::gemm_phase<pg8::EpiMlaIn, pg8::StaticOrder, true, true>(F.lds + RING_OFF, g, S, E);
        if (split) { if (bx < 96) { pg8::Unit tv; S.unit_of(768 + (bx >> 3), tv); SPLIT_TAIL(pg8::EpiMlaIn, E, ws + WS_A, ws + WS_W3T, 1536, tv.pm, tv.pn, bx >> 3, bx & 7, args.out + (size_t)4 * 1024 * 1024, 1); }
                     else if (rep == 0) KV_CACHED(704 + 2 * (bx - 96), 2); }
        else if (tails && rep == 0 && bx >= 12) { if (bx < 72) KV_CACHED(720 + 2 * (bx - 12), 2); else KV_CACHED(840 + (bx - 72), 1); }
        if (BOTH(4)) GRID_BAR();
    }
#define P5A() { pg8::Gemm g{(const pg8::bf16_t*)(ws + WS_QLAT), (const pg8::bf16_t*)(ws + WS_W4T), MT, 1536, 256}; pg8::StaticOrder S; S.init(MT, 1536, F.G, bx); \
          pg8::EpiQ E{(const float*)(ws + WS_SSQQ), (const float*)(ws + WS_ROPE), (pg8::bf16_t*)args.out, (pg8::bf16_t*)args.out + QP_ELEMS}; \
          pg8::gemm_phase<pg8::EpiQ, pg8::StaticOrder, true, true>(F.lds + RING_OFF, g, S, E); }
#define P5B(FIX) { pg8::Gemm g{(const pg8::bf16_t*)(ws + WS_CKVA), (const pg8::bf16_t*)(ws + WS_W5T), MKV, 2048, 128}; \
          pg8::EpiKV E{(const float*)(ws + WS_SSQKV), (pg8::bf16_t*)(ws + WS_K), (pg8::bf16_t*)(ws + WS_V), args.out, FIX}; \
          if (tails) { pg8::KvOrder S; S.init(130 * 256, 2048, F.G, bx); pg8::gemm_phase<pg8::EpiKV, pg8::KvOrder, true, true>(F.lds + RING_OFF, g, S, E); } \
          else { pg8::StaticOrder S; S.init(MKV, 2048, F.G, bx); pg8::gemm_phase<pg8::EpiKV, pg8::StaticOrder, true, true>(F.lds + RING_OFF, g, S, E); } }
    if (IN(5)) {
#if (PROBE_DUP) & 32
        P5A(); GRID_BAR();
#endif
#if (PROBE_DUP) & 512
        P5B(0); GRID_BAR();
#endif
        P5A(); P5B(0);
        if (BOTH(5)) GRID_BAR();
    }
    if (IN(6)) { for (int rep = 0; rep <= DUP(6); ++rep) { p6_attention(F, args, (char*)lds + RING_OFF, rep < DUP(6)); if (BOTH(6)) GRID_BAR(); } }
    const bool fuse78 = tails && N_LAUNCHES == 1 && IN(7) && IN(8);
    if (fuse78) {
        pg8::Gemm g{(const pg8::bf16_t*)(ws + WS_B), (const pg8::bf16_t*)(ws + WS_W6T), MT, 1024, 1024}; pg8::PanelOrder S{bx, split ? 128 : 130};
        pg8::EpiResidNorm E{(const pg8::bf16_t*)(ws + WS_A), args.out, args.in[6], (float*)(ws + WS_SSQ2), (PG8_LAS float*)(F.lds + RING_OFF + pg8::STAGE_BYTES)};
        pg8::gemm_phase<pg8::EpiResidNorm, pg8::PanelOrder, true, true>(F.lds + RING_OFF, g, S, E);
        if (split && bx < 64) SPLIT_TAIL(pg8::EpiResidNorm, E, ws + WS_B, ws + WS_W6T, 1024, 128 + (bx >> 5), (bx >> 3) & 3, bx >> 3, bx & 7, ws + WS_K, 2);
    }
    if (IN(7) && !fuse78) for (int rep = 0; rep <= DUP(7); ++rep) {
        pg8::Gemm g{(const pg8::bf16_t*)(ws + WS_B), (const pg8::bf16_t*)(ws + WS_W6T), MT, 1024, 1024}; pg8::StaticOrder S; S.init(MT, 1024, F.G, bx);
        pg8::EpiResid E{(const pg8::bf16_t*)(ws + WS_A), (pg8::bf16_t*)(ws + WS_K), (float*)(ws + WS_SSQ2), nullptr};
        pg8::gemm_phase<pg8::EpiResid, pg8::StaticOrder, true, true>(F.lds + RING_OFF, g, S, E);
        if (BOTH(7)) GRID_BAR();
    }
    if (IN(8) && !fuse78) { p8_final(F, args); }
#undef IN
#undef BOTH
#undef GRID_BAR
}

extern "C" void kernel_launch(void* const* d_in, const int* in_sizes, int n_in, void* d_out, int out_size, void* d_ws, size_t ws_size, hipStream_t stream) {
    static int grid = 0;
    if (grid == 0) {
        if (n_in != 16 || in_sizes[0] != MP * DM || in_sizes[1] != MS * DM || (size_t)out_size != O_END || ws_size < WS_END) {
            fprintf(stderr, "kernel_launch: shape mismatch: n_in %d in0 %d in1 %d out %d ws %zu (need >= %zu)\n", n_in, n_in > 0 ? in_sizes[0] : -1, n_in > 1 ? in_sizes[1] : -1, out_size, ws_size, (size_t)WS_END); grid = -1; return; }
        int dev = 0, cus = 0, per_cu = 0;
        if (hipGetDevice(&dev) != hipSuccess || hipDeviceGetAttribute(&cus, hipDeviceAttributeMultiprocessorCount, dev) != hipSuccess) { fprintf(stderr, "kernel_launch: device query failed\n"); grid = -1; return; }
        if (hipFuncSetAttribute((const void*)mk_fwd, hipFuncAttributeMaxDynamicSharedMemorySize, LDS_BYTES) != hipSuccess) { fprintf(stderr, "kernel_launch: hipFuncSetAttribute failed\n"); grid = -1; return; }
        if (hipOccupancyMaxActiveBlocksPerMultiprocessor(&per_cu, (const void*)mk_fwd, NWAVES * 64, LDS_BYTES) != hipSuccess || per_cu < 1) { fprintf(stderr, "kernel_launch: occupancy query says %d blocks per CU\n", per_cu); per_cu = 1; }
        (void)hipGetLastError();
        grid = cus;
        fprintf(stderr, "kernel_launch: grid %d (occupancy %d per CU)\n", grid, per_cu);
    }
    if (grid < 0) return;
    if (hipMemsetAsync((char*)d_ws + WS_CTL, 0, CTL_USED_BYTES, stream) != hipSuccess) { fprintf(stderr, "kernel_launch: memset failed\n"); return; }
    Args a{};
    for (int i = 0; i < 16; ++i) a.in[i] = (const float*)d_in[i];
    a.out = (float*)d_out; a.ws = (unsigned char*)d_ws;
    if (N_LAUNCHES == 1) {
        a.ph_lo = 0; a.ph_hi = PER_PHASE; a.li = 0;
        void* kargs[] = {&a};
        const hipError_t le = hipLaunchCooperativeKernel((const void*)mk_fwd, dim3(grid), dim3(NWAVES * 64), kargs, LDS_BYTES, stream);
        if (le != hipSuccess) fprintf(stderr, "kernel_launch: cooperative launch failed: %s (grid %d)\n", hipGetErrorName(le), grid);
    } else {
        for (int li = 0; li < PER_PHASE; ++li) {
            a.ph_lo = li; a.ph_hi = li + 1; a.li = li;
            hipLaunchKernelGGL(mk_fwd, dim3(grid), dim3(NWAVES * 64), LDS_BYTES, stream, a);
            const hipError_t le = hipPeekAtLastError();
            if (le != hipSuccess) { fprintf(stderr, "kernel_launch: launch %d failed: %s\n", li, hipGetErrorName(le)); break; }
        }
    }
}
```
